# Optimizing an MI355X kernel written in HIP

```python
import math
import numpy as np
import jax
import jax.numpy as jnp
from jax import lax

D_MODEL = 1024
BATCH = 8
SEQ = 4096
DEPTH = 2

PLE_DIM = 256
N_MIXERS = 2
N_NSA_LAYERS = (DEPTH + 1) // 2
N_RET_LAYERS = DEPTH // 2
RMS_EPS = 1e-6
GN_EPS = 1e-5

NSA_HEADS = 16
NSA_HEAD_DIM = D_MODEL // NSA_HEADS
NSA_KV_GROUPS = 4
NSA_HPG = NSA_HEADS // NSA_KV_GROUPS
CMP_BLOCK = 32
CMP_STRIDE = 16
CMP_HIDDEN = 256
SEL_BLOCK = 64
SEL_TOPN = 16
WINDOW = 512
Q_CHUNK = 32
FORCE_BONUS = 1e4
NEG = -1e30
NSA_Q_W = NSA_HEADS * NSA_HEAD_DIM
NSA_KV_W = NSA_KV_GROUPS * NSA_HEAD_DIM
NSA_GATE_COLS = 3 * NSA_HEADS
NSA_Z_W = NSA_HEADS * NSA_HEAD_DIM
NSA_SIZES = [NSA_Q_W] + [NSA_KV_W] * 6 + [NSA_GATE_COLS, NSA_Z_W]
NSA_IN_COLS = int(sum(NSA_SIZES))
NSA_SPLITS = [int(v) for v in np.cumsum(NSA_SIZES[:-1])]

RET_HEADS = 4
RET_KEY_DIM = D_MODEL // RET_HEADS
RET_VAL_DIM = 2 * RET_KEY_DIM
RET_CHUNK = 128
ROPE_BASE = 10000.0
RET_SIZES = [RET_HEADS * RET_KEY_DIM, RET_HEADS * RET_KEY_DIM,
             RET_HEADS * RET_VAL_DIM, RET_HEADS * RET_VAL_DIM]
RET_IN_COLS = int(sum(RET_SIZES))
RET_SPLITS = [int(v) for v in np.cumsum(RET_SIZES[:-1])]

kernel_name = "nsa_retention_interleaved_hybrid"


def rms_norm(x, g):
    xf = x.astype(jnp.float32)
    y = xf * lax.rsqrt(jnp.mean(xf * xf, axis=-1, keepdims=True) + RMS_EPS)
    return (y * g.astype(jnp.float32)).astype(x.dtype)


def masked_softmax(s, mask):
    s32 = jnp.where(mask, s.astype(jnp.float32), NEG)
    p = jax.nn.softmax(s32, axis=-1)
    return jnp.where(mask, p, 0.0)


def cmp_sel_overlap(n_cmp, n_sel):
    i = np.arange(n_cmp)[:, None]
    j = np.arange(n_sel)[None, :]
    c_start = i * CMP_STRIDE
    c_end = c_start + CMP_BLOCK
    ov = (c_start < (j + 1) * SEL_BLOCK) & (c_end > j * SEL_BLOCK)
    return ov.astype(np.float32)


def compress(k, pos, w1, w2):
    b, s, g, d = k.shape
    n_sub_tot = s // CMP_STRIDE
    n_sub = CMP_BLOCK // CMP_STRIDE
    sub = k.reshape(b, n_sub_tot, CMP_STRIDE, g, d)
    n_cmp = n_sub_tot - n_sub + 1
    blocks = jnp.concatenate([sub[:, j:j + n_cmp] for j in range(n_sub)], axis=2)
    blocks = blocks + pos[None, None, :, None, :]
    flat = blocks.transpose(0, 1, 3, 2, 4).reshape(b, n_cmp, g, CMP_BLOCK * d)
    return jax.nn.silu(flat @ w1) @ w2


def nsa_mixer(h, w_in, q_g, kc_g, ks_g, kw_g, pos_k, pos_v, ck_w1, ck_w2, cv_w1, cv_w2, w_out):
    b, s, _ = h.shape
    G, HPG, dk = NSA_KV_GROUPS, NSA_HPG, NSA_HEAD_DIM
    proj = h @ w_in
    q, kc, vc, ks, vs, kw, vw, gl, z = jnp.split(proj, NSA_SPLITS, axis=-1)
    q = rms_norm(q.reshape(b, s, G, HPG, dk), q_g) * (dk ** -0.5)
    kvs = (b, s, G, dk)
    kc = rms_norm(compress(kc.reshape(kvs), pos_k, ck_w1, ck_w2), kc_g)
    vc = compress(vc.reshape(kvs), pos_v, cv_w1, cv_w2)
    ks = rms_norm(ks.reshape(kvs), ks_g)
    vs = vs.reshape(kvs)
    kw = rms_norm(kw.reshape(kvs), kw_g)
    vw = vw.reshape(kvs)
    gates = jax.nn.sigmoid(gl.reshape(b, s, G, HPG, 3))

    n_cmp = kc.shape[1]
    n_sel = s // SEL_BLOCK
    top_n = min(SEL_TOPN, n_sel)
    cmp_end = jnp.arange(n_cmp) * CMP_STRIDE + CMP_BLOCK - 1
    overlap = jnp.asarray(cmp_sel_overlap(n_cmp, n_sel))
    ks_blk = ks.reshape(b, n_sel, SEL_BLOCK, G, dk).transpose(0, 3, 1, 2, 4)
    vs_blk = vs.reshape(b, n_sel, SEL_BLOCK, G, dk).transpose(0, 3, 1, 2, 4)
    kw_pad = jnp.pad(kw, ((0, 0), (WINDOW, 0), (0, 0), (0, 0)))
    vw_pad = jnp.pad(vw, ((0, 0), (WINDOW, 0), (0, 0), (0, 0)))
    b_ix = jnp.arange(b)[:, None, None, None]
    g_ix = jnp.arange(G)[None, None, :, None]
    sel_off = jnp.arange(SEL_BLOCK)
    win_off = jnp.arange(WINDOW + Q_CHUNK)
    blk = jnp.arange(n_sel)
    n_keys_sel = top_n * SEL_BLOCK

    def chunk(c):
        t0 = c * Q_CHUNK
        t = t0 + jnp.arange(Q_CHUNK)
        qc = lax.dynamic_slice_in_dim(q, t0, Q_CHUNK, axis=1)
        gc = lax.dynamic_slice_in_dim(gates, t0, Q_CHUNK, axis=1)
        sc = jnp.einsum('btghd,bngd->btghn', qc, kc)
        mc = (cmp_end[None, :] <= t[:, None])[None, :, None, None, :]
        pc = masked_softmax(sc, mc)
        o_c = jnp.einsum('btghn,bngd->btghd', pc.astype(vc.dtype), vc)
        imp = jnp.einsum('btgn,nj->btgj', pc.sum(axis=3), overlap)
        cur = t // SEL_BLOCK
        valid = blk[None, :] <= cur[:, None]
        forced = (blk[None, :] == 0) | (blk[None, :] == cur[:, None]) | (blk[None, :] == cur[:, None] - 1)
        score = jnp.where(valid[None, :, None, :],
                          imp + FORCE_BONUS * forced[None, :, None, :].astype(jnp.float32), NEG)
        _, idx = lax.top_k(score, top_n)
        kg = ks_blk[b_ix, g_ix, idx].reshape(b, Q_CHUNK, G, n_keys_sel, dk)
        vg = vs_blk[b_ix, g_ix, idx].reshape(b, Q_CHUNK, G, n_keys_sel, dk)
        ss = jnp.einsum('btghd,btgmd->btghm', qc, kg)
        kpos = (idx[..., None] * SEL_BLOCK + sel_off).reshape(b, Q_CHUNK, G, n_keys_sel)
        ms = (kpos <= t[None, :, None, None])[:, :, :, None, :]
        ps = masked_softmax(ss, ms)
        o_s = jnp.einsum('btghm,btgmd->btghd', ps.astype(vg.dtype), vg)
        kwc = lax.dynamic_slice_in_dim(kw_pad, t0, WINDOW + Q_CHUNK, axis=1)
        vwc = lax.dynamic_slice_in_dim(vw_pad, t0, WINDOW + Q_CHUNK, axis=1)
        spos = t0 - WINDOW + win_off
        mw = (spos[None, :] >= 0) & (spos[None, :] <= t[:, None]) & (t[:, None] - spos[None, :] < WINDOW)
        sw = jnp.einsum('btghd,bsgd->btghs', qc, kwc)
        pw = masked_softmax(sw, mw[None, :, None, None, :])
        o_w = jnp.einsum('btghs,bsgd->btghd', pw.astype(vwc.dtype), vwc)
        return gc[..., 0:1] * o_c + gc[..., 1:2] * o_s + gc[..., 2:3] * o_w

    out = lax.map(chunk, jnp.arange(s // Q_CHUNK))
    out = out.transpose(1, 0, 2, 3, 4, 5).reshape(b, s, NSA_HEADS * dk)
    return (out * jax.nn.silu(z)) @ w_out


def rotary(x, pos):
    half = x.shape[-1] // 2
    inv = ROPE_BASE ** (-jnp.linspace(0.0, 1.0, half, dtype=jnp.float32))
    ang = pos[:, None] * inv[None, :]
    cos = jnp.cos(ang)[None, :, None, :].astype(x.dtype)
    sin = jnp.sin(ang)[None, :, None, :].astype(x.dtype)
    x1, x2 = x[..., :half], x[..., half:]
    return jnp.concatenate([x1 * cos - x2 * sin, x1 * sin + x2 * cos], axis=-1)


def retention_mixer(h, w_in, w_out):
    b, s, _ = h.shape
    H, dk, dv, C = RET_HEADS, RET_KEY_DIM, RET_VAL_DIM, RET_CHUNK
    proj = h @ w_in
    q, k, v, z = jnp.split(proj, RET_SPLITS, axis=-1)
    pos = jnp.arange(s, dtype=jnp.float32)
    q = rotary(q.reshape(b, s, H, dk), pos)
    k = rotary(k.reshape(b, s, H, dk), pos) * (dk ** -0.5)
    v = v.reshape(b, s, H, dv)
    n_c = s // C

    def to_chunks(a):
        return a.reshape(b, n_c, C, H, a.shape[-1]).transpose(1, 0, 3, 2, 4).astype(jnp.float32)

    log_g = jnp.log(1.0 - 2.0 ** (-5.0 - jnp.arange(H, dtype=jnp.float32)))
    ix = jnp.arange(C, dtype=jnp.float32)
    diff = ix[:, None] - ix[None, :]
    intra_decay = jnp.where(diff >= 0, jnp.exp(log_g[:, None, None] * jnp.maximum(diff, 0.0)), 0.0)
    q_decay = jnp.exp(log_g[:, None] * (ix + 1.0))
    k_decay = jnp.exp(log_g[:, None] * (C - 1.0 - ix))
    chunk_decay = jnp.exp(log_g * C)

    def step(state, qkv):
        qc, kc, vc = qkv
        att = jnp.einsum('bhid,bhjd->bhij', qc, kc) * intra_decay
        o = (jnp.einsum('bhij,bhje->bhie', att, vc)
             + jnp.einsum('bhid,bhde->bhie', qc, state) * q_decay[..., None])
        state = (state * chunk_decay[:, None, None]
                 + jnp.einsum('bhjd,bhje->bhde', kc * k_decay[..., None], vc))
        return state, o

    state0 = jnp.zeros((b, H, dk, dv), jnp.float32)
    _, o = lax.scan(step, state0, (to_chunks(q), to_chunks(k), to_chunks(v)))
    o = o.transpose(1, 0, 3, 2, 4).reshape(b, s, H, dv)
    mu = jnp.mean(o, axis=-1, keepdims=True)
    var = jnp.mean(jnp.square(o - mu), axis=-1, keepdims=True)
    o = ((o - mu) * lax.rsqrt(var + GN_EPS)).reshape(b, s, H * dv).astype(h.dtype)
    return (o * jax.nn.silu(z)) @ w_out


def setup_inputs(seed: int = 0) -> dict:
    key = jax.random.key(seed)
    ks = jax.random.split(key, 20)

    def nrm(k, shape, fan_in):
        return jax.random.normal(k, shape, jnp.float32) * (fan_in ** -0.5)

    def gain(k, shape):
        return 1.0 + 0.02 * jax.random.normal(k, shape, jnp.float32)

    NA, NB, dk = N_NSA_LAYERS, N_RET_LAYERS, NSA_HEAD_DIM
    return {
        "x": jax.random.normal(ks[0], (BATCH, SEQ, D_MODEL), jnp.float32),
        "p": jax.random.normal(ks[1], (DEPTH, BATCH, SEQ, PLE_DIM), jnp.float32),
        "norm_g": gain(ks[2], (DEPTH, D_MODEL)),
        "nsa_w_in": nrm(ks[3], (NA, D_MODEL, NSA_IN_COLS), D_MODEL),
        "nsa_q_g": gain(ks[4], (NA, dk)),
        "nsa_kc_g": gain(ks[5], (NA, dk)),
        "nsa_ks_g": gain(ks[6], (NA, dk)),
        "nsa_kw_g": gain(ks[7], (NA, dk)),
        "nsa_cmp_pos_k": 0.1 * jax.random.normal(ks[8], (NA, CMP_BLOCK, dk), jnp.float32),
        "nsa_cmp_pos_v": 0.1 * jax.random.normal(ks[9], (NA, CMP_BLOCK, dk), jnp.float32),
        "nsa_cmp_k_w1": nrm(ks[10], (NA, CMP_BLOCK * dk, CMP_HIDDEN), CMP_BLOCK * dk),
        "nsa_cmp_k_w2": nrm(ks[11], (NA, CMP_HIDDEN, dk), CMP_HIDDEN),
        "nsa_cmp_v_w1": nrm(ks[12], (NA, CMP_BLOCK * dk, CMP_HIDDEN), CMP_BLOCK * dk),
        "nsa_cmp_v_w2": nrm(ks[13], (NA, CMP_HIDDEN, dk), CMP_HIDDEN),
        "nsa_w_out": nrm(ks[14], (NA, NSA_Z_W, D_MODEL), NSA_Z_W),
        "ret_w_in": nrm(ks[15], (NB, D_MODEL, RET_IN_COLS), D_MODEL),
        "ret_w_out": nrm(ks[16], (NB, RET_HEADS * RET_VAL_DIM, D_MODEL), RET_HEADS * RET_VAL_DIM),
        "ple_w": nrm(ks[17], (DEPTH, PLE_DIM, D_MODEL), PLE_DIM),
        "ple_gate_w": nrm(ks[18], (DEPTH, D_MODEL, D_MODEL), D_MODEL),
    }


def reference(x, p, norm_g, nsa_w_in, nsa_q_g, nsa_kc_g, nsa_ks_g, nsa_kw_g,
              nsa_cmp_pos_k, nsa_cmp_pos_v, nsa_cmp_k_w1, nsa_cmp_k_w2,
              nsa_cmp_v_w1, nsa_cmp_v_w2, nsa_w_out, ret_w_in, ret_w_out,
              ple_w, ple_gate_w):
    for i in range(DEPTH):
        h = rms_norm(x, norm_g[i])
        j = i // N_MIXERS
        if i % N_MIXERS == 0:
            y = nsa_mixer(h, nsa_w_in[j], nsa_q_g[j], nsa_kc_g[j], nsa_ks_g[j], nsa_kw_g[j],
                          nsa_cmp_pos_k[j], nsa_cmp_pos_v[j], nsa_cmp_k_w1[j], nsa_cmp_k_w2[j],
                          nsa_cmp_v_w1[j], nsa_cmp_v_w2[j], nsa_w_out[j])
        else:
            y = retention_mixer(h, ret_w_in[j], ret_w_out[j])
        x = x + y
        x = x + jax.nn.sigmoid(x @ ple_gate_w[i]) * (p[i] @ ple_w[i])
    return x
```

```cpp
#include <hip/hip_runtime.h>
#include <hip/hip_cooperative_groups.h>
#include <cstdio>
#include <cstdint>
namespace cg = cooperative_groups;

#define LAS __attribute__((address_space(3)))
#define GAS __attribute__((address_space(1)))
typedef unsigned short bf16_t;
typedef short bf16x8 __attribute__((ext_vector_type(8)));
typedef short s16x4 __attribute__((ext_vector_type(4)));
typedef float f32x2 __attribute__((ext_vector_type(2)));
typedef float f32x4 __attribute__((ext_vector_type(4)));
typedef float f32x16 __attribute__((ext_vector_type(16)));
typedef unsigned u32x2 __attribute__((ext_vector_type(2)));
typedef unsigned u32x4 __attribute__((ext_vector_type(4)));

constexpr int T_TOK = 32768, SEQ = 4096, NB = 8, DM = 1024;
constexpr float LOG2E = 1.4426950408889634f;
constexpr float RMS_EPS = 1e-6f, GN_EPS = 1e-5f;

typedef __bf16 bf16x2_t __attribute__((ext_vector_type(2)));
__device__ __forceinline__ unsigned cvt_pk_bf16(float lo, float hi) { const f32x2 v = {lo, hi}; const bf16x2_t b = __builtin_convertvector(v, bf16x2_t); return __builtin_bit_cast(unsigned, b); }
__device__ __forceinline__ float bf_lo(unsigned w) { return __uint_as_float(w << 16); }
__device__ __forceinline__ float bf_hi(unsigned w) { return __uint_as_float(w & 0xffff0000u); }
__device__ __forceinline__ int lane_id() { int l; asm volatile("v_mbcnt_lo_u32_b32 %0, -1, 0\n\tv_mbcnt_hi_u32_b32 %0, -1, %0" : "=v"(l)); return l; }
__device__ __forceinline__ const char* uni_ptr(const char* p) {
    const unsigned long long v = (unsigned long long)p; const unsigned lo = __builtin_amdgcn_readfirstlane((unsigned)v), hi = __builtin_amdgcn_readfirstlane((unsigned)(v >> 32));
    return (const char*)(((unsigned long long)hi << 32) | lo); }
__device__ __forceinline__ float fast_rcp(float x) { return __builtin_amdgcn_rcpf(x); }
__device__ __forceinline__ float sigmoidf_(float x) { return fast_rcp(1.0f + __builtin_amdgcn_exp2f(-x * LOG2E)); }
__device__ __forceinline__ float siluf_(float x) { return x * sigmoidf_(x); }

template <class T> __device__ __forceinline__ void st_nt(T* p, const T v) { __builtin_nontemporal_store(v, p); }
namespace pg8 {
constexpr int BM = 256, BK = 64, HALF = 128, HTB = HALF * BK * 2, STAGE_BYTES = 8 * HTB, NXCD = 8, WGM = 8;
__host__ __device__ __forceinline__ int lds_byte(int r, int c) { const int st = (r >> 4) * 2 + (c >> 5), rr = r & 15, cc = c & 31, ob = rr * 64 + cc * 2; return st * 1024 + (ob ^ (((ob >> 9) & 1) << 5)); }
__host__ __device__ __forceinline__ void stage_rc(int b, int& R, int& C) { const int st = b / 1024, sb = b % 1024, swz = sb ^ (((sb >> 9) & 1) << 5); R = (st >> 1) * 16 + swz / 64; C = (st & 1) * 32 + (swz % 64) / 2; }
__host__ __device__ __forceinline__ int perm32(int rho) { const int n = rho >> 4, i = rho & 15; return 8 * (i >> 2) + 4 * n + (i & 3); }

struct Unit { int pm, pn; };
struct Gemm { const char* A; const char* Bt; unsigned lda, ldb; unsigned ksA, ksB; int K; };

struct SchedStd {
    int nM, nN, nwg, G, c, pn0, first, last; size_t a_ts, b_ts;
    __device__ __forceinline__ void init(int nM_, int nN_, int pn0_, int G_, int c_, size_t a_ts_, size_t b_ts_) { nM = nM_; nN = nN_; nwg = nM * nN; G = G_; c = c_; pn0 = pn0_; a_ts = a_ts_; b_ts = b_ts_; first = 0; last = nwg; }
    __device__ __forceinline__ void range(int first_, int last_) { first = first_; last = last_; }
    __device__ __forceinline__ bool next(int i, Unit& u) const {
        const long L = (long)first + (long)i * G + c; if (L >= last) return false;
        int wgid = (int)L; { const int q = nwg / NXCD, r = nwg % NXCD, xcd = wgid % NXCD, off = wgid / NXCD; wgid = (xcd < r ? xcd * (q + 1) : r * (q + 1) + (xcd - r) * q) + off; }
#if defined(SCHED_PNMAJOR)
        u.pm = (int)(L % nM); u.pn = pn0 + (int)(L / nM); return true;
#else
        const int nig = WGM * nN, gid = wgid / nig, fm = gid * WGM, gsz = (nM - fm) < WGM ? (nM - fm) : WGM;
        u.pm = fm + ((wgid % nig) % gsz); u.pn = pn0 + (wgid % nig) / gsz; return true;
#endif
    }
    __device__ __forceinline__ unsigned a_off(const Unit& u) const { return (unsigned)u.pm * (unsigned)a_ts; }
    __device__ __forceinline__ unsigned b_off(const Unit& u) const { return (unsigned)u.pn * (unsigned)b_ts; }
};
struct SchedCmp {
    int G, c; size_t kv_stride_a, kv_stride_b;
    __device__ __forceinline__ bool next(int i, Unit& u) const { const int L = i * G + c; if (L >= 64) return false; u.pm = L; u.pn = 0; return true; }
    __device__ __forceinline__ unsigned a_off(const Unit& u) const { return (unsigned)(u.pm >> 5) * (unsigned)kv_stride_a + (unsigned)((u.pm >> 2) & 7) * (unsigned)(SEQ * 512) + (unsigned)(u.pm & 3) * 128u; }
    __device__ __forceinline__ unsigned b_off(const Unit& u) const { return (unsigned)(u.pm >> 5) * (unsigned)kv_stride_b; }
};

template <class Epi, class Sched, bool SWAP>
__device__ __forceinline__ void gemm_phase(LAS unsigned char* lds, const int wid, const Gemm g, const Sched& S, const Epi& E) {
    const int lane = lane_id(), tid = wid * 64 + lane, wr = wid >> 2, wc = wid & 3, fr = lane & 15, fq = lane >> 4;
    const int nt = g.K / BK;
    unsigned voffA[2], voffB[2];
#pragma unroll
    for (int i = 0; i < 2; ++i) { int R, C; stage_rc(tid * 16 + i * 8192, R, C); const int Rb = (!SWAP) ? ((R & ~31) + perm32(R & 31)) : R;
        voffA[i] = (unsigned)R * g.lda + (unsigned)C * 2u; voffB[i] = (unsigned)Rb * g.ldb + (unsigned)C * 2u; }
    const unsigned ksA = g.ksA, ksB = g.ksB;
    const unsigned hsA = (unsigned)HALF * g.lda, hsB = (unsigned)HALF * g.ldb;
    const unsigned ldsw = (unsigned)wid * 1024u;
    const int aoff = lds_byte(wr * 64 + fr, fq * 8), boff = lds_byte(wc * 32 + fr, fq * 8);
    const __amdgpu_buffer_rsrc_t rsA = __builtin_amdgcn_make_buffer_rsrc((void*)g.A, (short)0, 0x7fffffff, 0x00020000);
    const __amdgpu_buffer_rsrc_t rsB = __builtin_amdgcn_make_buffer_rsrc((void*)g.Bt, (short)0, 0x7fffffff, 0x00020000);
#define PG8_SA(b, h) (((b) * 2 + (h)) * HTB)
#define PG8_SB(b, h) ((4 + (b) * 2 + (h)) * HTB)
#define PG8_STAGE(bufoff, rs, soff, voff) do { _Pragma("unroll") for (int _i = 0; _i < 2; ++_i) \
        __builtin_amdgcn_raw_ptr_buffer_load_lds((rs), (LAS unsigned*)(lds + (bufoff) + ldsw + _i * 8192), 16, (int)(voff)[_i], (int)(soff), 0, 0); } while (0)
#define PG8_LDA(dst, b, h) do { _Pragma("unroll") for (int m = 0; m < 4; ++m) _Pragma("unroll") for (int k = 0; k < 2; ++k) dst[m][k] = *(const LAS bf16x8*)(lds + PG8_SA(b, h) + aoff + m * 2048 + k * 1024); } while (0)
#define PG8_LDB(dst, b, h) do { _Pragma("unroll") for (int n = 0; n < 2; ++n) _Pragma("unroll") for (int k = 0; k < 2; ++k) dst[n][k] = *(const LAS bf16x8*)(lds + PG8_SB(b, h) + boff + n * 2048 + k * 1024); } while (0)
#define PG8_MMA(ai, bj, At, Bt) do { __builtin_amdgcn_s_setprio(1); _Pragma("unroll") for (int m = 0; m < 4; ++m) _Pragma("unroll") for (int n = 0; n < 2; ++n) _Pragma("unroll") for (int k = 0; k < 2; ++k) \
        acc[ai][bj][m][n] = SWAP ? __builtin_amdgcn_mfma_f32_16x16x32_bf16(At[m][k], Bt[n][k], acc[ai][bj][m][n], 0, 0, 0) : __builtin_amdgcn_mfma_f32_16x16x32_bf16(Bt[n][k], At[m][k], acc[ai][bj][m][n], 0, 0, 0); __builtin_amdgcn_s_setprio(0); } while (0)
#define PG8_WAIT_V(n) asm volatile("s_waitcnt vmcnt(" #n ")" ::: "memory")
#define PG8_WAIT_L(n) asm volatile("s_waitcnt lgkmcnt(" #n ")" ::: "memory")
#define PG8_BAR __builtin_amdgcn_s_barrier()
#define PG8_SCHED __builtin_amdgcn_sched_barrier(0)
    Unit cur, nxt; int ui = 0;
    if (!S.next(0, cur)) return;
    f32x4 acc[2][2][4][2];
#pragma unroll
    for (int a = 0; a < 2; ++a)
#pragma unroll
        for (int b = 0; b < 2; ++b)
#pragma unroll
            for (int m = 0; m < 4; ++m)
#pragma unroll
                for (int n = 0; n < 2; ++n) acc[a][b][m][n] = (f32x4){0.f, 0.f, 0.f, 0.f};
    bf16x8 At[4][2], B0[2][2], B1[2][2];
    unsigned cA = S.a_off(cur), cB = S.b_off(cur);
    PG8_STAGE(PG8_SB(0, 0), rsB, cB, voffB); PG8_STAGE(PG8_SB(0, 1), rsB, cB + hsB, voffB); PG8_STAGE(PG8_SA(0, 0), rsA, cA, voffA); PG8_STAGE(PG8_SA(0, 1), rsA, cA + hsA, voffA);
    if (wr == 1) PG8_BAR;
    PG8_WAIT_V(2); PG8_BAR;
    PG8_STAGE(PG8_SB(1, 0), rsB, cB + ksB, voffB); PG8_STAGE(PG8_SA(1, 0), rsA, cA + ksA, voffA); PG8_STAGE(PG8_SB(1, 1), rsB, cB + hsB + ksB, voffB);
    PG8_WAIT_V(6); PG8_BAR;
    for (;;) {
        const bool has_next = S.next(ui + 1, nxt);
        const unsigned nA = has_next ? S.a_off(nxt) : cA, nB = has_next ? S.b_off(nxt) : cB;
        for (int t = 0; t < nt; t += 2) {
            const bool last = (t == nt - 2);
            const unsigned a1 = cA + (unsigned)(t + 1) * ksA;
            const unsigned a2 = last ? nA : cA + (unsigned)(t + 2) * ksA, b2 = last ? nB : cB + (unsigned)(t + 2) * ksB;
            const unsigned a3 = a2 + ksA, b3 = b2 + ksB;
            PG8_LDB(B0, 0, 0); PG8_LDB(B1, 0, 1); PG8_SCHED; PG8_LDA(At, 0, 0); PG8_STAGE(PG8_SA(1, 1), rsA, a1 + hsA, voffA);
            PG8_WAIT_V(8); PG8_WAIT_L(0); PG8_BAR; PG8_MMA(0, 0, At, B0); PG8_MMA(0, 1, At, B1); PG8_BAR; PG8_SCHED;
            PG8_LDA(At, 0, 1); PG8_STAGE(PG8_SB(0, 0), rsB, b2, voffB); PG8_STAGE(PG8_SB(0, 1), rsB, b2 + hsB, voffB); PG8_STAGE(PG8_SA(0, 0), rsA, a2, voffA);
            PG8_WAIT_V(8); PG8_WAIT_L(0); PG8_BAR; PG8_MMA(1, 0, At, B0); PG8_MMA(1, 1, At, B1); PG8_BAR; PG8_SCHED;
            PG8_LDB(B0, 1, 0); PG8_LDB(B1, 1, 1); PG8_SCHED; PG8_LDA(At, 1, 0); PG8_STAGE(PG8_SA(0, 1), rsA, a2 + hsA, voffA);
            PG8_WAIT_V(8); PG8_WAIT_L(0); PG8_BAR; PG8_MMA(0, 0, At, B0); PG8_MMA(0, 1, At, B1); PG8_BAR; PG8_SCHED;
            PG8_LDA(At, 1, 1); PG8_STAGE(PG8_SB(1, 0), rsB, b3, voffB); PG8_STAGE(PG8_SB(1, 1), rsB, b3 + hsB, voffB); PG8_STAGE(PG8_SA(1, 0), rsA, a3, voffA);
            PG8_WAIT_V(8); PG8_WAIT_L(0); PG8_BAR; PG8_MMA(1, 0, At, B0); PG8_MMA(1, 1, At, B1); PG8_BAR; PG8_SCHED;
        }
        if (wr == 0) PG8_BAR;
        E(acc, cur, wr, wc, fr, fq);
#if defined(PROBE_EPI)
        if (Epi::ID == PROBE_EPI) { asm volatile("" ::: "memory"); E(acc, cur, wr, wc, fr, fq); }
#endif
#if defined(PROBE_ST)
        if constexpr (Epi::ID == 30) { asm volatile("" ::: "memory"); E.probe(acc, cur, wr, wc, fr, fq); }
#endif
        if (!has_next) break;
#pragma unroll
        for (int a = 0; a < 2; ++a)
#pragma unroll
            for (int b = 0; b < 2; ++b)
#pragma unroll
                for (int m = 0; m < 4; ++m)
#pragma unroll
                    for (int n = 0; n < 2; ++n) acc[a][b][m][n] = (f32x4){0.f, 0.f, 0.f, 0.f};
        cur = nxt; cA = nA; cB = nB; ++ui;
        if (wr == 1) PG8_BAR;
    }
    PG8_WAIT_V(0);
    PG8_BAR;
#undef PG8_SA
#undef PG8_SB
#undef PG8_STAGE
#undef PG8_LDA
#undef PG8_LDB
#undef PG8_MMA
#undef PG8_WAIT_V
#undef PG8_WAIT_L
#undef PG8_BAR
#undef PG8_SCHED
}
typedef f32x4 Acc[2][2][4][2];
}

constexpr size_t MiB = 1u << 20;
constexpr size_t WS_CTL = 0, WS_ROWSC0 = 1 * MiB, WS_ROWSS1 = 1 * MiB + 128 * 1024, WS_CBIAS = 1 * MiB + 256 * 1024, WS_GAINS = 1 * MiB + 264 * 1024, WS_STATS = 2 * MiB, ZERO_BYTES = 3 * MiB;
constexpr size_t WS_WRIN = 3 * MiB, WS_WROUT = 15 * MiB, WS_WG1 = 19 * MiB, WS_WP1 = 21 * MiB;
constexpr size_t WS_X2 = 22 * MiB;
constexpr size_t WS_XB = 150 * MiB;
constexpr size_t WS_PB0 = 214 * MiB;
constexpr size_t WS_KC = 230 * MiB, WS_VC = 246 * MiB, WS_KS = 262 * MiB, WS_VS = 278 * MiB, WS_KW = 294 * MiB, WS_VW = 310 * MiB;
constexpr size_t WS_G = 326 * MiB, WS_E0 = 332 * MiB, WS_ATT = 396 * MiB;
constexpr size_t WS_COS = 470 * MiB, WS_SIN = 472 * MiB, WS_COST = 102 * MiB, WS_SINT = 104 * MiB;
constexpr size_t WS_WNIN = 474 * MiB, WS_WNOUT = 482 * MiB, WS_WG0 = 484 * MiB, WS_WP0 = 486 * MiB, WS_WC1K = 487 * MiB, WS_WC1V = 488 * MiB, WS_WC2K = 489 * MiB, WS_WC2V = 489 * MiB + 65536, WS_WGT = 490 * MiB;
constexpr size_t WS_HID = 492 * MiB, WS_KCC = 500 * MiB, WS_VCC = 501 * MiB;
constexpr size_t WS_X1B = 230 * MiB;
constexpr size_t WS_QP = 214 * MiB, WS_KTP = 278 * MiB, WS_VT = 342 * MiB, WS_PT = 470 * MiB, WS_PB1 = 22 * MiB;
constexpr size_t WS_X3B = 342 * MiB, WS_E1 = 38 * MiB;
constexpr size_t WS_END = 512 * MiB;
constexpr size_t DO_Q = 0, DO_Z = 64 * MiB;
constexpr int CW_BAR = 4096;
constexpr int RING_BYTES = 131072, LDSCTL_OFF = 150016, MISC_OFF = LDSCTL_OFF + 320, LDS_GATE = 151552, LDS_BYTES = 154624;
constexpr int NWAVES = 8;


namespace epi {
using pg8::Unit; using pg8::Acc;
__device__ __forceinline__ u32x4 pack8(const f32x4& a, const f32x4& b) { u32x4 w; w.x = cvt_pk_bf16(a[0], a[1]); w.y = cvt_pk_bf16(a[2], a[3]); w.z = cvt_pk_bf16(b[0], b[1]); w.w = cvt_pk_bf16(b[2], b[3]); return w; }
__device__ __forceinline__ void unpack8(const u32x4& w, f32x4& a, f32x4& b) { a[0] = bf_lo(w.x); a[1] = bf_hi(w.x); a[2] = bf_lo(w.y); a[3] = bf_hi(w.y); b[0] = bf_lo(w.z); b[1] = bf_hi(w.z); b[2] = bf_lo(w.w); b[3] = bf_hi(w.w); }
__device__ __forceinline__ float dot4(const f32x4& a) { return (a[0] * a[0] + a[1] * a[1]) + (a[2] * a[2] + a[3] * a[3]); }

struct Bf16Plain {
    static constexpr int ID = 10;
    static constexpr bool PERM = true;
    bf16_t* O; int ldc; int col0;
    __device__ __forceinline__ void operator()(const Acc& acc, const Unit& u, int wr, int wc, int fr, int fq) const {
#pragma unroll
        for (int ai = 0; ai < 2; ++ai)
#pragma unroll
            for (int m = 0; m < 4; ++m) { const int row = u.pm * 256 + ai * 128 + wr * 64 + m * 16 + fr; bf16_t* rp = O + (size_t)row * ldc + (u.pn * 256 - col0 + wc * 32 + fq * 8);
#pragma unroll
                for (int bj = 0; bj < 2; ++bj) st_nt((u32x4*)(rp + bj * 128), (u32x4)(pack8(acc[ai][bj][m][0], acc[ai][bj][m][1]))); }
    }
};
struct Cmp1 {
    static constexpr int ID = 20;
    static constexpr bool PERM = true;
    unsigned char* ws;
    __device__ __forceinline__ void operator()(const Acc& acc, const Unit& u, int wr, int wc, int fr, int fq) const {
        bf16_t* H = (bf16_t*)(ws + WS_HID);
        const float* bb = (const float*)(ws + WS_CBIAS) + (u.pm >> 5) * 256;
        f32x4 bv[2][2];
#pragma unroll
        for (int bj = 0; bj < 2; ++bj)
#pragma unroll
            for (int n = 0; n < 2; ++n) bv[bj][n] = *(const f32x4*)(bb + bj * 128 + wc * 32 + fq * 8 + n * 4);
#pragma unroll
        for (int ai = 0; ai < 2; ++ai)
#pragma unroll
            for (int m = 0; m < 4; ++m) { const int row = u.pm * 256 + ai * 128 + wr * 64 + m * 16 + fr; bf16_t* rp = H + (size_t)row * 256 + (wc * 32 + fq * 8);
#pragma unroll
                for (int bj = 0; bj < 2; ++bj) { f32x4 v0 = acc[ai][bj][m][0] + bv[bj][0], v1 = acc[ai][bj][m][1] + bv[bj][1];
#pragma unroll
                    for (int x = 0; x < 4; ++x) { v0[x] = siluf_(v0[x]); v1[x] = siluf_(v1[x]); }
                    *(u32x4*)(rp + bj * 128) = pack8(v0, v1); } }
    }
};
struct NsaIn {
    static constexpr int ID = 30;
    static constexpr bool PERM = true;
    unsigned char* ws; unsigned char* dout;
    __device__ __forceinline__ void operator()(const Acc& acc, const Unit& u, int wr, int wc, int fr, int fq) const {
        const int pn = u.pn;
        const float* rowscale = (const float*)(ws + WS_ROWSC0); const float* gains = (const float*)(ws + WS_GAINS);
        const float *q_g = gains, *ks_g = gains + 128, *kw_g = gains + 192;
        bf16_t* Q = (bf16_t*)(dout + DO_Q); bf16_t* Z = (bf16_t*)(dout + DO_Z);
        const bool normed = (pn < 4) || pn == 6 || pn == 8;
        f32x4 gq[2][2];
        if (normed) { const float* gp = (pn < 4) ? q_g : (pn == 6 ? ks_g : kw_g); const float sc = (pn < 4) ? 0.125f * LOG2E : 1.0f;
#pragma unroll
            for (int bj = 0; bj < 2; ++bj)
#pragma unroll
                for (int n = 0; n < 2; ++n) gq[bj][n] = *(const f32x4*)(gp + bj * 32 + fq * 8 + n * 4) * sc; }
        bf16_t* dst; int ldc, cbase;
        if (pn < 4) { dst = Q; ldc = 1024; cbase = pn * 256; }
        else if (pn < 10) { dst = (bf16_t*)(ws + WS_KC + (size_t)(pn - 4) * (16 * MiB)); ldc = 256; cbase = 0; }
        else { dst = Z; ldc = 1024; cbase = (pn - 10) * 256; }
        float rsc[8];
#pragma unroll
        for (int i = 0; i < 8; ++i) rsc[i] = rowscale[u.pm * 256 + (i >> 2) * 128 + wr * 64 + (i & 3) * 16 + fr];
#pragma unroll
        for (int ai = 0; ai < 2; ++ai)
#pragma unroll
            for (int m = 0; m < 4; ++m) {
                const int row = u.pm * 256 + ai * 128 + wr * 64 + m * 16 + fr; const float s = rsc[ai * 4 + m];
                f32x4 v[2][2];
#pragma unroll
                for (int bj = 0; bj < 2; ++bj)
#pragma unroll
                    for (int n = 0; n < 2; ++n) v[bj][n] = acc[ai][bj][m][n] * s;
                if (normed) { float ss = (dot4(v[0][0]) + dot4(v[0][1])) + (dot4(v[1][0]) + dot4(v[1][1]));
                    ss += __shfl_xor(ss, 16); ss += __shfl_xor(ss, 32);
                    const float rn = __builtin_amdgcn_rsqf(ss * (1.0f / 64.0f) + RMS_EPS);
#pragma unroll
                    for (int bj = 0; bj < 2; ++bj)
#pragma unroll
                        for (int n = 0; n < 2; ++n) v[bj][n] = v[bj][n] * rn * gq[bj][n]; }
                else if (pn >= 10) {
#pragma unroll
                    for (int bj = 0; bj < 2; ++bj)
#pragma unroll
                        for (int n = 0; n < 2; ++n)
#pragma unroll
                            for (int x = 0; x < 4; ++x) v[bj][n][x] = siluf_(v[bj][n][x]); }
                bf16_t* rp = dst + (size_t)row * ldc + cbase + wc * 64 + fq * 8;
#pragma unroll
                for (int bj = 0; bj < 2; ++bj) st_nt((u32x4*)(rp + bj * 32), (u32x4)(pack8(v[bj][0], v[bj][1])));
            }
    }
#if defined(PROBE_ST)
    __device__ __forceinline__ void probe(const Acc& acc, const Unit& u, int wr, int wc, int fr, int fq) const {
        bf16_t* base = (bf16_t*)(ws + WS_E1);
#pragma unroll
        for (int ai = 0; ai < 2; ++ai)
#pragma unroll
            for (int m = 0; m < 4; ++m) {
                const int row = (PROBE_ST == 1) ? (int)blockIdx.x * 16 + fr : u.pm * 256 + ai * 128 + wr * 64 + m * 16 + fr;
                bf16_t* rp = base + (size_t)row * 1024 + (u.pn & 3) * 256 + wc * 64 + fq * 8;
#pragma unroll
                for (int bj = 0; bj < 2; ++bj) {
#if PROBE_ST == 3
                    __builtin_nontemporal_store(pack8(acc[ai][bj][m][0], acc[ai][bj][m][1]), (u32x4*)(rp + bj * 32));
#else
                    st_nt((u32x4*)(rp + bj * 32), (u32x4)(pack8(acc[ai][bj][m][0], acc[ai][bj][m][1])));
#endif
                }
            }
    }
#endif
};
template <int LAYER> struct Res {
    static constexpr int ID = 40 + LAYER;
    static constexpr bool PERM = true;
    const float* x; unsigned char* ws;
    __device__ __forceinline__ void operator()(const Acc& acc, const Unit& u, int wr, int wc, int fr, int fq) const {
        const bf16_t* xinb = (const bf16_t*)(ws + WS_XB); bf16_t* xb = (bf16_t*)(ws + (LAYER == 0 ? WS_X1B : WS_X3B));
        const unsigned base = (unsigned)(u.pm * 256 + wr * 64 + fr) * 1024u + (unsigned)(u.pn * 256 + wc * 32 + fq * 8);
        f32x4 ra[2][4], rc[2][4]; u32x4 rb[2][4];
#define RES_ISSUE(k) { _Pragma("unroll") for (int mm = 0; mm < 2; ++mm) _Pragma("unroll") for (int bj = 0; bj < 2; ++bj) { \
            const unsigned off = base + (unsigned)((((k) >> 1) * 128 + (((k) & 1) * 2 + mm) * 16) * 1024 + bj * 128); \
            if (LAYER == 0) { ra[(k) & 1][mm * 2 + bj] = *(const f32x4*)(x + off); rc[(k) & 1][mm * 2 + bj] = *(const f32x4*)(x + off + 4); } \
            else rb[(k) & 1][mm * 2 + bj] = *(const u32x4*)(xinb + off); } }
        RES_ISSUE(0)
#pragma unroll
        for (int k = 0; k < 4; ++k) {
            if (k < 3) RES_ISSUE(k + 1)
            const int ai = k >> 1;
#pragma unroll
            for (int mm = 0; mm < 2; ++mm) { const int m = (k & 1) * 2 + mm;
#pragma unroll
                for (int bj = 0; bj < 2; ++bj) { const unsigned off = base + (unsigned)((ai * 128 + m * 16) * 1024 + bj * 128);
                    f32x4 r0, r1;
                    if (LAYER == 0) { r0 = ra[k & 1][mm * 2 + bj]; r1 = rc[k & 1][mm * 2 + bj]; } else unpack8(rb[k & 1][mm * 2 + bj], r0, r1);
                    *(u32x4*)(xb + off) = pack8(r0 + acc[ai][bj][m][0], r1 + acc[ai][bj][m][1]); } }
        }
#undef RES_ISSUE
    }
};
template <int LAYER> struct Ple {
    static constexpr int ID = 50 + LAYER;
    static constexpr bool PERM = true; static constexpr bool NEXT = (LAYER == 0);
    unsigned char* ws; unsigned char* dout;
    __device__ __forceinline__ void operator()(const Acc& acc, const Unit& u, int wr, int wc, int fr, int fq) const {
        const bf16_t* xinb = (const bf16_t*)(ws + (LAYER == 0 ? WS_X1B : WS_X3B)); const bf16_t* E = (const bf16_t*)(ws + (LAYER == 0 ? WS_E0 : WS_E1));
        float* xout = (float*)dout; bf16_t* xb = (bf16_t*)(ws + WS_XB); float* rowss = (float*)(ws + WS_ROWSS1);
        const unsigned base = (unsigned)(u.pm * 256 + wr * 64 + fr) * 1024u + (unsigned)(u.pn * 256 + wc * 32 + fq * 8);
        u32x4 eb[2][4], rb[2][4];
#define PLE_ISSUE(k) { _Pragma("unroll") for (int mm = 0; mm < 2; ++mm) _Pragma("unroll") for (int bj = 0; bj < 2; ++bj) { \
            const unsigned off = base + (unsigned)((((k) >> 1) * 128 + (((k) & 1) * 2 + mm) * 16) * 1024 + bj * 128); \
            eb[(k) & 1][mm * 2 + bj] = *(const u32x4*)(E + off); rb[(k) & 1][mm * 2 + bj] = *(const u32x4*)(xinb + off); } }
        PLE_ISSUE(0)
#pragma unroll
        for (int k = 0; k < 4; ++k) {
            if (k < 3) PLE_ISSUE(k + 1)
            const int ai = k >> 1;
#pragma unroll
            for (int mm = 0; mm < 2; ++mm) { const int m = (k & 1) * 2 + mm; float ss = 0.f;
#pragma unroll
                for (int bj = 0; bj < 2; ++bj) { const unsigned off = base + (unsigned)((ai * 128 + m * 16) * 1024 + bj * 128);
                    f32x4 e0, e1, r0, r1; unpack8(eb[k & 1][mm * 2 + bj], e0, e1); unpack8(rb[k & 1][mm * 2 + bj], r0, r1);
                    f32x4 g0 = acc[ai][bj][m][0], g1 = acc[ai][bj][m][1];
#pragma unroll
                    for (int x = 0; x < 4; ++x) { g0[x] = sigmoidf_(g0[x]); g1[x] = sigmoidf_(g1[x]); }
                    const f32x4 o0 = r0 + g0 * e0, o1 = r1 + g1 * e1;
                    if (NEXT) { *(u32x4*)(xb + off) = pack8(o0, o1); ss += dot4(o0) + dot4(o1); }
                    else { st_nt((f32x4*)(xout + off), (f32x4)(o0)); st_nt((f32x4*)(xout + off + 4), (f32x4)(o1)); } }
                if (NEXT) { ss += __shfl_xor(ss, 16); ss += __shfl_xor(ss, 32); if (fq == 0) atomicAdd(rowss + (u.pm * 256 + ai * 128 + wr * 64 + m * 16 + fr), ss); } }
        }
#undef PLE_ISSUE
    }
};

__device__ __forceinline__ size_t qt_index(int b, int tok, int h, int d) { return ((((size_t)(b * 128 + (tok >> 5)) * 4 + h) * 16 + (d >> 4)) * 2 + ((d >> 3) & 1)) * 256 + (tok & 31) * 8 + (d & 7); }
__device__ __forceinline__ size_t tt_index(int bh, int nblk, int row, int tok) { return ((((size_t)bh * nblk + (row >> 5)) * 256 + (tok >> 4)) * 2 + ((tok >> 3) & 1)) * 256 + (row & 31) * 8 + (tok & 7); }
__device__ __forceinline__ float log2_gamma(int h) { return __log2f(1.0f - __builtin_amdgcn_exp2f(-5.0f - (float)h)); }
struct RetQ {
    static constexpr int ID = 60;
    static constexpr bool PERM = true;
    unsigned char* ws;
    __device__ __forceinline__ void operator()(const Acc& acc, const Unit& u, int wr, int wc, int fr, int fq) const {
        const float* rowss = (const float*)(ws + WS_ROWSS1); const float* cosT = (const float*)(ws + WS_COS); const float* sinT = (const float*)(ws + WS_SIN); bf16_t* Qp = (bf16_t*)(ws + WS_QP);
        const int h = u.pn; const float l2g = log2_gamma(h);
        const int rbase = u.pm * 256 + wr * 64 + fr; const int d0 = wc * 32 + fq * 8;
        f32x4 cb[2][4], sb[2][4]; float rs[2][2];
#define RQ_ISSUE(k) { _Pragma("unroll") for (int mm = 0; mm < 2; ++mm) { const int row = rbase + ((k) >> 1) * 128 + (((k) & 1) * 2 + mm) * 16; const int pos = row & (SEQ - 1); \
            rs[(k) & 1][mm] = rowss[row]; \
            _Pragma("unroll") for (int n = 0; n < 2; ++n) { cb[(k) & 1][mm * 2 + n] = *(const f32x4*)(cosT + (size_t)pos * 128 + d0 + n * 4); sb[(k) & 1][mm * 2 + n] = *(const f32x4*)(sinT + (size_t)pos * 128 + d0 + n * 4); } } }
        RQ_ISSUE(0)
#pragma unroll
        for (int k = 0; k < 4; ++k) {
            if (k < 3) RQ_ISSUE(k + 1)
            const int ai = k >> 1;
#pragma unroll
            for (int mm = 0; mm < 2; ++mm) { const int m = (k & 1) * 2 + mm; const int row = rbase + ai * 128 + m * 16;
                const float s = __builtin_amdgcn_rsqf(rs[k & 1][mm] * (1.0f / 1024.0f) + RMS_EPS);
                const int pos = row & (SEQ - 1), il = row & 127; const float dec = __builtin_amdgcn_exp2f((float)(il + 1) * l2g) * s;
                f32x4 y1[2], y2[2];
#pragma unroll
                for (int n = 0; n < 2; ++n) { const f32x4 c4 = cb[k & 1][mm * 2 + n], s4 = sb[k & 1][mm * 2 + n];
                    const f32x4 x1 = acc[ai][0][m][n], x2 = acc[ai][1][m][n]; y1[n] = (x1 * c4 - x2 * s4) * dec; y2[n] = (x1 * s4 + x2 * c4) * dec; }
                bf16_t* rp = Qp + qt_index(row >> 12, pos, h, d0);
                st_nt((u32x4*)rp, (u32x4)(pack8(y1[0], y1[1]))); st_nt((u32x4*)(rp + 8 * 512), (u32x4)(pack8(y2[0], y2[1]))); }
        }
#undef RQ_ISSUE
    }
};
struct RetKV {
    static constexpr int ID = 70;
    static constexpr bool PERM = false;
    unsigned char* ws; unsigned char* dout;
    __device__ __forceinline__ void operator()(const Acc& acc, const Unit& u, int wr, int wc, int fr, int fq) const {
        const float* rowss = (const float*)(ws + WS_ROWSS1); const float* cosT = (const float*)(ws + WS_COST); const float* sinT = (const float*)(ws + WS_SINT);
        bf16_t* Kp = (bf16_t*)dout; bf16_t* Ktp = (bf16_t*)(ws + WS_KTP); bf16_t* Vt = (bf16_t*)(ws + WS_VT);
        const int pn = u.pn; const bool isk = pn < 8; const int h = isk ? pn - 4 : (pn - 8) >> 1; const int ebase = isk ? 0 : ((pn - 8) & 1) * 256;
        const float l2g = log2_gamma(h);
#pragma unroll
        for (int ai = 0; ai < 2; ++ai)
#pragma unroll
            for (int m = 0; m < 4; ++m) { const int row0 = u.pm * 256 + ai * 128 + wr * 64 + m * 16 + fq * 4; const int b = row0 >> 12, t0 = row0 & (SEQ - 1);
                f32x4 s4 = *(const f32x4*)(rowss + row0);
#pragma unroll
                for (int x = 0; x < 4; ++x) s4[x] = __builtin_amdgcn_rsqf(s4[x] * (1.0f / 1024.0f) + RMS_EPS);
                if (isk) {
                    f32x4 kd;
#pragma unroll
                    for (int x = 0; x < 4; ++x) kd[x] = __builtin_amdgcn_exp2f((float)(127 - ((t0 + x) & 127)) * l2g) * 0.0625f * s4[x];
#pragma unroll
                    for (int n = 0; n < 2; ++n) { const int d = wc * 32 + n * 16 + fr;
                        const f32x4 c4 = *(const f32x4*)(cosT + (size_t)d * SEQ + t0), s4r = *(const f32x4*)(sinT + (size_t)d * SEQ + t0);
                        const f32x4 x1 = acc[ai][0][m][n], x2 = acc[ai][1][m][n];
                        const f32x4 y1 = (x1 * c4 - x2 * s4r) * kd, y2 = (x1 * s4r + x2 * c4) * kd;
                        u32x2 w1, w2; w1.x = cvt_pk_bf16(y1[0], y1[1]); w1.y = cvt_pk_bf16(y1[2], y1[3]); w2.x = cvt_pk_bf16(y2[0], y2[1]); w2.y = cvt_pk_bf16(y2[2], y2[3]);
                        bf16_t* tp = Ktp + tt_index(b * 4 + h, 8, d, t0); st_nt((u32x2*)tp, (u32x2)(w1)); st_nt((u32x2*)(tp + (size_t)4 * 256 * 512), (u32x2)(w2));
                        bf16_t* rp = Kp + qt_index(b, t0, h, d);
                        rp[0] = (bf16_t)(w1.x & 0xffffu); rp[8] = (bf16_t)(w1.x >> 16); rp[16] = (bf16_t)(w1.y & 0xffffu); rp[24] = (bf16_t)(w1.y >> 16);
                        rp[8 * 512] = (bf16_t)(w2.x & 0xffffu); rp[8 * 512 + 8] = (bf16_t)(w2.x >> 16); rp[8 * 512 + 16] = (bf16_t)(w2.y & 0xffffu); rp[8 * 512 + 24] = (bf16_t)(w2.y >> 16); }
                } else {
#pragma unroll
                    for (int bj = 0; bj < 2; ++bj)
#pragma unroll
                        for (int n = 0; n < 2; ++n) { const int e = ebase + bj * 128 + wc * 32 + n * 16 + fr; const f32x4 v = acc[ai][bj][m][n] * s4;
                            u32x2 w; w.x = cvt_pk_bf16(v[0], v[1]); w.y = cvt_pk_bf16(v[2], v[3]);
                            st_nt((u32x2*)(Vt + tt_index(b * 4 + h, 16, e, t0)), (u32x2)(w)); }
                }
                if (m & 1) asm volatile("" ::: "memory"); }
    }
};
struct RetZ {
    static constexpr int ID = 80;
    static constexpr bool PERM = true;
    unsigned char* ws; unsigned char* dout;
    __device__ __forceinline__ void operator()(const Acc& acc, const Unit& u, int wr, int wc, int fr, int fq) const {
        const float* rowss = (const float*)(ws + WS_ROWSS1); const float* stats = (const float*)(ws + WS_STATS); bf16_t* O = (bf16_t*)dout;
        const int zt = u.pn - 16, h = zt >> 1;
        const int rbase = u.pm * 256 + wr * 64 + fr;
        const unsigned obase = (unsigned)rbase * 2048u + (unsigned)(zt * 256 + wc * 32 + fq * 8);
        const float* sp0 = stats + ((size_t)((rbase >> 12) * 4 + h) * 2) * SEQ + (rbase & (SEQ - 1));
        u32x4 ob[2][4]; float rs[2][2], s0[2][2], s1[2][2];
#define RZ_ISSUE(k) { _Pragma("unroll") for (int mm = 0; mm < 2; ++mm) { const int ro = ((k) >> 1) * 128 + (((k) & 1) * 2 + mm) * 16; \
            rs[(k) & 1][mm] = rowss[rbase + ro]; s0[(k) & 1][mm] = sp0[ro]; s1[(k) & 1][mm] = sp0[SEQ + ro]; \
            _Pragma("unroll") for (int bj = 0; bj < 2; ++bj) ob[(k) & 1][mm * 2 + bj] = *(const u32x4*)(O + obase + (unsigned)(ro * 2048 + bj * 128)); } }
        RZ_ISSUE(0)
#pragma unroll
        for (int k = 0; k < 4; ++k) {
            if (k < 3) RZ_ISSUE(k + 1)
            const int ai = k >> 1;
#pragma unroll
            for (int mm = 0; mm < 2; ++mm) { const int m = (k & 1) * 2 + mm; const int ro = ai * 128 + m * 16;
                const float s = __builtin_amdgcn_rsqf(rs[k & 1][mm] * (1.0f / 1024.0f) + RMS_EPS);
                const float mu = s0[k & 1][mm] * (1.0f / 512.0f); float var = s1[k & 1][mm] * (1.0f / 512.0f) - mu * mu; var = var > 0.f ? var : 0.f; const float rstd = __builtin_amdgcn_rsqf(var + GN_EPS);
#pragma unroll
                for (int bj = 0; bj < 2; ++bj) { bf16_t* p = O + obase + (unsigned)(ro * 2048 + bj * 128);
                    f32x4 o0, o1; unpack8(ob[k & 1][mm * 2 + bj], o0, o1); f32x4 z0 = acc[ai][bj][m][0] * s, z1 = acc[ai][bj][m][1] * s;
#pragma unroll
                    for (int x = 0; x < 4; ++x) { z0[x] = siluf_(z0[x]); z1[x] = siluf_(z1[x]); }
                    o0 = (o0 - mu) * rstd * z0; o1 = (o1 - mu) * rstd * z1; *(u32x4*)p = pack8(o0, o1); } }
        }
#undef RZ_ISSUE
    }
};
}
#define RLX_AGENT __ATOMIC_RELAXED, __HIP_MEMORY_SCOPE_AGENT
#define LDS_WAIT() asm volatile("s_waitcnt lgkmcnt(0)" ::: "memory")
#define VM_WAIT() asm volatile("s_waitcnt vmcnt(0)" ::: "memory")

#define XB_TMO      128
#define XB_XCNT(j)  (256  + 64 * (j))
#define XB_XSUB(j)  (1280 + 64 * (j))
#define XB_XGEN(j)  (2304 + 64 * (j))
#define XB_TOP      3328
#define XB_TOPGEN   3392
#define XCD_BAR_WORDS 3456
#define XB_SPIN_CAP (1u << 23)
__device__ __forceinline__ unsigned xb_ld(unsigned* p)              { return __hip_atomic_load(p, __ATOMIC_RELAXED, __HIP_MEMORY_SCOPE_AGENT); }
__device__ __forceinline__ unsigned xb_add(unsigned* p, unsigned v) { return __hip_atomic_fetch_add(p, v, __ATOMIC_RELAXED, __HIP_MEMORY_SCOPE_AGENT); }
__device__ __forceinline__ unsigned xb_xcc_id() { return (unsigned)__builtin_amdgcn_s_getreg((3 << 11) | 20) & 0xFu; }
#define XB_SPIN(cond, bar) do { unsigned _sp = 0; while (cond) { __builtin_amdgcn_s_sleep(1); \
    if ((++_sp & 255u) == 0u) { if (xb_ld(&(bar)[XB_TMO])) break; if (_sp > XB_SPIN_CAP) { atomicAdd(&(bar)[XB_TMO], 1u); break; } } } } while (0)
struct XcdBarrier { unsigned* bar; unsigned x; volatile LAS unsigned* st; int wave; };
__device__ __forceinline__ XcdBarrier xcd_barrier_post(unsigned* bar, volatile LAS unsigned* st, int wave) {
    XcdBarrier b; b.bar = bar; b.x = xb_xcc_id(); b.st = st; b.wave = wave;
    if (wave == 0 && lane_id() == 0) (void)xb_add(&bar[XB_XCNT(b.x)], 1u);
    return b;
}
__device__ __forceinline__ void xcd_barrier_complete(unsigned* bar, unsigned x, unsigned& nloc, unsigned& nx) {
    const unsigned G = gridDim.x * gridDim.y * gridDim.z;
    unsigned sum, cnt, mine, sp = 0u;
    for (;;) {
        sum = 0u; cnt = 0u; mine = 0u;
#pragma unroll
        for (unsigned j = 0; j < 16; ++j) { const unsigned c = xb_ld(&bar[XB_XCNT(j)]); sum += c; cnt += (c > 0u) ? 1u : 0u; mine = (j == x) ? c : mine; }
        if (sum == G) break;
        __builtin_amdgcn_s_sleep(1);
        if ((++sp & 255u) == 0u) { if (xb_ld(&bar[XB_TMO])) break; if (sp > XB_SPIN_CAP) { atomicAdd(&bar[XB_TMO], 1u); break; } }
    }
    nloc = mine > 0u ? mine : 1u; nx = cnt > 0u ? cnt : 1u;
}
__device__ __forceinline__ void xcd_barrier(const XcdBarrier& b) {
    asm volatile("s_waitcnt vmcnt(0)" ::: "memory");
    __syncthreads();
    if (b.wave == 0 && lane_id() == 0) {
        unsigned* bar = b.bar;
        __builtin_amdgcn_s_waitcnt(0);
        unsigned nloc = b.st[0], nx = b.st[1];
        if (nloc == 0u) { xcd_barrier_complete(bar, b.x, nloc, nx); b.st[0] = nloc; b.st[1] = nx; }
        const unsigned old = xb_add(&bar[XB_XSUB(b.x)], 1u);
        const unsigned gen = old / nloc;
        if (old + 1u == (gen + 1u) * nloc) {
            __builtin_amdgcn_fence(__ATOMIC_RELEASE, "agent");
            asm volatile("s_waitcnt vmcnt(0)" ::: "memory");
            const unsigned og = xb_add(&bar[XB_TOP], 1u);
            const unsigned tg = og / nx;
            if (og + 1u == (tg + 1u) * nx) xb_add(&bar[XB_TOPGEN], 1u);
            else XB_SPIN(xb_ld(&bar[XB_TOPGEN]) == tg, bar);
            __builtin_amdgcn_fence(__ATOMIC_ACQUIRE, "agent");
            xb_add(&bar[XB_XGEN(b.x)], 1u);
            asm volatile("s_waitcnt vmcnt(0)" ::: "memory");
        } else {
            XB_SPIN(xb_ld(&bar[XB_XGEN(b.x)]) == gen, bar);
            __builtin_amdgcn_fence(__ATOMIC_ACQUIRE, "agent");
            asm volatile("s_waitcnt vmcnt(0)" ::: "memory");
        }
    }
    __syncthreads();
}

struct Frame {
    LAS unsigned char* lds;
    volatile LAS unsigned* MISC;
    unsigned* ctl;
    int wave, vcu, G;
    unsigned char* out; unsigned char* ws;
};
struct Args { const float* in[19]; unsigned char* out; unsigned char* ws; int ph_lo, ph_hi; };
__device__ __forceinline__ float wave_sum(float v) {
#pragma unroll
    for (int o = 1; o < 64; o <<= 1) v += __shfl_xor(v, o);
    return v;
}
__device__ __forceinline__ void tr_item(const float* W, int ldw, int K, int k0, int srcc, bf16_t* WT, int drow, const float* gain, LAS float* scr, int lane) {
    float wv[32];
#pragma unroll
    for (int i = 0; i < 32; ++i) { const int kk = 2 * i + (lane >> 5); wv[i] = W[(size_t)(k0 + kk) * ldw + srcc + (lane & 31)]; }
#pragma unroll
    for (int i = 0; i < 32; ++i) { const int kk = 2 * i + (lane >> 5); float w = wv[i]; if (gain) w *= gain[k0 + kk]; scr[kk * 33 + (lane & 31)] = w; }
    LDS_WAIT(); asm volatile("" ::: "memory");
    const int c = lane & 7;
#pragma unroll
    for (int j = 0; j < 4; ++j) { const int n = (lane >> 3) + 8 * j; const LAS float* s = scr + (8 * c) * 33 + n;
        u32x4 o; o.x = cvt_pk_bf16(s[0 * 33], s[1 * 33]); o.y = cvt_pk_bf16(s[2 * 33], s[3 * 33]); o.z = cvt_pk_bf16(s[4 * 33], s[5 * 33]); o.w = cvt_pk_bf16(s[6 * 33], s[7 * 33]);
        *(u32x4*)(WT + (size_t)(drow + n) * K + k0 + 8 * c) = o; }
    LDS_WAIT(); asm volatile("" ::: "memory");
}
__device__ __forceinline__ void cvt_rows(Frame& F, const float* src, bf16_t* dst, size_t n8) {
    const size_t nthr = (size_t)F.G * 512;
    for (size_t i = (size_t)F.vcu * 512 + F.wave * 64 + lane_id(); i < n8; i += 8 * nthr) { f32x4 a[8], b[8];
#pragma unroll
        for (int j = 0; j < 8; ++j) if (i + j * nthr < n8) { a[j] = *(const f32x4*)(src + (i + j * nthr) * 8); b[j] = *(const f32x4*)(src + (i + j * nthr) * 8 + 4); }
#pragma unroll
        for (int j = 0; j < 8; ++j) if (i + j * nthr < n8) *(u32x4*)(dst + (i + j * nthr) * 8) = epi::pack8(a[j], b[j]); }
}
__device__ __forceinline__ void p0_prologue(Frame& F, const Args& A, bool first = true) {
    LAS float* scr = (LAS float*)(F.lds + F.wave * 16384);
    const int gw = F.vcu * NWAVES + F.wave, NGW = F.G * NWAVES, lane = lane_id();
    unsigned char* ws = F.ws;
    constexpr int I0 = 16 * 112, I1 = 512, I2 = 512, I3 = 512, I4 = 128, I5 = 128, I6 = 16 * 192, I7 = 32 * 32, I8 = 32 * 8, I9 = 32 * 8, I10 = 8, I11 = 8, I12 = 16 * 2;
    constexpr int NITEMS = I0 + I1 + I2 + I3 + I4 + I5 + I6 + I7 + I8 + I9 + I10 + I11 + I12;
    for (int it = gw; it < NITEMS; it += NGW) {
        int r = it;
        if (r < I0) { const int kb = r / 112, gi = r % 112, pn = gi >> 3, gg = gi & 7, bj = gg >> 2, wc = gg & 3; int srcc;
            if (pn < 4) srcc = pn * 256 + wc * 64 + bj * 32; else if (pn < 10) srcc = 1024 + (pn - 4) * 256 + wc * 64 + bj * 32; else srcc = 2608 + (pn - 10) * 256 + wc * 64 + bj * 32;
            tr_item(A.in[3], 3632, 1024, 64 * kb, srcc, (bf16_t*)(ws + WS_WNIN), 32 * gi, A.in[2], scr, lane); continue; } r -= I0;
        if (r < I1) { tr_item(A.in[14], 1024, 1024, 64 * (r / 32), 32 * (r % 32), (bf16_t*)(ws + WS_WNOUT), 32 * (r % 32), nullptr, scr, lane); continue; } r -= I1;
        if (r < I2) { tr_item(A.in[18], 1024, 1024, 64 * (r / 32), 32 * (r % 32), (bf16_t*)(ws + WS_WG0), 32 * (r % 32), nullptr, scr, lane); continue; } r -= I2;
        if (r < I3) { tr_item(A.in[18] + (size_t)1024 * 1024, 1024, 1024, 64 * (r / 32), 32 * (r % 32), (bf16_t*)(ws + WS_WG1), 32 * (r % 32), nullptr, scr, lane); continue; } r -= I3;
        if (r < I4) { tr_item(A.in[17], 1024, 256, 64 * (r / 32), 32 * (r % 32), (bf16_t*)(ws + WS_WP0), 32 * (r % 32), nullptr, scr, lane); continue; } r -= I4;
        if (r < I5) { tr_item(A.in[17] + (size_t)256 * 1024, 1024, 256, 64 * (r / 32), 32 * (r % 32), (bf16_t*)(ws + WS_WP1), 32 * (r % 32), nullptr, scr, lane); continue; } r -= I5;
        if (r < I6) { tr_item(A.in[15], 6144, 1024, 64 * (r / 192), 32 * (r % 192), (bf16_t*)(ws + WS_WRIN), 32 * (r % 192), A.in[2] + 1024, scr, lane); continue; } r -= I6;
        if (r < I7) { tr_item(A.in[16], 1024, 2048, 64 * (r / 32), 32 * (r % 32), (bf16_t*)(ws + WS_WROUT), 32 * (r % 32), nullptr, scr, lane); continue; } r -= I7;
        if (r < I8) { tr_item(A.in[10], 256, 2048, 64 * (r / 8), 32 * (r % 8), (bf16_t*)(ws + WS_WC1K), 32 * (r % 8), nullptr, scr, lane); continue; } r -= I8;
        if (r < I9) { tr_item(A.in[12], 256, 2048, 64 * (r / 8), 32 * (r % 8), (bf16_t*)(ws + WS_WC1V), 32 * (r % 8), nullptr, scr, lane); continue; } r -= I9;
        if (r < I10) { tr_item(A.in[11], 64, 256, 64 * (r / 2), 32 * (r % 2), (bf16_t*)(ws + WS_WC2K), 32 * (r % 2), nullptr, scr, lane); continue; } r -= I10;
        if (r < I11) { tr_item(A.in[13], 64, 256, 64 * (r / 2), 32 * (r % 2), (bf16_t*)(ws + WS_WC2V), 32 * (r % 2), nullptr, scr, lane); continue; } r -= I11;
        tr_item(A.in[3], 3632, 1024, 64 * (r / 2), 2560 + 32 * (r % 2), (bf16_t*)(ws + WS_WGT), 32 * (r % 2), A.in[2], scr, lane);
    }
    { const float* x = A.in[0]; bf16_t* xb = (bf16_t*)(ws + WS_XB); float* rs = (float*)(ws + WS_ROWSC0);
      for (int m = gw; m < T_TOK; m += 4 * NGW) { f32x4 v[4][4]; float s[4];
#pragma unroll
          for (int q = 0; q < 4; ++q) { const int mq = (m + q * NGW < T_TOK) ? m + q * NGW : m; const f32x4* xr = (const f32x4*)(x + (size_t)mq * DM) + lane;
#pragma unroll
              for (int j = 0; j < 4; ++j) v[q][j] = xr[64 * j]; }
#pragma unroll
          for (int q = 0; q < 4; ++q) { float a = 0.f;
#pragma unroll
              for (int j = 0; j < 4; ++j) a += epi::dot4(v[q][j]);
              s[q] = wave_sum(a); }
#pragma unroll
          for (int q = 0; q < 4; ++q) if (m + q * NGW < T_TOK) { const int mq = m + q * NGW; u32x2* o8 = (u32x2*)(xb + (size_t)mq * DM) + lane;
#pragma unroll
              for (int j = 0; j < 4; ++j) { u32x2 w; w.x = cvt_pk_bf16(v[q][j][0], v[q][j][1]); w.y = cvt_pk_bf16(v[q][j][2], v[q][j][3]); o8[64 * j] = w; }
              if (lane == 0) rs[mq] = __builtin_amdgcn_rsqf(s[q] * (1.0f / DM) + RMS_EPS); } } }
    cvt_rows(F, A.in[1], (bf16_t*)(ws + WS_PB0), (size_t)T_TOK * 256 / 8);
    cvt_rows(F, A.in[1] + (size_t)T_TOK * 256, (bf16_t*)(ws + WS_PB1), (size_t)T_TOK * 256 / 8);
    { float* ct = (float*)(ws + WS_COS); float* st = (float*)(ws + WS_SIN); float* ctt = (float*)(ws + WS_COST); float* stt = (float*)(ws + WS_SINT);
      for (int i = F.vcu * 512 + F.wave * 64 + lane_id(); i < 2 * SEQ * 128; i += F.G * 512) { const bool tr = i >= SEQ * 128; const int ii = tr ? i - SEQ * 128 : i; const int pos = tr ? (ii & (SEQ - 1)) : (ii >> 7), j = tr ? (ii >> 12) : (ii & 127);
          const float inv = (float)exp2(-((double)j / 127.0) * 13.287712379549449);
          const float ang = (float)pos * inv;
          double t = (double)ang * 0.15915494309189535; t -= floor(t);
          const float cv = __builtin_amdgcn_cosf((float)t), sv = __builtin_amdgcn_sinf((float)t);
          if (tr) { ctt[ii] = cv; stt[ii] = sv; } else { ct[ii] = cv; st[ii] = sv; } } }
    if (first) for (int task = gw; task < 512; task += NGW) { const int kv = task >> 8, cb = (task >> 6) & 3, kc = task & 63, col = cb * 64 + lane; const float* pos = kv ? A.in[9] : A.in[8]; const float* w1 = kv ? A.in[12] : A.in[10]; float a = 0.f;
#pragma unroll 8
        for (int k = kc * 32; k < kc * 32 + 32; ++k) a += pos[k] * w1[(size_t)k * 256 + col];
        atomicAdd((float*)(ws + WS_CBIAS) + kv * 256 + col, a); }
    if (gw == NGW - 1) { float* gd = (float*)(ws + WS_GAINS); gd[lane] = A.in[4][lane]; gd[64 + lane] = A.in[5][lane]; gd[128 + lane] = A.in[6][lane]; gd[192 + lane] = A.in[7][lane]; }
}
__device__ __forceinline__ void cmp2_task(Frame& F, int task) {
    const float* kcg = (const float*)(F.ws + WS_GAINS) + 64;
    const int lane = lane_id(), r32 = lane & 31, hi = lane >> 5;
    unsigned char* ws = F.ws;
    {
        const int kv = task >> 8, rb = task & 255;
        const bf16_t* H = (const bf16_t*)(ws + WS_HID) + ((size_t)kv * 8192 + rb * 32) * 256;
        const bf16_t* W2 = (const bf16_t*)(ws + (kv ? WS_WC2V : WS_WC2K));
        f32x16 o0 = {}, o1 = {};
#pragma unroll 4
        for (int ks = 0; ks < 16; ++ks) {
            const bf16x8 hb = *(const bf16x8*)(H + (size_t)r32 * 256 + ks * 16 + hi * 8);
            const bf16x8 w0 = *(const bf16x8*)(W2 + (size_t)r32 * 256 + ks * 16 + hi * 8), w1 = *(const bf16x8*)(W2 + (size_t)(32 + r32) * 256 + ks * 16 + hi * 8);
            o0 = __builtin_amdgcn_mfma_f32_32x32x16_bf16(w0, hb, o0, 0, 0, 0); o1 = __builtin_amdgcn_mfma_f32_32x32x16_bf16(w1, hb, o1, 0, 0, 0);
        }
        if (kv == 0) { float ss = 0.f;
#pragma unroll
            for (int r = 0; r < 16; ++r) ss += o0[r] * o0[r] + o1[r] * o1[r];
            ss += __shfl_xor(ss, 32);
            const float rn = __builtin_amdgcn_rsqf(ss * (1.0f / 64.0f) + RMS_EPS); const float* gp = kcg;
#pragma unroll
            for (int r = 0; r < 16; ++r) { const int c = (r & 3) + 8 * (r >> 2) + 4 * hi; o0[r] *= rn * gp[c]; o1[r] *= rn * gp[32 + c]; } }
        const int rowg = rb * 32 + r32;
        if ((rowg & 255) == 255) { o0 = f32x16{}; o1 = f32x16{}; }
        bf16_t* dst = (bf16_t*)(ws + (kv ? WS_VCC : WS_KCC)) + (size_t)rowg * 64;
#pragma unroll
        for (int a = 0; a < 4; ++a) { u32x2 w; w.x = cvt_pk_bf16(o0[4 * a], o0[4 * a + 1]); w.y = cvt_pk_bf16(o0[4 * a + 2], o0[4 * a + 3]); *(u32x2*)(dst + 8 * a + 4 * hi) = w;
            w.x = cvt_pk_bf16(o1[4 * a], o1[4 * a + 1]); w.y = cvt_pk_bf16(o1[4 * a + 2], o1[4 * a + 3]); *(u32x2*)(dst + 32 + 8 * a + 4 * hi) = w; }
    }
}
__device__ __forceinline__ void gates_task(Frame& F, int task) {
    const int lane = lane_id(), r32 = lane & 31, hi = lane >> 5;
    unsigned char* ws = F.ws;
    const bf16_t* X = (const bf16_t*)(ws + WS_XB) + ((size_t)task * 32 + r32) * 1024 + hi * 32;
    const bf16_t* W = (const bf16_t*)(ws + WS_WGT) + (size_t)r32 * 1024 + hi * 32;
    f32x16 o0 = {}, o1 = {};
#pragma unroll 2
    for (int j = 0; j < 16; ++j) { bf16x8 xf[4], w0[4], w1[4];
#pragma unroll
        for (int s_ = 0; s_ < 4; ++s_) { xf[s_] = *(const bf16x8*)(X + j * 64 + s_ * 8); w0[s_] = *(const bf16x8*)(W + j * 64 + s_ * 8); w1[s_] = *(const bf16x8*)(W + (size_t)32 * 1024 + j * 64 + s_ * 8); }
#pragma unroll
        for (int s_ = 0; s_ < 4; ++s_) { o0 = __builtin_amdgcn_mfma_f32_32x32x16_bf16(w0[s_], xf[s_], o0, 0, 0, 0); o1 = __builtin_amdgcn_mfma_f32_32x32x16_bf16(w1[s_], xf[s_], o1, 0, 0, 0); } }
    const int row = task * 32 + r32; const float s = ((const float*)(ws + WS_ROWSC0))[row];
    float* gp = (float*)(ws + WS_G) + (size_t)row * 48;
#pragma unroll
    for (int a = 0; a < 4; ++a) { f32x4 v;
#pragma unroll
        for (int x = 0; x < 4; ++x) v[x] = sigmoidf_(o0[4 * a + x] * s);
        *(f32x4*)(gp + 8 * a + 4 * hi) = v;
        if (a < 2) {
#pragma unroll
            for (int x = 0; x < 4; ++x) v[x] = sigmoidf_(o1[4 * a + x] * s);
            *(f32x4*)(gp + 32 + 8 * a + 4 * hi) = v; } }
}

namespace nsa {
constexpr int L_KV = 0, L_K = 0, L_V = 24576, L_WSF = 49152, L_ACC = 51200, L_GS = 116736, L_LS = 133120, L_MSK = 149504, L_END = 150016;
constexpr int NSLOT = 3, SLOTB = 8192;
#define NSA_NEG (-INFINITY)
#ifndef ODD_NT
#define ODD_NT 1
#endif
#ifndef WIN_PREFETCH
#define WIN_PREFETCH 0
#endif
__device__ __forceinline__ int crow(int r, int hi) { return (r & 3) + 8 * (r >> 2) + 4 * hi; }
__device__ __forceinline__ void qkt(f32x16& p0, f32x16& p1, const LAS unsigned char* Kslot, const bf16x8* qr, int r32, int hi) {
    const LAS unsigned char* kb = Kslot + hi * 1024 + r32 * 16;
    const f32x16 z = {};
#pragma unroll
    for (int d0 = 0; d0 < 4; ++d0) {
        const bf16x8 b0 = *(const LAS bf16x8*)(kb + d0 * 2048), b1 = *(const LAS bf16x8*)(kb + d0 * 2048 + 512);
        if (d0 == 0) { p0 = __builtin_amdgcn_mfma_f32_32x32x16_bf16(b0, qr[0], z, 0, 0, 0); p1 = __builtin_amdgcn_mfma_f32_32x32x16_bf16(b1, qr[0], z, 0, 0, 0); }
        else { p0 = __builtin_amdgcn_mfma_f32_32x32x16_bf16(b0, qr[d0], p0, 0, 0, 0); p1 = __builtin_amdgcn_mfma_f32_32x32x16_bf16(b1, qr[d0], p1, 0, 0, 0); }
    }
}
__device__ __forceinline__ void pv(f32x16* o, int vb, bf16x8 pa0, bf16x8 pa1, bf16x8 pa2, bf16x8 pa3) {
#pragma unroll
    for (int d0 = 0; d0 < 2; ++d0) { s16x4 lo[4], hi[4];
#pragma unroll
        for (int ks = 0; ks < 4; ++ks) {
            asm volatile("ds_read_b64_tr_b16 %0,%1 offset:%c2" : "=&v"(lo[ks]) : "v"(vb), "i"(d0 * 4096 + ks * 1024) : "memory");
            asm volatile("ds_read_b64_tr_b16 %0,%1 offset:%c2" : "=&v"(hi[ks]) : "v"(vb), "i"(d0 * 4096 + ks * 1024 + 512) : "memory"); }
        asm volatile("s_waitcnt lgkmcnt(0)" ::: "memory"); __builtin_amdgcn_sched_barrier(0);
#define NSA_PK(k) (bf16x8){lo[k][0], lo[k][1], lo[k][2], lo[k][3], hi[k][0], hi[k][1], hi[k][2], hi[k][3]}
        o[d0] = __builtin_amdgcn_mfma_f32_32x32x16_bf16(pa0, NSA_PK(0), o[d0], 0, 0, 0);
        o[d0] = __builtin_amdgcn_mfma_f32_32x32x16_bf16(pa1, NSA_PK(1), o[d0], 0, 0, 0);
        o[d0] = __builtin_amdgcn_mfma_f32_32x32x16_bf16(pa2, NSA_PK(2), o[d0], 0, 0, 0);
        o[d0] = __builtin_amdgcn_mfma_f32_32x32x16_bf16(pa3, NSA_PK(3), o[d0], 0, 0, 0);
#undef NSA_PK
    }
}
__device__ __forceinline__ float rowmax(const f32x16& p0, const f32x16& p1) {
    float a = fmaxf(fmaxf(p0[0], p0[1]), p1[0]), b = fmaxf(fmaxf(p0[2], p0[3]), p1[1]); a = fmaxf(fmaxf(a, p1[2]), p1[3]);
#pragma unroll
    for (int r = 4; r < 16; r += 4) { a = fmaxf(fmaxf(a, p0[r]), p0[r + 1]); b = fmaxf(fmaxf(b, p0[r + 2]), p0[r + 3]); a = fmaxf(fmaxf(a, p1[r]), p1[r + 1]); b = fmaxf(fmaxf(b, p1[r + 2]), p1[r + 3]); }
    const float m = fmaxf(a, b);
    auto rr = __builtin_amdgcn_permlane32_swap(__float_as_uint(m), __float_as_uint(m), false, false);
    return fmaxf(__uint_as_float(rr[0]), __uint_as_float(rr[1]));
}
__device__ __forceinline__ float halfsum(float v) {
    auto rr = __builtin_amdgcn_permlane32_swap(__float_as_uint(v), __float_as_uint(v), false, false);
    return __uint_as_float(rr[0]) + __uint_as_float(rr[1]);
}
__device__ __forceinline__ void row_scale(f32x16 (&o)[2], float f, LAS float* wsf, int r32, int hi) {
    if (hi == 0) wsf[r32] = f;
#pragma unroll
    for (int a = 0; a < 4; ++a) { const f32x4 f4 = *(const LAS f32x4*)(wsf + 8 * a + 4 * hi);
#pragma unroll
        for (int x = 0; x < 4; ++x) { o[0][4 * a + x] *= f4[x]; o[1][4 * a + x] *= f4[x]; } }
}
__device__ __forceinline__ void row_fma(f32x16 (&acc)[2], const f32x16 (&o)[2], float f, LAS float* wsf, int r32, int hi) {
    if (hi == 0) wsf[r32] = f;
#pragma unroll
    for (int a = 0; a < 4; ++a) { const f32x4 f4 = *(const LAS f32x4*)(wsf + 8 * a + 4 * hi);
#pragma unroll
        for (int x = 0; x < 4; ++x) { acc[0][4 * a + x] += o[0][4 * a + x] * f4[x]; acc[1][4 * a + x] += o[1][4 * a + x] * f4[x]; } }
}
__device__ __forceinline__ void softmax_step(f32x16& p0, f32x16& p1, float& m, float& l, f32x16 (&o)[2], LAS float* wsf, int r32, int hi) {
    const float rm = rowmax(p0, p1);
    if (__any(rm > m)) {
        const float mn = fmaxf(m, rm), mu = (mn == NSA_NEG) ? 0.f : mn;
        const float alpha = __builtin_amdgcn_exp2f(m - mu);
        l *= alpha; m = mn;
        row_scale(o, alpha, wsf, r32, hi);
    }
    const float mu = (m == NSA_NEG) ? 0.f : m; float s = 0.f;
#pragma unroll
    for (int r = 0; r < 16; ++r) { p0[r] = __builtin_amdgcn_exp2f(p0[r] - mu); p1[r] = __builtin_amdgcn_exp2f(p1[r] - mu); s += p0[r] + p1[r]; }
    l += s;
}

__device__ __forceinline__ void glds16(const void* sbase, unsigned voff, unsigned lds_dst) { unsigned keep;
    asm volatile("s_mov_b32 %0, m0\n\ts_mov_b32 m0, %3\n\ts_nop 0\n\tglobal_load_lds_dwordx4 %1, %2\n\ts_mov_b32 m0, %0" : "=&s"(keep) : "v"(voff), "s"(sbase), "s"(lds_dst) : "memory"); }
__device__ __forceinline__ float max3f(float a, float b, float c) { float r; asm("v_max3_f32 %0, %1, %2, %3" : "=v"(r) : "v"(a), "v"(b), "v"(c)); return r; }
__device__ __forceinline__ float max2f(float a, float b) { float r; asm("v_max_f32_e32 %0, %1, %2" : "=v"(r) : "v"(a), "v"(b)); return r; }
__device__ __forceinline__ float fadd_s(float a, float b) { float r; asm("v_add_f32_e32 %0, %1, %2" : "=v"(r) : "v"(a), "v"(b)); return r; }
__device__ __forceinline__ float fsub_s(float a, float b) { float r; asm("v_sub_f32_e32 %0, %1, %2" : "=v"(r) : "v"(a), "v"(b)); return r; }
typedef LAS const char* lds_cptr;
typedef short v4i16_t __attribute__((ext_vector_type(4)));
__device__ __forceinline__ void kload8(bf16x8* kf, lds_cptr kp) {
    kf[0] = *(const LAS bf16x8*)(kp);        kf[1] = *(const LAS bf16x8*)(kp + 512);
    kf[2] = *(const LAS bf16x8*)(kp + 2048); kf[3] = *(const LAS bf16x8*)(kp + 2560);
    kf[4] = *(const LAS bf16x8*)(kp + 4096); kf[5] = *(const LAS bf16x8*)(kp + 4608);
    kf[6] = *(const LAS bf16x8*)(kp + 6144); kf[7] = *(const LAS bf16x8*)(kp + 6656); }
__device__ __forceinline__ void kload2(bf16x8* kf, lds_cptr kp, int j) { kf[2 * j] = *(const LAS bf16x8*)(kp + j * 2048); kf[2 * j + 1] = *(const LAS bf16x8*)(kp + j * 2048 + 512); }
__device__ __forceinline__ s16x4 vtr(lds_cptr p) { return __builtin_bit_cast(s16x4, __builtin_amdgcn_ds_read_tr16_b64_v4i16((LAS v4i16_t*)p)); }
__device__ __forceinline__ float rowmax_a(const f32x16& p0, const f32x16& p1) {
    float a = max3f(p0[0], p0[1], p1[0]), b = max3f(p0[2], p0[3], p1[1]); a = max3f(a, p1[2], p1[3]);
#pragma unroll
    for (int r = 4; r < 16; r += 4) { a = max3f(a, p0[r], p0[r + 1]); b = max3f(b, p0[r + 2], p0[r + 3]); a = max3f(a, p1[r], p1[r + 1]); b = max3f(b, p1[r + 2], p1[r + 3]); }
    const float m = max2f(a, b);
    auto rr = __builtin_amdgcn_permlane32_swap(__float_as_uint(m), __float_as_uint(m), false, false);
    return max2f(__uint_as_float(rr[0]), __uint_as_float(rr[1]));
}
#define FB_SBAR() __builtin_amdgcn_sched_barrier(0)
#define FB_WAIT_BAR(N) asm volatile("s_waitcnt vmcnt(" #N ") lgkmcnt(0)\n\ts_barrier" ::: "memory")
template <int MODE> __device__ __forceinline__ void mask_tile(f32x16& p0, f32x16& p1, int t, int qb, int nreal, int tl_base, const LAS unsigned long long* mskp) {
    const float NEG = -INFINITY;
    if (t >= nreal) {
#pragma unroll
        for (int r = 0; r < 16; ++r) { p0[r] = NEG; p1[r] = NEG; }
        return; }
    if ((MODE == 0) ? (t == qb) : (t == 0)) { const int l_ = lane_id(); const int lim = tl_base + ((l_ & 31) >> 2) - 4 * (l_ >> 5);
#pragma unroll
        for (int r = 0; r < 16; ++r) { const int cr = (r & 3) + 8 * (r >> 2); if (cr > lim) p0[r] = NEG; if (cr + 32 > lim) p1[r] = NEG; } }
    if (MODE == 1 && t == 8) { const int l_ = lane_id(); const int lim = tl_base + ((l_ & 31) >> 2) - 4 * (l_ >> 5);
#pragma unroll
        for (int r = 0; r < 16; ++r) { const int cr = (r & 3) + 8 * (r >> 2); if (cr <= lim) p0[r] = NEG; if (cr + 32 <= lim) p1[r] = NEG; } }
    if (MODE == 0) { const bool dead = !((*mskp >> t) & 1ull);
        if (__any(dead)) {
#pragma unroll
            for (int r = 0; r < 16; ++r) { p0[r] = dead ? NEG : p0[r]; p1[r] = dead ? NEG : p1[r]; } } }
}
template <int MODE> __device__ __forceinline__ void mask_pos(f32x16& p0, f32x16& p1, int t, int qb, int tl_base) {
    const float NEG = -INFINITY;
    if ((MODE == 0) ? (t == qb) : (t == 0)) { const int l_ = lane_id(); const int lim = tl_base + ((l_ & 31) >> 2) - 4 * (l_ >> 5);
#pragma unroll
        for (int r = 0; r < 16; ++r) { const int cr = (r & 3) + 8 * (r >> 2); if (cr > lim) p0[r] = NEG; if (cr + 32 > lim) p1[r] = NEG; } }
    if (MODE == 1 && t == 8) { const int l_ = lane_id(); const int lim = tl_base + ((l_ & 31) >> 2) - 4 * (l_ >> 5);
#pragma unroll
        for (int r = 0; r < 16; ++r) { const int cr = (r & 3) + 8 * (r >> 2); if (cr <= lim) p0[r] = NEG; if (cr + 32 <= lim) p1[r] = NEG; } }
}
template <int MODE> __device__ __forceinline__ void flash_prefetch(LAS unsigned char* lds, const bf16_t* Kg, const bf16_t* Vg, int qb, int wid) {
    constexpr long PITCH = 256;
    const int nreal = (MODE == 0) ? qb + 1 : (qb >= 8 ? 9 : qb + 1);
    const unsigned lds0 = (unsigned)(uintptr_t)lds; const unsigned kdst = lds0 + L_K + wid * 1024, vdst = lds0 + L_V + wid * 1024;
#define PF_TILE(t) ((MODE == 0) ? (((t) < nreal) ? (t) : nreal - 1) : (qb - (((t) < nreal) ? (t) : nreal - 1)))
    const int l_ = lane_id();
    const unsigned koff = (unsigned)(l_ * (int)PITCH + wid * 8) * 2u, voff = (unsigned)((16 * (wid & 3) + (l_ >> 2)) * (int)PITCH + (wid >> 2) * 32 + (l_ & 3) * 8) * 2u;
    glds16(uni_ptr((const char*)(Kg + (long)PF_TILE(0) * 64 * PITCH)), koff, (unsigned)__builtin_amdgcn_readfirstlane(kdst));
    glds16(uni_ptr((const char*)(Vg + (long)PF_TILE(0) * 64 * PITCH)), voff, (unsigned)__builtin_amdgcn_readfirstlane(vdst));
    glds16(uni_ptr((const char*)(Kg + (long)PF_TILE(1) * 64 * PITCH)), koff, (unsigned)__builtin_amdgcn_readfirstlane(kdst + SLOTB));
    glds16(uni_ptr((const char*)(Kg + (long)PF_TILE(2) * 64 * PITCH)), koff, (unsigned)__builtin_amdgcn_readfirstlane(kdst + 2 * SLOTB));
#undef PF_TILE
}
template <int MODE, bool PRE = false> __device__ __forceinline__ void flash_branch(LAS unsigned char* lds, const bf16_t* Kg, const bf16_t* Vg, const bf16x8 (&qr)[4], int qb, int tl, const LAS unsigned long long* mskp, const LAS float* gatep, int wid, int lane) {
    const int r32 = lane & 31, hi = lane >> 5;
    constexpr long PITCH = 256;
    const int nreal = (MODE == 0) ? qb + 1 : (qb >= 8 ? 9 : qb + 1);
    const int NT = nreal < 4 ? 4 : (ODD_NT ? nreal : ((nreal + 1) & ~1));
#define FB_TILE(t) ((MODE == 0) ? (((t) < nreal) ? (t) : nreal - 1) : (qb - (((t) < nreal) ? (t) : nreal - 1)))
    const unsigned lds0 = (unsigned)(uintptr_t)lds;
    LAS float* wsf = (LAS float*)(lds + L_WSF) + wid * 64;
#define FB_KOFF() ((unsigned)(lane_id() * (int)PITCH + wid * 8) * 2u)
#define FB_VOFF() ({ const int l_ = lane_id(); (unsigned)((16 * (wid & 3) + (l_ >> 2)) * (int)PITCH + (wid >> 2) * 32 + (l_ & 3) * 8) * 2u; })
    const unsigned kdst = lds0 + L_K + wid * 1024, vdst = lds0 + L_V + wid * 1024;
#define DMA_K(t, slot) glds16(uni_ptr((const char*)(Kg + (long)FB_TILE(t) * 64 * PITCH)), FB_KOFF(), (unsigned)__builtin_amdgcn_readfirstlane(kdst + (slot)))
#define DMA_V(t, slot) glds16(uni_ptr((const char*)(Vg + (long)FB_TILE(t) * 64 * PITCH)), FB_VOFF(), (unsigned)__builtin_amdgcn_readfirstlane(vdst + (slot)))
    bf16x8 kf[8];
    const lds_cptr shm3 = (lds_cptr)lds; const lds_cptr kp0 = shm3 + L_K + hi * 1024 + r32 * 16; const lds_cptr vp0 = shm3 + L_V + ((lane >> 4) & 1) * 32 + (lane & 3) * 8 + (4 * hi + ((lane & 15) >> 2)) * 64;
    if (!PRE) { DMA_K(0, 0); DMA_V(0, 0); DMA_K(1, SLOTB); }
    float mhat = 0.f, l_reg = 0.f; f32x16 o[2]; o[0] = f32x16{}; o[1] = f32x16{}; const f32x16 zero16 = f32x16{};
#define CMASK(P0, P1, t) mask_tile<MODE>(P0, P1, (t), qb, nreal, wid * 8, mskp)
    bool resc = false;
#define START(P0, P1) do { const float rm = rowmax_a(P0, P1); resc = false; \
    { const float dl = rm; mhat = fadd_s(mhat, dl); \
      _Pragma("unroll") for (int r = 0; r < 16; ++r) { P0[r] = fsub_s(P0[r], dl); P1[r] = fsub_s(P1[r], dl); } } \
    _Pragma("unroll") for (int r = 0; r < 16; ++r) P0[r] = __builtin_amdgcn_exp2f(P0[r]); } while (0)
#define RESC() do { if (resc) { asm volatile("s_waitcnt lgkmcnt(0)" ::: "memory"); \
      _Pragma("unroll") for (int d_ = 0; d_ < 2; ++d_) _Pragma("unroll") for (int r = 0; r < 16; ++r) o[d_][r] *= wsf[crow(r, hi)]; } } while (0)
    f32x16 pA0, pA1, pB0, pB1;
    int sl_prev = 0, sl_cur = 0, sl_next = SLOTB;
#define ROT() do { sl_prev = sl_cur; sl_cur = sl_next; sl_next = (sl_next == (NSLOT - 1) * SLOTB) ? 0 : sl_next + SLOTB; } while (0)
    if (!PRE) { DMA_K(2, 2 * SLOTB); }
    if (PRE) { FB_WAIT_BAR(7); } else { FB_WAIT_BAR(3); }
    { const lds_cptr kb = kp0;
      const f32x16 z = zero16;
#pragma unroll
      for (int d0 = 0; d0 < 4; ++d0) { const bf16x8 b0 = *(const LAS bf16x8*)(kb + d0 * 2048), b1 = *(const LAS bf16x8*)(kb + d0 * 2048 + 512);
          if (d0 == 0) { pA0 = __builtin_amdgcn_mfma_f32_32x32x16_bf16(b0, qr[0], z, 0, 0, 0); pA1 = __builtin_amdgcn_mfma_f32_32x32x16_bf16(b1, qr[0], z, 0, 0, 0); }
          else { pA0 = __builtin_amdgcn_mfma_f32_32x32x16_bf16(b0, qr[d0], pA0, 0, 0, 0); pA1 = __builtin_amdgcn_mfma_f32_32x32x16_bf16(b1, qr[d0], pA1, 0, 0, 0); } } }
    asm volatile("s_nop 15\n\ts_nop 7" : "+v"(pA0), "+v"(pA1)); CMASK(pA0, pA1, 0);
    START(pA0, pA1);
#pragma unroll
    for (int r = 0; r < 16; ++r) pA1[r] = __builtin_amdgcn_exp2f(pA1[r]);
    FB_WAIT_BAR(0);
    DMA_K(3, 0); DMA_V(1, SLOTB);
    ROT();
    kload8(kf, kp0 + sl_cur);
    FB_WAIT_BAR(2);
    s16x4 vlo[8], vhi[8]; u32x4 pw0, pw1, pw2, pw3;
#define PKW(P, B) cvt_pk_bf16(P[B], P[B + 1])
#define PAF(k) __builtin_bit_cast(bf16x8, pw##k)
#define VFR(i) (bf16x8){vlo[i][0], vlo[i][1], vlo[i][2], vlo[i][3], vhi[i][0], vhi[i][1], vhi[i][2], vhi[i][3]}
#define PIN(x) asm volatile("" : "+v"(x))
#define MX3(a, b, c) __builtin_fmaxf(__builtin_fmaxf((a), (b)), (c))
#define GAPA(MF, A0, A1, A2, A3, W0, W1, PW) do { MF; sacc += A0; sacc += A1; sacc += A2; sacc += A3; PIN(sacc); W0; W1; PIN(PW); FB_SBAR(); } while (0)
#define EX(v) __builtin_amdgcn_exp2f(v)
#define GAPB(MF, X, B) do { MF; X[B] = EX(X[B]); X[B + 1] = EX(X[B + 1]); X[B + 2] = EX(X[B + 2]); X[B + 3] = EX(X[B + 3]); PIN(X); FB_SBAR(); } while (0)
#define VRD(i) do { vlo[i] = vtr(vp_ + (((i) >> 2) * 4096 + ((i) & 3) * 1024)); vhi[i] = vtr(vp_ + (((i) >> 2) * 4096 + ((i) & 3) * 1024 + 512)); } while (0)
#define KRD(G, j) do { if (G) { kload2(kf, kp0 + sl_next, j); FB_SBAR(); } } while (0)
#define STEP(C0, C1, P0, P1, t, GK, GV, GL) do { FB_SBAR(); \
    const lds_cptr vp_ = vp0 + sl_prev; \
    VRD(0); FB_SBAR(); float sacc = (P0[0] + P0[1]); \
    GAPA(C0 = __builtin_amdgcn_mfma_f32_32x32x16_bf16(kf[0], qr[0], zero16, 0, 0, 0), P0[2], P0[3], P0[4], P0[5],     pw0[0] = PKW(P0, 0), pw0[1] = PKW(P0, 2), pw0); \
    VRD(4); FB_SBAR(); GAPA(C1 = __builtin_amdgcn_mfma_f32_32x32x16_bf16(kf[1], qr[0], zero16, 0, 0, 0), P0[6], P0[7], P0[8], P0[9],     pw0[2] = PKW(P0, 4), pw0[3] = PKW(P0, 6), pw0); \
    VRD(1); FB_SBAR(); GAPA(C0 = __builtin_amdgcn_mfma_f32_32x32x16_bf16(kf[2], qr[1], C0, 0, 0, 0),   P0[10], P0[11], P0[12], P0[13], pw1[0] = PKW(P0, 8), pw1[1] = PKW(P0, 10), pw1); \
    VRD(5); FB_SBAR(); GAPA(C1 = __builtin_amdgcn_mfma_f32_32x32x16_bf16(kf[3], qr[1], C1, 0, 0, 0),   P0[14], P0[15], P1[0], P1[1],   pw1[2] = PKW(P0, 12), pw1[3] = PKW(P0, 14), pw1); \
    VRD(2); FB_SBAR(); GAPA(C0 = __builtin_amdgcn_mfma_f32_32x32x16_bf16(kf[4], qr[2], C0, 0, 0, 0),   P1[2], P1[3], P1[4], P1[5],     pw2[0] = PKW(P1, 0), pw2[1] = PKW(P1, 2), pw2); \
    VRD(6); FB_SBAR(); GAPA(C1 = __builtin_amdgcn_mfma_f32_32x32x16_bf16(kf[5], qr[2], C1, 0, 0, 0),   P1[6], P1[7], P1[8], P1[9],     pw2[2] = PKW(P1, 4), pw2[3] = PKW(P1, 6), pw2); \
    VRD(3); FB_SBAR(); GAPA(C0 = __builtin_amdgcn_mfma_f32_32x32x16_bf16(kf[6], qr[3], C0, 0, 0, 0),   P1[10], P1[11], P1[12], P1[13], pw3[0] = PKW(P1, 8), pw3[1] = PKW(P1, 10), pw3); \
    VRD(7); FB_SBAR(); GAPA(C1 = __builtin_amdgcn_mfma_f32_32x32x16_bf16(kf[7], qr[3], C1, 0, 0, 0),   P1[14], P1[15], 0.f, 0.f,       pw3[2] = PKW(P1, 12), pw3[3] = PKW(P1, 14), pw3); \
    l_reg += sacc; \
    if (GK) { DMA_K((t) + 3, sl_cur); } if (GV) { DMA_V((t) + 1, sl_next); } \
    { const bool dead_ = ((t) >= nreal) || (MODE == 0 && !((*mskp >> (t)) & 1ull)); const float mh_ = dead_ ? INFINITY : mhat;       \
      _Pragma("unroll") for (int r = 0; r < 16; ++r) { C0[r] -= mh_; C1[r] -= mh_; } } \
    mask_pos<MODE>(C0, C1, (t), qb, wid * 8); \
    { float a = MX3(C0[0], C0[1], C1[0]), b = MX3(C0[2], C0[3], C1[1]); a = MX3(a, C1[2], C1[3]); \
      _Pragma("unroll") for (int r = 4; r < 16; r += 4) { a = MX3(a, C0[r], C0[r + 1]); b = MX3(b, C0[r + 2], C0[r + 3]); a = MX3(a, C1[r], C1[r + 1]); b = MX3(b, C1[r + 2], C1[r + 3]); } \
      float rm = __builtin_fmaxf(a, b); { auto rr = __builtin_amdgcn_permlane32_swap(__float_as_uint(rm), __float_as_uint(rm), false, false); rm = __builtin_fmaxf(__uint_as_float(rr[0]), __uint_as_float(rr[1])); } \
      resc = false; \
      if (__builtin_expect(__any(rm > 8.0f), 0)) { const float dl = __builtin_fmaxf(rm, 0.f); mhat += dl; \
        _Pragma("unroll") for (int r = 0; r < 16; ++r) { C0[r] -= dl; C1[r] -= dl; } \
        const float f = __builtin_amdgcn_exp2f(-dl); l_reg *= f; if (hi == 0) wsf[r32] = f; resc = true; } } \
    FB_SBAR(); \
    GAPB(o[0] = __builtin_amdgcn_mfma_f32_32x32x16_bf16(PAF(0), VFR(0), o[0], 0, 0, 0), C0, 0); \
    GAPB(o[1] = __builtin_amdgcn_mfma_f32_32x32x16_bf16(PAF(0), VFR(4), o[1], 0, 0, 0), C0, 4); \
    KRD(GL, 0); GAPB(o[0] = __builtin_amdgcn_mfma_f32_32x32x16_bf16(PAF(1), VFR(1), o[0], 0, 0, 0), C0, 8); \
    KRD(GL, 1); GAPB(o[1] = __builtin_amdgcn_mfma_f32_32x32x16_bf16(PAF(1), VFR(5), o[1], 0, 0, 0), C0, 12); \
    KRD(GL, 2); GAPB(o[0] = __builtin_amdgcn_mfma_f32_32x32x16_bf16(PAF(2), VFR(2), o[0], 0, 0, 0), C1, 0); \
    KRD(GL, 3); GAPB(o[1] = __builtin_amdgcn_mfma_f32_32x32x16_bf16(PAF(2), VFR(6), o[1], 0, 0, 0), C1, 4); \
    GAPB(o[0] = __builtin_amdgcn_mfma_f32_32x32x16_bf16(PAF(3), VFR(3), o[0], 0, 0, 0), C1, 8); \
    GAPB(o[1] = __builtin_amdgcn_mfma_f32_32x32x16_bf16(PAF(3), VFR(7), o[1], 0, 0, 0), C1, 12); \
    } while (0)
    int t = 1;
    for (; t + 5 < NT; t += 2) {
        STEP(pB0, pB1, pA0, pA1, t, true, true, true);     FB_WAIT_BAR(2); RESC(); ROT();
        STEP(pA0, pA1, pB0, pB1, t + 1, true, true, true); FB_WAIT_BAR(2); RESC(); ROT();
    }
#define ENDW(tt) do { if ((tt) + 3 < NT) { FB_WAIT_BAR(2); } else if ((tt) + 2 < NT) { FB_WAIT_BAR(1); } else { FB_WAIT_BAR(0); } } while (0)
    for (; t + 1 < NT; t += 2) {
        STEP(pB0, pB1, pA0, pA1, t, (t + 3 < NT), (t + 1 < NT), (t + 1 < NT));         ENDW(t);     RESC(); ROT();
        STEP(pA0, pA1, pB0, pB1, t + 1, (t + 4 < NT), (t + 2 < NT), (t + 2 < NT));     ENDW(t + 1); RESC(); ROT();
    }
#define DRAIN(P0, P1, SL) do { float sacc = P0[0] + P0[1]; \
      _Pragma("unroll") for (int r = 2; r < 16; ++r) sacc += P0[r]; \
      _Pragma("unroll") for (int r = 0; r < 16; ++r) sacc += P1[r]; \
      l_reg += sacc; \
      pw0 = (u32x4){PKW(P0, 0), PKW(P0, 2), PKW(P0, 4), PKW(P0, 6)}; pw1 = (u32x4){PKW(P0, 8), PKW(P0, 10), PKW(P0, 12), PKW(P0, 14)}; \
      pw2 = (u32x4){PKW(P1, 0), PKW(P1, 2), PKW(P1, 4), PKW(P1, 6)}; pw3 = (u32x4){PKW(P1, 8), PKW(P1, 10), PKW(P1, 12), PKW(P1, 14)}; \
      FB_SBAR(); pv(o, (int)(lds0 + L_V) + ((lane >> 4) & 1) * 32 + (lane & 3) * 8 + (4 * hi + ((lane & 15) >> 2)) * 64 + (SL), PAF(0), PAF(1), PAF(2), PAF(3)); } while (0)
    if (t < NT) { STEP(pB0, pB1, pA0, pA1, NT - 1, false, false, false); RESC(); DRAIN(pB0, pB1, sl_cur); }
    else { DRAIN(pA0, pA1, sl_prev); }
#undef DRAIN
    l_reg = halfsum(l_reg);
    if (hi == 0) { const float gate = *gatep; wsf[32 + r32] = (l_reg > 0.f) ? gate / l_reg : 0.f; }
    asm volatile("s_waitcnt lgkmcnt(0)" ::: "memory");
    { LAS float* acc = (LAS float*)(lds + L_ACC) + wid * 2048;
#pragma unroll
      for (int r = 0; r < 16; ++r) { const int orow = crow(r, hi); const float f = wsf[32 + orow];
#pragma unroll
          for (int d0 = 0; d0 < 2; ++d0) acc[orow * 64 + d0 * 32 + r32] += o[d0][r] * f; } }
    asm volatile("s_waitcnt lgkmcnt(0)\n\ts_barrier" ::: "memory");
#undef DMA_K
#undef DMA_V
#undef CMASK
#undef START
#undef RESC
#undef ROT
#undef PKW
#undef PAF
#undef VFR
#undef PIN
#undef MX3
#undef GAPA
#undef GAPB
#undef EX
#undef VRD
#undef KRD
#undef STEP
#undef ENDW
#undef FB_TILE
#undef FB_KOFF
#undef FB_VOFF
}
#define NSA_PACK(P, B) cvt_pk_bf16(P[B], P[B + 1])
#define NSA_PA(P, B) __builtin_bit_cast(bf16x8, (u32x4){NSA_PACK(P, B), NSA_PACK(P, B + 2), NSA_PACK(P, B + 4), NSA_PACK(P, B + 6)})

__device__ __forceinline__ void nsa_unit(Frame& F, int b, int g, int qb) {
    const int lane = lane_id(), wid = F.wave, r32 = lane & 31, hi = lane >> 5;
    LAS unsigned char* lds = F.lds; unsigned char* ws = F.ws;
    const bf16_t* Q = (const bf16_t*)(F.out + DO_Q); const bf16_t* Z = (const bf16_t*)(F.out + DO_Z);
    const float* G = (const float*)(ws + WS_G); bf16_t* ATT = (bf16_t*)(ws + WS_ATT);
    const int tl = wid * 8 + (r32 >> 2), hh = r32 & 3, t = qb * 64 + tl;
    const size_t tokrow = (size_t)b * SEQ + t;
    bf16x8 qr[4];
#pragma unroll
    for (int d0 = 0; d0 < 4; ++d0) qr[d0] = *(const bf16x8*)(Q + tokrow * 1024 + g * 256 + hh * 64 + d0 * 16 + hi * 8);
    LAS float* gl = (LAS float*)(lds + LDS_GATE) + wid * 96 + r32;
    { const float* gp = G + tokrow * 48 + g * 12 + hh * 3; const float g0_ = gp[0], g1_ = gp[1], g2_ = gp[2]; if (hi == 0) { gl[0] = g0_; gl[32] = g1_; gl[64] = g2_; } }
    LAS float* wsf = (LAS float*)(lds + L_WSF) + wid * 64;
    LAS float* GS = (LAS float*)(lds + L_GS) + wid * 512; LAS float* LS = (LAS float*)(lds + L_LS) + wid * 512;
    LAS unsigned long long* MSK = (LAS unsigned long long*)(lds + L_MSK) + wid * 8;
    const int vbl = (int)(unsigned)(uintptr_t)(lds + L_KV + 8192) + ((lane >> 4) & 1) * 32 + (lane & 3) * 8 + (4 * hi + ((lane & 15) >> 2)) * 64;
    f32x16 oacc[2], o[2], p0, p1; oacc[0] = f32x16{}; oacc[1] = f32x16{};
#define NSA_DMA_K(st, base) __builtin_amdgcn_global_load_lds((const unsigned*)(uni_ptr(base) + koff), (LAS unsigned*)(lds + L_KV + (st) * 16384 + wid * 1024), 16, 0, 0)
#define NSA_DMA_V(st, base) __builtin_amdgcn_global_load_lds((const unsigned*)(uni_ptr(base) + voff), (LAS unsigned*)(lds + L_KV + (st) * 16384 + 8192 + wid * 1024), 16, 0, 0)
#ifndef PROBE_NSA
#define PROBE_NSA 0
#endif
    for (int prep = 0; prep < (PROBE_NSA == 1 ? 2 : 1); ++prep) { oacc[0] = f32x16{}; oacc[1] = f32x16{};
    {
        const int nvalid = (4 * qb + 3 < 255) ? 4 * qb + 3 : 255, ntc = (nvalid + 63) >> 6;
        const char* Kc = (const char*)(ws + WS_KCC) + (size_t)(b * 4 + g) * 256 * 128; const char* Vc = (const char*)(ws + WS_VCC) + (size_t)(b * 4 + g) * 256 * 128;
        const unsigned koff = (unsigned)lane * 128u + wid * 16, voff = (unsigned)(16 * (wid & 3) + (lane >> 2)) * 128u + (wid >> 2) * 64 + (lane & 3) * 16;
        for (int i = 0; i < ntc; ++i) {
            __builtin_amdgcn_global_load_lds((const unsigned*)(uni_ptr(Kc + (size_t)i * 8192) + koff), (LAS unsigned*)(lds + i * 8192 + wid * 1024), 16, 0, 0);
            __builtin_amdgcn_global_load_lds((const unsigned*)(uni_ptr(Vc + (size_t)i * 8192) + voff), (LAS unsigned*)(lds + L_ACC + i * 8192 + wid * 1024), 16, 0, 0); }
        const int nrow = (t >= 31) ? ((t - 31) >> 4) : -1;
        VM_WAIT(); __syncthreads();
        f32x16 s0[4], s1[4];
        float m = NSA_NEG;
#pragma unroll
        for (int i = 0; i < 4; ++i) if (i < ntc) {
            qkt(s0[i], s1[i], lds + i * 8192, qr, r32, hi);
            const int lim = nrow - 64 * i - 4 * hi;
#pragma unroll
            for (int r = 0; r < 16; ++r) { const int cr = (r & 3) + 8 * (r >> 2); if (cr > lim) s0[i][r] = NSA_NEG; if (cr + 32 > lim) s1[i][r] = NSA_NEG; }
#pragma unroll
            for (int r = 0; r < 16; r += 2) m = fmaxf(m, fmaxf(fmaxf(s0[i][r], s0[i][r + 1]), fmaxf(s1[i][r], s1[i][r + 1]))); }
        { auto rr = __builtin_amdgcn_permlane32_swap(__float_as_uint(m), __float_as_uint(m), false, false); m = fmaxf(__uint_as_float(rr[0]), __uint_as_float(rr[1])); }
        const float mu = (m == NSA_NEG) ? 0.f : m; float l = 0.f;
#pragma unroll
        for (int i = 0; i < 4; ++i) if (i < ntc) {
#pragma unroll
            for (int r = 0; r < 16; ++r) { s0[i][r] = __builtin_amdgcn_exp2f(s0[i][r] - mu); s1[i][r] = __builtin_amdgcn_exp2f(s1[i][r] - mu); l += s0[i][r] + s1[i][r]; } }
        l = halfsum(l);
        const float inv_l = l > 0.f ? 1.0f / l : 0.f;
        o[0] = f32x16{}; o[1] = f32x16{};
        const int vbc = (int)(unsigned)(uintptr_t)(lds + L_ACC) + ((lane >> 4) & 1) * 32 + (lane & 3) * 8 + (4 * hi + ((lane & 15) >> 2)) * 64;
#define QSUM(v) do { v += __int_as_float(__builtin_amdgcn_update_dpp(0, __float_as_int(v), 0xB1, 0xf, 0xf, true)); v += __int_as_float(__builtin_amdgcn_update_dpp(0, __float_as_int(v), 0x4E, 0xf, 0xf, true)); } while (0)
#pragma unroll
        for (int i = 0; i < 4; ++i) if (i < ntc) {
#if defined(PROBE_CMP) && PROBE_CMP == 1
            for (int prc = 0; prc < 2; ++prc)
#endif
#pragma unroll
            for (int a = 0; a < 4; ++a) {
                float g0 = ((s0[i][4 * a] + s0[i][4 * a + 1]) + (s0[i][4 * a + 2] + s0[i][4 * a + 3])) * inv_l, l0 = s0[i][4 * a + 3] * inv_l;
                float g1 = ((s1[i][4 * a] + s1[i][4 * a + 1]) + (s1[i][4 * a + 2] + s1[i][4 * a + 3])) * inv_l, l1 = s1[i][4 * a + 3] * inv_l;
                QSUM(g0); QSUM(l0); QSUM(g1); QSUM(l1);
                if (hh == 0) { const int j = 16 * i + 2 * a + hi, tk = r32 >> 2;
                    GS[tk * 64 + j] = g0; GS[tk * 64 + j + 8] = g1; LS[tk * 64 + j + 1] = l0; if (j + 9 < 64) LS[tk * 64 + j + 9] = l1; }
            }
            const bf16x8 pa0 = NSA_PA(s0[i], 0), pa1 = NSA_PA(s0[i], 8), pa2 = NSA_PA(s1[i], 0), pa3 = NSA_PA(s1[i], 8);
            pv(o, vbc + i * 8192, pa0, pa1, pa2, pa3);
#if defined(PROBE_CMP) && PROBE_CMP == 2
            { f32x16 o2[2]; o2[0] = o[0]; o2[1] = o[1]; pv(o2, vbc + i * 8192, pa0, pa1, pa2, pa3); asm volatile("" :: "v"(o2[0]), "v"(o2[1])); }
#endif
        }
#undef QSUM
        { const float gate_c = gl[0] * inv_l; oacc[0] = f32x16{}; oacc[1] = f32x16{}; row_fma(oacc, o, gate_c, wsf, r32, hi); }
        __syncthreads();
    }
#if WIN_PREFETCH
    flash_prefetch<1>(lds, (const bf16_t*)(ws + WS_KW) + (size_t)b * SEQ * 256 + g * 64, (const bf16_t*)(ws + WS_VW) + (size_t)b * SEQ * 256 + g * 64, qb, wid);
#endif
    LDS_WAIT();
    {
        const int tkq = lane >> 3, c8 = lane & 7;
        const LAS float* gsp = GS + tkq * 64 + c8 * 8; const LAS float* lsp = LS + tkq * 64 + c8 * 8;
        const f32x4 ga = *(const LAS f32x4*)gsp, gb = *(const LAS f32x4*)(gsp + 4), la = *(const LAS f32x4*)lsp, lb = *(const LAS f32x4*)(lsp + 4);
        unsigned key[8];
#pragma unroll
        for (int i = 0; i < 8; ++i) { const int j = c8 * 8 + i; const float gv = (i < 4) ? ga[i & 3] : gb[i & 3], lv = (i < 4) ? la[i & 3] : lb[i & 3];
            const float imp = gv + (j > 0 ? lv : 0.f);
            const bool valid = j <= qb, forced = (j == 0) || (j == qb) || (j == qb - 1);
#if defined(PROBE_SELINV)
            const float sc = forced ? 1e4f : (1e3f - imp);
#else
            const float sc = imp + (forced ? 1e4f : 0.f);
#endif
            key[i] = valid ? __float_as_uint(sc) + 1u : 0u; }
#define G8SUM(v) do { v += __builtin_amdgcn_update_dpp(0, v, 0xB1, 0xf, 0xf, true); v += __builtin_amdgcn_update_dpp(0, v, 0x4E, 0xf, 0xf, true); v += __builtin_amdgcn_update_dpp(0, v, 0x141, 0xf, 0xf, true); } while (0)
        unsigned T = 0u;
#if defined(PROBE_TOPK)
        for (int prt = 0; prt < 2; ++prt) { T = 0u;
#pragma unroll
        for (int i = 0; i < 8; ++i) asm volatile("" : "+v"(key[i]));
#endif
        if (qb >= 16) {
#pragma unroll
            for (int bit = 31; bit >= 0; --bit) { const unsigned cand = T | (1u << bit); int cnt = 0;
#pragma unroll
                for (int i = 0; i < 8; ++i) cnt += (key[i] >= cand) ? 1 : 0;
                G8SUM(cnt);
                T = (cnt >= 16) ? cand : T; } }
#if defined(PROBE_TOPK)
        }
#endif
        int gcnt = 0, ecnt = 0;
#pragma unroll
        for (int i = 0; i < 8; ++i) { gcnt += (key[i] > T) ? 1 : 0; ecnt += (key[i] == T) ? 1 : 0; }
        G8SUM(gcnt); const int need = 16 - gcnt;
        int pre = ecnt;
        { const int t1 = __builtin_amdgcn_update_dpp(0, pre, 0x111, 0xf, 0xf, true); pre += (c8 >= 1) ? t1 : 0;
          const int t2 = __builtin_amdgcn_update_dpp(0, pre, 0x112, 0xf, 0xf, true); pre += (c8 >= 2) ? t2 : 0;
          const int t4 = __builtin_amdgcn_update_dpp(0, pre, 0x114, 0xf, 0xf, true); pre += (c8 >= 4) ? t4 : 0; }
        int below = pre - ecnt; unsigned bits = 0u;
#pragma unroll
        for (int i = 0; i < 8; ++i) { const bool eq = key[i] == T; const bool sel = (key[i] != 0u) && ((key[i] > T) || (eq && below < need)); below += eq ? 1 : 0; bits |= sel ? (1u << i) : 0u; }
        ((LAS unsigned char*)MSK)[tkq * 8 + c8] = (unsigned char)bits;
#undef G8SUM
    }
    }
    LDS_WAIT();
    { const char* zsrc = (const char*)Z + ((size_t)b * SEQ + qb * 64 + wid * 8) * 2048 + g * 512 + (lane >> 5) * 2048 + (lane & 31) * 16;
      const unsigned zg = (unsigned)(uintptr_t)(lds + L_GS) + wid * 2048u, zl = (unsigned)(uintptr_t)(lds + L_LS) + wid * 2048u;
      glds16(uni_ptr((const char*)Z + ((size_t)b * SEQ + qb * 64 + wid * 8) * 2048 + g * 512), (unsigned)((lane >> 5) * 2048 + (lane & 31) * 16), (unsigned)__builtin_amdgcn_readfirstlane(zg));
      glds16(uni_ptr((const char*)Z + ((size_t)b * SEQ + qb * 64 + wid * 8 + 2) * 2048 + g * 512), (unsigned)((lane >> 5) * 2048 + (lane & 31) * 16), (unsigned)__builtin_amdgcn_readfirstlane(zg + 1024u));
      glds16(uni_ptr((const char*)Z + ((size_t)b * SEQ + qb * 64 + wid * 8 + 4) * 2048 + g * 512), (unsigned)((lane >> 5) * 2048 + (lane & 31) * 16), (unsigned)__builtin_amdgcn_readfirstlane(zl));
      glds16(uni_ptr((const char*)Z + ((size_t)b * SEQ + qb * 64 + wid * 8 + 6) * 2048 + g * 512), (unsigned)((lane >> 5) * 2048 + (lane & 31) * 16), (unsigned)__builtin_amdgcn_readfirstlane(zl + 1024u));
      (void)zsrc; }
    const LAS unsigned long long* mskp = MSK + (r32 >> 2);
    { LAS float* acc = (LAS float*)(lds + L_ACC) + wid * 2048;
#pragma unroll
      for (int r = 0; r < 16; ++r) { const int orow = crow(r, hi);
#pragma unroll
          for (int d0 = 0; d0 < 2; ++d0) acc[orow * 64 + d0 * 32 + r32] = oacc[d0][r]; } }
    { const bf16_t* Kw = (const bf16_t*)(ws + WS_KW) + (size_t)b * SEQ * 256 + g * 64; const bf16_t* Vw = (const bf16_t*)(ws + WS_VW) + (size_t)b * SEQ * 256 + g * 64;
      flash_branch<1, WIN_PREFETCH != 0>(lds, Kw, Vw, qr, qb, tl, mskp, gl + 64, wid, lane);
      if (PROBE_NSA == 2) flash_branch<1>(lds, Kw, Vw, qr, qb, tl, mskp, (const LAS float*)(lds + LDSCTL_OFF), wid, lane); }
    { const bf16_t* Ks = (const bf16_t*)(ws + WS_KS) + (size_t)b * SEQ * 256 + g * 64; const bf16_t* Vs = (const bf16_t*)(ws + WS_VS) + (size_t)b * SEQ * 256 + g * 64;
      flash_branch<0>(lds, Ks, Vs, qr, qb, tl, mskp, gl + 32, wid, lane);
      if (PROBE_NSA == 3) flash_branch<0>(lds, Ks, Vs, qr, qb, tl, mskp, (const LAS float*)(lds + LDSCTL_OFF), wid, lane); }
    {
        const LAS float* acc = (const LAS float*)(lds + L_ACC) + wid * 2048;
#pragma unroll
        for (int i = 0; i < 4; ++i) { const int row = i * 8 + (lane >> 3), ch = lane & 7; const f32x4 a0 = *(const LAS f32x4*)(acc + row * 64 + ch * 8), a1 = *(const LAS f32x4*)(acc + row * 64 + ch * 8 + 4);
            const size_t off = ((size_t)b * SEQ + qb * 64 + wid * 8 + (row >> 2)) * 1024 + g * 256 + (row & 3) * 64 + ch * 8;
            const int tk_ = row >> 2; const LAS unsigned char* zp = lds + (tk_ < 4 ? L_GS : L_LS) + wid * 2048 + (tk_ & 3) * 512 + (row & 3) * 128 + ch * 16;
            const u32x4 zz = *(const LAS u32x4*)zp; f32x4 z0, z1; epi::unpack8(zz, z0, z1);
            *(u32x4*)(ATT + off) = epi::pack8(a0 * z0, a1 * z1); }
        LDS_WAIT();
    }
    __syncthreads();
#undef NSA_DMA_K
#undef NSA_DMA_V
}
__device__ __forceinline__ void nsa_phase(Frame& F) {
    if (F.G == 256) {
        const int bg = F.vcu >> 3, s = F.vcu & 7;
        for (int i = 0; i < 8; ++i) { const int k = i >> 1; const int qb = (i & 1) ? (63 - 8 * k - s) : (8 * k + s); nsa_unit(F, bg >> 2, bg & 3, qb); }
    } else {
        for (int u = F.vcu; u < 2048; u += F.G) nsa_unit(F, u >> 8, (u >> 6) & 3, u & 63);
    }
}
}

namespace ret {
__device__ __forceinline__ int crow(int r, int hi) { return (r & 3) + 8 * (r >> 2) + 4 * hi; }
__device__ __forceinline__ void p_phase(Frame& F) {
    const int lane = lane_id(), wid = F.wave, r32 = lane & 31, hi = lane >> 5;
    const bf16_t* Qp = (const bf16_t*)(F.ws + WS_QP); const bf16_t* Kp = (const bf16_t*)(F.out);
    bf16_t* PT = (bf16_t*)(F.ws + WS_PT);
    const int ib = wid & 3, jb0 = (wid >> 2) * 2;
    for (int it = F.vcu; it < 1024; it += F.G) {
        const int bh = it >> 5, c = it & 31, b = bh >> 2, h = bh & 3;
        const float ginv = __builtin_amdgcn_exp2f(-128.0f * epi::log2_gamma(h));
#pragma unroll
        for (int jj = 0; jj < 2; ++jj) { const int jb = jb0 + jj;
            if (jb > ib) {
#pragma unroll
                for (int a = 0; a < 4; ++a) *(u32x2*)(PT + ((((size_t)it * 4 + ib) * 8 + (2 * jb + (a >> 1))) * 2 + (a & 1)) * 256 + r32 * 8 + 4 * hi) = (u32x2){0u, 0u};
            } else {
                const bf16_t* ka = Kp + epi::qt_index(b, c * 128 + jb * 32, h, 0) + lane * 8; const bf16_t* qa = Qp + epi::qt_index(b, c * 128 + ib * 32, h, 0) + lane * 8;
                bf16x8 fa[16], fb[16];
#pragma unroll
                for (int ks = 0; ks < 16; ++ks) { fa[ks] = *(const bf16x8*)(ka + ks * 512); fb[ks] = *(const bf16x8*)(qa + ks * 512); }
                f32x16 acc = {};
#pragma unroll
                for (int ks = 0; ks < 16; ++ks) acc = __builtin_amdgcn_mfma_f32_32x32x16_bf16(fa[ks], fb[ks], acc, 0, 0, 0);
#pragma unroll
                for (int a = 0; a < 4; ++a) { float v[4];
#pragma unroll
                    for (int x = 0; x < 4; ++x) { const int jl = jb * 32 + 8 * a + 4 * hi + x; v[x] = (jl <= ib * 32 + r32) ? acc[4 * a + x] * ginv : 0.f; }
                    u32x2 w; w.x = cvt_pk_bf16(v[0], v[1]); w.y = cvt_pk_bf16(v[2], v[3]);
                    *(u32x2*)(PT + ((((size_t)it * 4 + ib) * 8 + (2 * jb + (a >> 1))) * 2 + (a & 1)) * 256 + r32 * 8 + 4 * hi) = w; }
            } }
    }
}
constexpr int ST_PITCH = 264;
__device__ __forceinline__ void scan_item(Frame& F, int b, int h, int s, bool do_stats) {
    const int lane = lane_id(), wid = F.wave, r32 = lane & 31, hi = lane >> 5, ib = wid & 3; const bool heavy = wid < 4;
    const bf16_t* Qp = (const bf16_t*)(F.ws + WS_QP); const bf16_t* Ktp = (const bf16_t*)(F.ws + WS_KTP); const bf16_t* Vt = (const bf16_t*)(F.ws + WS_VT); const bf16_t* PT = (const bf16_t*)(F.ws + WS_PT);
    bf16_t* O = (bf16_t*)(F.out); float* stats = (float*)(F.ws + WS_STATS);
    LAS bf16_t* St = (LAS bf16_t*)(F.lds);
    const int bh = b * 4 + h;
    const float l2g = epi::log2_gamma(h), g128 = __builtin_amdgcn_exp2f(128.0f * l2g);
    const bf16_t* vB0 = Vt + epi::tt_index(bh, 16, s * 64, 0) + lane * 8;
    const bf16_t* vB1 = Vt + epi::tt_index(bh, 16, s * 64 + 32, 0) + lane * 8;
    const bf16_t* kA = Ktp + epi::tt_index(bh, 8, wid * 32, 0) + lane * 8;
    const bf16_t* qB = Qp + epi::qt_index(b, ib * 32, h, 0) + lane * 8;
    const bf16_t* pB = PT + (((size_t)bh * 32) * 4 + ib) * 8 * 512 + lane * 8;
    constexpr int ST_BYTES = 64 * ST_PITCH * 2, VT_OFF = 2 * ST_BYTES, OST_OFF = VT_OFF + 32768, OST_BYTES = 128 * 136;
    const bf16_t* vS = Vt + epi::tt_index(bh, 16, s * 64 + (wid >> 2) * 32, 0);
    const unsigned vdst0 = (unsigned)(uintptr_t)(F.lds + VT_OFF) + (unsigned)wid * 2048u;
#define VT_DMA(c_, buf_) do { const char* src_ = (const char*)(vS + (size_t)((c_) * 8 + 2 * (wid & 3)) * 512); \
        nsa::glds16(uni_ptr(src_), (unsigned)lane * 16u, (unsigned)__builtin_amdgcn_readfirstlane(vdst0 + (buf_) * 16384u)); \
        nsa::glds16(uni_ptr(src_ + 1024), (unsigned)lane * 16u, (unsigned)__builtin_amdgcn_readfirstlane(vdst0 + (buf_) * 16384u + 1024u)); } while (0)
    const LAS bf16_t* vl = (const LAS bf16_t*)(F.lds + VT_OFF) + lane * 8;
    f32x16 S0 = {}, S1 = {};
    bf16x8 kaf[8], ipb[8], qf[16];
#define LOAD_KA(c_) do { _Pragma("unroll") for (int ks = 0; ks < 8; ++ks) kaf[ks] = *(const bf16x8*)(kA + (size_t)((c_) * 8 + ks) * 512); } while (0)
#define LOAD_PB(c_) do { _Pragma("unroll") for (int ks = 0; ks < 8; ++ks) ipb[ks] = *(const bf16x8*)(pB + (size_t)(c_) * (4 * 8 * 512) + ks * 512); } while (0)
#define LOAD_Q(c_)  do { _Pragma("unroll") for (int ks = 0; ks < 16; ++ks) qf[ks] = *(const bf16x8*)(qB + (size_t)(c_) * (4 * 4 * 16 * 512) + ks * 512); } while (0)
#define STORE_ROWS(c_) do { _Pragma("unroll") for (int i2 = 0; i2 < 2; ++i2) { const int row = wid * 16 + i2 * 8 + (lane >> 3), q = lane & 7; const LAS unsigned char* os = F.lds + OST_OFF + ((c_) & 1) * OST_BYTES + row * 136 + q * 16; \
            const u32x2 lo = *(const LAS u32x2*)os, hi2 = *(const LAS u32x2*)(os + 8); \
            *(u32x4*)(O + ((size_t)b * SEQ + (c_) * 128 + row) * 2048 + h * 512 + s * 64 + q * 8) = (u32x4){lo.x, lo.y, hi2.x, hi2.y}; } \
        if (heavy && hi == 0 && do_stats) { float* sp = stats + ((size_t)bh * 2) * SEQ + (c_) * 128 + ib * 32 + r32; atomicAdd(sp, ps1); atomicAdd(sp + SEQ, ps2); } } while (0)
    float ps1 = 0.f, ps2 = 0.f;
    VT_DMA(0, 0);
    LOAD_KA(0); if (heavy) LOAD_PB(0);
    asm volatile("s_waitcnt vmcnt(0)\n\ts_barrier" ::: "memory");
    for (int c = 0; c < 32; ++c) {
        const LAS bf16_t* vb = vl + (c & 1) * 8192;
        const LAS bf16_t* sa = St + (c & 1) * (64 * ST_PITCH) + r32 * ST_PITCH + hi * 8;
        LAS bf16_t* Stn = St + ((c + 1) & 1) * (64 * ST_PITCH);
        if (c < 31) VT_DMA(c + 1, (c + 1) & 1);
        if (c > 0) { if (heavy) LOAD_Q(c); STORE_ROWS(c - 1); }
        if (c < 31) {
#pragma unroll
            for (int r = 0; r < 16; ++r) { S0[r] *= g128; S1[r] *= g128; }
#pragma unroll
            for (int ks = 0; ks < 8; ++ks) { S0 = __builtin_amdgcn_mfma_f32_32x32x16_bf16(kaf[ks], *(const LAS bf16x8*)(vb + ks * 512), S0, 0, 0, 0); S1 = __builtin_amdgcn_mfma_f32_32x32x16_bf16(kaf[ks], *(const LAS bf16x8*)(vb + (8 + ks) * 512), S1, 0, 0, 0); }
            if (c < 30) LOAD_KA(c + 1);
#pragma unroll
            for (int a = 0; a < 4; ++a) { u32x2 w; w.x = cvt_pk_bf16(S0[4 * a], S0[4 * a + 1]); w.y = cvt_pk_bf16(S0[4 * a + 2], S0[4 * a + 3]); *(LAS u32x2*)(Stn + r32 * ST_PITCH + wid * 32 + 8 * a + 4 * hi) = w;
                w.x = cvt_pk_bf16(S1[4 * a], S1[4 * a + 1]); w.y = cvt_pk_bf16(S1[4 * a + 2], S1[4 * a + 3]); *(LAS u32x2*)(Stn + (32 + r32) * ST_PITCH + wid * 32 + 8 * a + 4 * hi) = w; }
        }
        if (heavy) {
            f32x16 oc0 = {}, oc1 = {};
#pragma unroll
            for (int ks = 0; ks < 8; ++ks) { oc0 = __builtin_amdgcn_mfma_f32_32x32x16_bf16(*(const LAS bf16x8*)(vb + ks * 512), ipb[ks], oc0, 0, 0, 0); oc1 = __builtin_amdgcn_mfma_f32_32x32x16_bf16(*(const LAS bf16x8*)(vb + (8 + ks) * 512), ipb[ks], oc1, 0, 0, 0); }
            if (c < 31) LOAD_PB(c + 1);
            if (c > 0) {
#pragma unroll
                for (int ks = 0; ks < 16; ++ks) { oc0 = __builtin_amdgcn_mfma_f32_32x32x16_bf16(*(const LAS bf16x8*)(sa + ks * 16), qf[ks], oc0, 0, 0, 0); oc1 = __builtin_amdgcn_mfma_f32_32x32x16_bf16(*(const LAS bf16x8*)(sa + 32 * ST_PITCH + ks * 16), qf[ks], oc1, 0, 0, 0); } }
            float s1 = 0.f, s2 = 0.f;
#pragma unroll
            for (int r = 0; r < 16; ++r) { s1 += oc0[r] + oc1[r]; s2 += oc0[r] * oc0[r] + oc1[r] * oc1[r]; }
            ps1 = nsa::halfsum(s1); ps2 = nsa::halfsum(s2);
            LAS unsigned char* ow = F.lds + OST_OFF + (c & 1) * OST_BYTES + (ib * 32 + r32) * 136 + (4 * hi) * 2;
#pragma unroll
            for (int a = 0; a < 4; ++a) { u32x2 w; w.x = cvt_pk_bf16(oc0[4 * a], oc0[4 * a + 1]); w.y = cvt_pk_bf16(oc0[4 * a + 2], oc0[4 * a + 3]); *(LAS u32x2*)(ow + 16 * a) = w;
                w.x = cvt_pk_bf16(oc1[4 * a], oc1[4 * a + 1]); w.y = cvt_pk_bf16(oc1[4 * a + 2], oc1[4 * a + 3]); *(LAS u32x2*)(ow + 64 + 16 * a) = w; }
        }
        asm volatile("s_waitcnt vmcnt(0) lgkmcnt(0)\n\ts_barrier" ::: "memory");
    }
    STORE_ROWS(31);
#undef LOAD_KA
#undef LOAD_PB
#undef LOAD_Q
#undef STORE_ROWS
#undef VT_DMA
    __syncthreads();
}
__device__ __forceinline__ void scan_phase(Frame& F, bool do_stats) {
    for (int it = F.vcu; it < 256; it += F.G) scan_item(F, it >> 5, (it >> 3) & 3, it & 7, do_stats);
}
}

__global__ void __launch_bounds__(NWAVES * 64, 2) mk_fwd(Args args) {
    extern __shared__ __attribute__((aligned(16))) unsigned char lds_raw[];
    Frame F;
    F.lds = (LAS unsigned char*)lds_raw;
    F.MISC = (volatile LAS unsigned*)(F.lds + MISC_OFF);
    F.wave = __builtin_amdgcn_readfirstlane(threadIdx.x >> 6);
    F.G = gridDim.x; { const int bx = blockIdx.x; F.vcu = (F.G % 8 == 0) ? (bx % 8) * (F.G / 8) + bx / 8 : bx; }
    F.out = args.out; F.ws = args.ws; F.ctl = (unsigned*)(args.ws + WS_CTL);
    unsigned char* ws = F.ws; unsigned char* dout = F.out;
    for (int u = F.wave * 64 + lane_id(); u < (LDS_BYTES - LDSCTL_OFF) / 4; u += NWAVES * 64) ((LAS unsigned*)(F.lds + LDSCTL_OFF))[u] = 0u;
    __syncthreads();
    XcdBarrier bar = xcd_barrier_post(F.ctl + CW_BAR, F.MISC + 8, F.wave);
    cg::grid_group grid = cg::this_grid();
    const int lo = args.ph_lo, hi = args.ph_hi, bx = (int)blockIdx.x, G = F.G;
#ifndef PROBE_PH
#define PROBE_PH (-1)
#endif
#ifndef PROBE_GEMM
#define PROBE_GEMM 0
#endif
#define REPS(k, isgemm) (((PROBE_PH) == (k) || ((isgemm) && PROBE_GEMM)) ? 2 : 1)
#define IN(k) (lo <= (k) && (k) < hi)
#if defined(PROBE_BAR)
#define SEAM(k) do { if (IN(k) && IN((k) + 1)) { xcd_barrier(bar); xcd_barrier(bar); } } while (0)
#else
#define SEAM(k) do { if (IN(k) && IN((k) + 1)) xcd_barrier(bar); } while (0)
#endif
    LAS unsigned char* ring = F.lds;

    if (IN(0)) { for (int rep = 0; rep < REPS(0, 0); ++rep) p0_prologue(F, args, rep == 0); if (IN(1)) grid.sync(); }

    if (IN(1)) for (int rep = 0; rep < REPS(1, 1); ++rep) {
        pg8::Gemm g{(const char*)(ws + WS_XB), (const char*)(ws + WS_WNIN), 2048u, 2048u, 128u, 128u, 1024};
        pg8::SchedStd S; S.init(128, 14, 0, G, bx, (size_t)256 * 2048, (size_t)256 * 2048);
        epi::NsaIn E{ws, dout};
        pg8::gemm_phase<epi::NsaIn, pg8::SchedStd, false>(ring, F.wave, g, S, E);
    }
    SEAM(1);
    if (IN(2)) for (int rep = 0; rep < REPS(2, 0); ++rep) {
        const bool cmp_cu = (G == 256) ? (bx < 64) : true, other_cu = (G == 256) ? (bx >= 64) : true;
        if (cmp_cu) {
            pg8::Gemm g{(const char*)(ws + WS_KC), (const char*)(ws + WS_WC1K), 8192u, 4096u, 512u, 128u, 2048};
            pg8::SchedCmp S{G, bx, WS_VC - WS_KC, WS_WC1V - WS_WC1K};
            epi::Cmp1 E{ws};
            pg8::gemm_phase<epi::Cmp1, pg8::SchedCmp, false>(ring, F.wave, g, S, E);
            VM_WAIT(); __syncthreads();
            __builtin_amdgcn_fence(__ATOMIC_ACQUIRE, "agent"); VM_WAIT();
            for (int u = bx; u < 64; u += G) cmp2_task(F, (u >> 5) * 256 + (u & 31) * 8 + F.wave);
        }
        { const int G2 = (G == 256) ? (cmp_cu ? 64 : 192) : G, c2 = (G == 256) ? (cmp_cu ? bx : bx - 64) : bx, u0 = (G == 256 && !cmp_cu) ? 64 : 0, u1 = (G == 256 && cmp_cu) ? 64 : 512;
          { pg8::Gemm g{(const char*)(ws + WS_PB0), (const char*)(ws + WS_WP0), 512u, 512u, 128u, 128u, 256};
            pg8::SchedStd S; S.init(128, 4, 0, G2, c2, (size_t)256 * 512, (size_t)256 * 512); S.range(u0, u1);
            epi::Bf16Plain E{(bf16_t*)(ws + WS_E0), 1024, 0};
            pg8::gemm_phase<epi::Bf16Plain, pg8::SchedStd, false>(ring, F.wave, g, S, E); }
          { pg8::Gemm g{(const char*)(ws + WS_PB1), (const char*)(ws + WS_WP1), 512u, 512u, 128u, 128u, 256};
            pg8::SchedStd S; S.init(128, 4, 0, G2, c2, (size_t)256 * 512, (size_t)256 * 512); S.range(u0, u1);
            epi::Bf16Plain E{(bf16_t*)(ws + WS_E1), 1024, 0};
            pg8::gemm_phase<epi::Bf16Plain, pg8::SchedStd, false>(ring, F.wave, g, S, E); }
          if (G == 256) { if (bx >= 128) for (int task = (bx - 128) * NWAVES + F.wave; task < 1024; task += 128 * NWAVES) gates_task(F, task); }
          else for (int task = bx * NWAVES + F.wave; task < 1024; task += G * NWAVES) gates_task(F, task);
          (void)other_cu; }
    }
    SEAM(3);
    if (IN(4)) for (int rep = 0; rep < REPS(4, 0); ++rep) nsa::nsa_phase(F);
    SEAM(4);
    if (IN(5)) for (int rep = 0; rep < REPS(5, 1); ++rep) {
        pg8::Gemm g{(const char*)(ws + WS_ATT), (const char*)(ws + WS_WNOUT), 2048u, 2048u, 128u, 128u, 1024};
        pg8::SchedStd S; S.init(128, 4, 0, G, bx, (size_t)256 * 2048, (size_t)256 * 2048);
        epi::Res<0> E{args.in[0], ws};
        pg8::gemm_phase<epi::Res<0>, pg8::SchedStd, false>(ring, F.wave, g, S, E);
    }
    SEAM(5);
    if (IN(6)) {
        pg8::Gemm g{(const char*)(ws + WS_X1B), (const char*)(ws + WS_WG0), 2048u, 2048u, 128u, 128u, 1024};
        pg8::SchedStd S; S.init(128, 4, 0, G, bx, (size_t)256 * 2048, (size_t)256 * 2048);
        epi::Ple<0> E{ws, dout};
        pg8::gemm_phase<epi::Ple<0>, pg8::SchedStd, false>(ring, F.wave, g, S, E);
    }
    SEAM(6);
    if (IN(7)) for (int rep = 0; rep < REPS(7, 1); ++rep) {
        pg8::Gemm g{(const char*)(ws + WS_XB), (const char*)(ws + WS_WRIN), 2048u, 2048u, 128u, 128u, 1024};
        { pg8::SchedStd S; S.init(128, 4, 0, G, bx, (size_t)256 * 2048, (size_t)256 * 2048);
          epi::RetQ E{ws};
          pg8::gemm_phase<epi::RetQ, pg8::SchedStd, false>(ring, F.wave, g, S, E);
#if defined(PROBE_P7) && PROBE_P7 == 1
          pg8::gemm_phase<epi::RetQ, pg8::SchedStd, false>(ring, F.wave, g, S, E);
#endif
          }
        { pg8::SchedStd S; S.init(128, 12, 4, G, bx, (size_t)256 * 2048, (size_t)256 * 2048);
          epi::RetKV E{ws, dout};
          pg8::gemm_phase<epi::RetKV, pg8::SchedStd, true>(ring, F.wave, g, S, E);
#if defined(PROBE_P7) && PROBE_P7 == 2
          pg8::gemm_phase<epi::RetKV, pg8::SchedStd, true>(ring, F.wave, g, S, E);
#endif
          }
    }
    SEAM(7);
    if (IN(8)) for (int rep = 0; rep < REPS(8, 0); ++rep) ret::p_phase(F);
    SEAM(8);
    if (IN(9)) for (int rep = 0; rep < REPS(9, 0); ++rep) ret::scan_phase(F, rep == 0);
    SEAM(9);
    if (IN(10)) {
        pg8::Gemm g{(const char*)(ws + WS_XB), (const char*)(ws + WS_WRIN), 2048u, 2048u, 128u, 128u, 1024};
        pg8::SchedStd S; S.init(128, 8, 16, G, bx, (size_t)256 * 2048, (size_t)256 * 2048);
        epi::RetZ E{ws, dout};
        pg8::gemm_phase<epi::RetZ, pg8::SchedStd, false>(ring, F.wave, g, S, E);
    }
    SEAM(10);
    if (IN(11)) for (int rep = 0; rep < REPS(11, 1); ++rep) {
        { pg8::Gemm g{(const char*)dout, (const char*)(ws + WS_WROUT), 4096u, 4096u, 128u, 128u, 2048};
          pg8::SchedStd S; S.init(128, 4, 0, G, bx, (size_t)256 * 4096, (size_t)256 * 4096);
          epi::Res<1> E{nullptr, ws};
          pg8::gemm_phase<epi::Res<1>, pg8::SchedStd, false>(ring, F.wave, g, S, E); }
    }
    SEAM(11);
    if (IN(12)) for (int rep = 0; rep < REPS(12, 1); ++rep) {
        pg8::Gemm g{(const char*)(ws + WS_X3B), (const char*)(ws + WS_WG1), 2048u, 2048u, 128u, 128u, 1024};
        pg8::SchedStd S; S.init(128, 4, 0, G, bx, (size_t)256 * 2048, (size_t)256 * 2048);
        epi::Ple<1> E{ws, dout};
        pg8::gemm_phase<epi::Ple<1>, pg8::SchedStd, false>(ring, F.wave, g, S, E);
    }
#undef IN
#undef SEAM
}

extern "C" void kernel_launch(void* const* d_in, const int* in_sizes, int n_in, void* d_out, int out_size, void* d_ws, size_t ws_size, hipStream_t stream) {
    static int grid = 0;
    if (grid == 0) {
        if (n_in != 19 || out_size != T_TOK * DM || ws_size < WS_END) { fprintf(stderr, "kernel_launch: unexpected problem (n_in %d, out %d, ws %zu)\n", n_in, out_size, ws_size); grid = -1; return; }
        int dev = 0, cus = 0, per_cu = 0;
        (void)hipGetDevice(&dev); (void)hipDeviceGetAttribute(&cus, hipDeviceAttributeMultiprocessorCount, dev);
        if (hipFuncSetAttribute((const void*)mk_fwd, hipFuncAttributeMaxDynamicSharedMemorySize, LDS_BYTES) != hipSuccess) { fprintf(stderr, "kernel_launch: hipFuncSetAttribute failed\n"); grid = -1; return; }
        if (hipOccupancyMaxActiveBlocksPerMultiprocessor(&per_cu, (const void*)mk_fwd, NWAVES * 64, LDS_BYTES) != hipSuccess || per_cu < 1) { fprintf(stderr, "kernel_launch: occupancy query gave %d\n", per_cu); per_cu = 1; }
        (void)hipGetLastError();
        if (per_cu > 1) per_cu = 1;
        grid = cus * per_cu;
    }
    if (grid < 0) return;
    (void)hipMemsetAsync((char*)d_ws + WS_CTL, 0, ZERO_BYTES, stream);
    Args a{};
    for (int i = 0; i < 19; ++i) a.in[i] = (const float*)d_in[i];
    a.out = (unsigned char*)d_out; a.ws = (unsigned char*)d_ws; a.ph_lo = 0; a.ph_hi = 13;
    void* kargs[] = {&a};
    hipError_t e = hipLaunchCooperativeKernel((const void*)mk_fwd, dim3(grid), dim3(NWAVES * 64), kargs, LDS_BYTES, stream);
    if (e != hipSuccess) fprintf(stderr, "kernel_launch: cooperative launch failed: %s (grid %d)\n", hipGetErrorString(e), grid);
}
```

```cpp
#include <hip/hip_runtime.h>
#include <hip/hip_cooperative_groups.h>
#include <cstdio>
#include <cstdint>
namespace cg = cooperative_groups;

#define LAS __attribute__((address_space(3)))
#define GAS __attribute__((address_space(1)))
typedef unsigned short bf16_t;
typedef short bf16x8 __attribute__((ext_vector_type(8)));
typedef short s16x4 __attribute__((ext_vector_type(4)));
typedef float f32x2 __attribute__((ext_vector_type(2)));
typedef float f32x4 __attribute__((ext_vector_type(4)));
typedef float f32x16 __attribute__((ext_vector_type(16)));
typedef unsigned u32x2 __attribute__((ext_vector_type(2)));
typedef unsigned u32x4 __attribute__((ext_vector_type(4)));

constexpr int T_TOK = 32768, SEQ = 4096, NB = 8, DM = 1024;
constexpr float LOG2E = 1.4426950408889634f;
constexpr float RMS_EPS = 1e-6f, GN_EPS = 1e-5f;

typedef __bf16 bf16x2_t __attribute__((ext_vector_type(2)));
__device__ __forceinline__ unsigned cvt_pk_bf16(float lo, float hi) { const f32x2 v = {lo, hi}; const bf16x2_t b = __builtin_convertvector(v, bf16x2_t); return __builtin_bit_cast(unsigned, b); }
__device__ __forceinline__ float bf_lo(unsigned w) { return __uint_as_float(w << 16); }
__device__ __forceinline__ float bf_hi(unsigned w) { return __uint_as_float(w & 0xffff0000u); }
__device__ __forceinline__ int lane_id() { int l; asm volatile("v_mbcnt_lo_u32_b32 %0, -1, 0\n\tv_mbcnt_hi_u32_b32 %0, -1, %0" : "=v"(l)); return l; }
__device__ __forceinline__ const char* uni_ptr(const char* p) {
    const unsigned long long v = (unsigned long long)p; const unsigned lo = __builtin_amdgcn_readfirstlane((unsigned)v), hi = __builtin_amdgcn_readfirstlane((unsigned)(v >> 32));
    return (const char*)(((unsigned long long)hi << 32) | lo); }
__device__ __forceinline__ float fast_rcp(float x) { return __builtin_amdgcn_rcpf(x); }
__device__ __forceinline__ float sigmoidf_(float x) { return fast_rcp(1.0f + __builtin_amdgcn_exp2f(-x * LOG2E)); }
__device__ __forceinline__ float siluf_(float x) { return x * sigmoidf_(x); }

template <class T> __device__ __forceinline__ void st_nt(T* p, const T v) { __builtin_nontemporal_store(v, p); }
namespace pg8 {
constexpr int BM = 256, BK = 64, HALF = 128, HTB = HALF * BK * 2, STAGE_BYTES = 8 * HTB, NXCD = 8, WGM = 8;
__host__ __device__ __forceinline__ int lds_byte(int r, int c) { const int st = (r >> 4) * 2 + (c >> 5), rr = r & 15, cc = c & 31, ob = rr * 64 + cc * 2; return st * 1024 + (ob ^ (((ob >> 9) & 1) << 5)); }
__host__ __device__ __forceinline__ void stage_rc(int b, int& R, int& C) { const int st = b / 1024, sb = b % 1024, swz = sb ^ (((sb >> 9) & 1) << 5); R = (st >> 1) * 16 + swz / 64; C = (st & 1) * 32 + (swz % 64) / 2; }
__host__ __device__ __forceinline__ int perm32(int rho) { const int n = rho >> 4, i = rho & 15; return 8 * (i >> 2) + 4 * n + (i & 3); }

struct Unit { int pm, pn; };
struct Gemm { const char* A; const char* Bt; unsigned lda, ldb; unsigned ksA, ksB; int K; };

struct SchedStd {
    int nM, nN, nwg, G, c, pn0, first, last; size_t a_ts, b_ts;
    __device__ __forceinline__ void init(int nM_, int nN_, int pn0_, int G_, int c_, size_t a_ts_, size_t b_ts_) { nM = nM_; nN = nN_; nwg = nM * nN; G = G_; c = c_; pn0 = pn0_; a_ts = a_ts_; b_ts = b_ts_; first = 0; last = nwg; }
    __device__ __forceinline__ void range(int first_, int last_) { first = first_; last = last_; }
    __device__ __forceinline__ bool next(int i, Unit& u) const {
        const long L = (long)first + (long)i * G + c; if (L >= last) return false;
        int wgid = (int)L; { const int q = nwg / NXCD, r = nwg % NXCD, xcd = wgid % NXCD, off = wgid / NXCD; wgid = (xcd < r ? xcd * (q + 1) : r * (q + 1) + (xcd - r) * q) + off; }
#if defined(SCHED_PNMAJOR)
        u.pm = (int)(L % nM); u.pn = pn0 + (int)(L / nM); return true;
#else
        const int nig = WGM * nN, gid = wgid / nig, fm = gid * WGM, gsz = (nM - fm) < WGM ? (nM - fm) : WGM;
        u.pm = fm + ((wgid % nig) % gsz); u.pn = pn0 + (wgid % nig) / gsz; return true;
#endif
    }
    __device__ __forceinline__ unsigned a_off(const Unit& u) const { return (unsigned)u.pm * (unsigned)a_ts; }
    __device__ __forceinline__ unsigned b_off(const Unit& u) const { return (unsigned)u.pn * (unsigned)b_ts; }
};
struct SchedCmp {
    int G, c; size_t kv_stride_a, kv_stride_b;
    __device__ __forceinline__ bool next(int i, Unit& u) const { const int L = i * G + c; if (L >= 64) return false; u.pm = L; u.pn = 0; return true; }
    __device__ __forceinline__ unsigned a_off(const Unit& u) const { return (unsigned)(u.pm >> 5) * (unsigned)kv_stride_a + (unsigned)((u.pm >> 2) & 7) * (unsigned)(SEQ * 512) + (unsigned)(u.pm & 3) * 128u; }
    __device__ __forceinline__ unsigned b_off(const Unit& u) const { return (unsigned)(u.pm >> 5) * (unsigned)kv_stride_b; }
};

template <class Epi, class Sched, bool SWAP>
__device__ __forceinline__ void gemm_phase(LAS unsigned char* lds, const int wid, const Gemm g, const Sched& S, const Epi& E) {
    const int lane = lane_id(), tid = wid * 64 + lane, wr = wid >> 2, wc = wid & 3, fr = lane & 15, fq = lane >> 4;
    const int nt = g.K / BK;
    unsigned voffA[2], voffB[2];
#pragma unroll
    for (int i = 0; i < 2; ++i) { int R, C; stage_rc(tid * 16 + i * 8192, R, C); const int Rb = (!SWAP) ? ((R & ~31) + perm32(R & 31)) : R;
        voffA[i] = (unsigned)R * g.lda + (unsigned)C * 2u; voffB[i] = (unsigned)Rb * g.ldb + (unsigned)C * 2u; }
    const unsigned ksA = g.ksA, ksB = g.ksB;
    const unsigned hsA = (unsigned)HALF * g.lda, hsB = (unsigned)HALF * g.ldb;
    const unsigned ldsw = (unsigned)wid * 1024u;
    const int aoff = lds_byte(wr * 64 + fr, fq * 8), boff = lds_byte(wc * 32 + fr, fq * 8);
    const __amdgpu_buffer_rsrc_t rsA = __builtin_amdgcn_make_buffer_rsrc((void*)g.A, (short)0, 0x7fffffff, 0x00020000);
    const __amdgpu_buffer_rsrc_t rsB = __builtin_amdgcn_make_buffer_rsrc((void*)g.Bt, (short)0, 0x7fffffff, 0x00020000);
#define PG8_SA(b, h) (((b) * 2 + (h)) * HTB)
#define PG8_SB(b, h) ((4 + (b) * 2 + (h)) * HTB)
#define PG8_STAGE(bufoff, rs, soff, voff) do { _Pragma("unroll") for (int _i = 0; _i < 2; ++_i) \
        __builtin_amdgcn_raw_ptr_buffer_load_lds((rs), (LAS unsigned*)(lds + (bufoff) + ldsw + _i * 8192), 16, (int)(voff)[_i], (int)(soff), 0, 0); } while (0)
#define PG8_LDA(dst, b, h) do { _Pragma("unroll") for (int m = 0; m < 4; ++m) _Pragma("unroll") for (int k = 0; k < 2; ++k) dst[m][k] = *(const LAS bf16x8*)(lds + PG8_SA(b, h) + aoff + m * 2048 + k * 1024); } while (0)
#define PG8_LDB(dst, b, h) do { _Pragma("unroll") for (int n = 0; n < 2; ++n) _Pragma("unroll") for (int k = 0; k < 2; ++k) dst[n][k] = *(const LAS bf16x8*)(lds + PG8_SB(b, h) + boff + n * 2048 + k * 1024); } while (0)
#define PG8_MMA(ai, bj, At, Bt) do { __builtin_amdgcn_s_setprio(1); _Pragma("unroll") for (int m = 0; m < 4; ++m) _Pragma("unroll") for (int n = 0; n < 2; ++n) _Pragma("unroll") for (int k = 0; k < 2; ++k) \
        acc[ai][bj][m][n] = SWAP ? __builtin_amdgcn_mfma_f32_16x16x32_bf16(At[m][k], Bt[n][k], acc[ai][bj][m][n], 0, 0, 0) : __builtin_amdgcn_mfma_f32_16x16x32_bf16(Bt[n][k], At[m][k], acc[ai][bj][m][n], 0, 0, 0); __builtin_amdgcn_s_setprio(0); } while (0)
#define PG8_WAIT_V(n) asm volatile("s_waitcnt vmcnt(" #n ")" ::: "memory")
#define PG8_WAIT_L(n) asm volatile("s_waitcnt lgkmcnt(" #n ")" ::: "memory")
#define PG8_BAR __builtin_amdgcn_s_barrier()
#define PG8_SCHED __builtin_amdgcn_sched_barrier(0)
    Unit cur, nxt; int ui = 0;
    if (!S.next(0, cur)) return;
    f32x4 acc[2][2][4][2];
#pragma unroll
    for (int a = 0; a < 2; ++a)
#pragma unroll
        for (int b = 0; b < 2; ++b)
#pragma unroll
            for (int m = 0; m < 4; ++m)
#pragma unroll
                for (int n = 0; n < 2; ++n) acc[a][b][m][n] = (f32x4){0.f, 0.f, 0.f, 0.f};
    bf16x8 At[4][2], B0[2][2], B1[2][2];
    unsigned cA = S.a_off(cur), cB = S.b_off(cur);
    PG8_STAGE(PG8_SB(0, 0), rsB, cB, voffB); PG8_STAGE(PG8_SB(0, 1), rsB, cB + hsB, voffB); PG8_STAGE(PG8_SA(0, 0), rsA, cA, voffA); PG8_STAGE(PG8_SA(0, 1), rsA, cA + hsA, voffA);
    if (wr == 1) PG8_BAR;
    PG8_WAIT_V(2); PG8_BAR;
    PG8_STAGE(PG8_SB(1, 0), rsB, cB + ksB, voffB); PG8_STAGE(PG8_SA(1, 0), rsA, cA + ksA, voffA); PG8_STAGE(PG8_SB(1, 1), rsB, cB + hsB + ksB, voffB);
    PG8_WAIT_V(6); PG8_BAR;
    for (;;) {
        const bool has_next = S.next(ui + 1, nxt);
        const unsigned nA = has_next ? S.a_off(nxt) : cA, nB = has_next ? S.b_off(nxt) : cB;
        for (int t = 0; t < nt; t += 2) {
            const bool last = (t == nt - 2);
            const unsigned a1 = cA + (unsigned)(t + 1) * ksA;
            const unsigned a2 = last ? nA : cA + (unsigned)(t + 2) * ksA, b2 = last ? nB : cB + (unsigned)(t + 2) * ksB;
            const unsigned a3 = a2 + ksA, b3 = b2 + ksB;
            PG8_LDB(B0, 0, 0); PG8_LDB(B1, 0, 1); PG8_SCHED; PG8_LDA(At, 0, 0); PG8_STAGE(PG8_SA(1, 1), rsA, a1 + hsA, voffA);
            PG8_WAIT_V(8); PG8_WAIT_L(0); PG8_BAR; PG8_MMA(0, 0, At, B0); PG8_MMA(0, 1, At, B1); PG8_BAR; PG8_SCHED;
            PG8_LDA(At, 0, 1); PG8_STAGE(PG8_SB(0, 0), rsB, b2, voffB); PG8_STAGE(PG8_SB(0, 1), rsB, b2 + hsB, voffB); PG8_STAGE(PG8_SA(0, 0), rsA, a2, voffA);
            PG8_WAIT_V(8); PG8_WAIT_L(0); PG8_BAR; PG8_MMA(1, 0, At, B0); PG8_MMA(1, 1, At, B1); PG8_BAR; PG8_SCHED;
            PG8_LDB(B0, 1, 0); PG8_LDB(B1, 1, 1); PG8_SCHED; PG8_LDA(At, 1, 0); PG8_STAGE(PG8_SA(0, 1), rsA, a2 + hsA, voffA);
            PG8_WAIT_V(8); PG8_WAIT_L(0); PG8_BAR; PG8_MMA(0, 0, At, B0); PG8_MMA(0, 1, At, B1); PG8_BAR; PG8_SCHED;
            PG8_LDA(At, 1, 1); PG8_STAGE(PG8_SB(1, 0), rsB, b3, voffB); PG8_STAGE(PG8_SB(1, 1), rsB, b3 + hsB, voffB); PG8_STAGE(PG8_SA(1, 0), rsA, a3, voffA);
            PG8_WAIT_V(8); PG8_WAIT_L(0); PG8_BAR; PG8_MMA(1, 0, At, B0); PG8_MMA(1, 1, At, B1); PG8_BAR; PG8_SCHED;
        }
        if (wr == 0) PG8_BAR;
        E(acc, cur, wr, wc, fr, fq);
#if defined(PROBE_EPI)
        if (Epi::ID == PROBE_EPI) { asm volatile("" ::: "memory"); E(acc, cur, wr, wc, fr, fq); }
#endif
#if defined(PROBE_ST)
        if constexpr (Epi::ID == 30) { asm volatile("" ::: "memory"); E.probe(acc, cur, wr, wc, fr, fq); }
#endif
        if (!has_next) break;
#pragma unroll
        for (int a = 0; a < 2; ++a)
#pragma unroll
            for (int b = 0; b < 2; ++b)
#pragma unroll
                for (int m = 0; m < 4; ++m)
#pragma unroll
                    for (int n = 0; n < 2; ++n) acc[a][b][m][n] = (f32x4){0.f, 0.f, 0.f, 0.f};
        cur = nxt; cA = nA; cB = nB; ++ui;
        if (wr == 1) PG8_BAR;
    }
    PG8_WAIT_V(0);
    PG8_BAR;
#undef PG8_SA
#undef PG8_SB
#undef PG8_STAGE
#undef PG8_LDA
#undef PG8_LDB
#undef PG8_MMA
#undef PG8_WAIT_V
#undef PG8_WAIT_L
#undef PG8_BAR
#undef PG8_SCHED
}
typedef f32x4 Acc[2][2][4][2];
}

constexpr size_t MiB = 1u << 20;
constexpr size_t WS_CTL = 0, WS_ROWSC0 = 1 * MiB, WS_ROWSS1 = 1 * MiB + 128 * 1024, WS_CBIAS = 1 * MiB + 256 * 1024, WS_GAINS = 1 * MiB + 264 * 1024, WS_STATS = 2 * MiB, ZERO_BYTES = 3 * MiB;
constexpr size_t WS_WRIN = 3 * MiB, WS_WROUT = 15 * MiB, WS_WG1 = 19 * MiB, WS_WP1 = 21 * MiB;
constexpr size_t WS_X2 = 22 * MiB;
constexpr size_t WS_XB = 150 * MiB;
constexpr size_t WS_PB0 = 214 * MiB;
constexpr size_t WS_KC = 230 * MiB, WS_VC = 246 * MiB, WS_KS = 262 * MiB, WS_VS = 278 * MiB, WS_KW = 294 * MiB, WS_VW = 310 * MiB;
constexpr size_t WS_G = 326 * MiB, WS_E0 = 332 * MiB, WS_ATT = 396 * MiB;
constexpr size_t WS_COS = 470 * MiB, WS_SIN = 472 * MiB, WS_COST = 102 * MiB, WS_SINT = 104 * MiB;
constexpr size_t WS_WNIN = 474 * MiB, WS_WNOUT = 482 * MiB, WS_WG0 = 484 * MiB, WS_WP0 = 486 * MiB, WS_WC1K = 487 * MiB, WS_WC1V = 488 * MiB, WS_WC2K = 489 * MiB, WS_WC2V = 489 * MiB + 65536, WS_WGT = 490 * MiB;
constexpr size_t WS_HID = 492 * MiB, WS_KCC = 500 * MiB, WS_VCC = 501 * MiB;
constexpr size_t WS_X1B = 230 * MiB;
constexpr size_t WS_QP = 214 * MiB, WS_KTP = 278 * MiB, WS_VT = 342 * MiB, WS_PT = 470 * MiB, WS_PB1 = 22 * MiB;
constexpr size_t WS_X3B = 342 * MiB, WS_E1 = 38 * MiB;
constexpr size_t WS_END = 512 * MiB;
constexpr size_t DO_Q = 0, DO_Z = 64 * MiB;
constexpr int CW_BAR = 4096;
constexpr int RING_BYTES = 131072, LDSCTL_OFF = 150016, MISC_OFF = LDSCTL_OFF + 320, LDS_GATE = 151552, LDS_BYTES = 154624;
constexpr int NWAVES = 8;


namespace epi {
using pg8::Unit; using pg8::Acc;
__device__ __forceinline__ u32x4 pack8(const f32x4& a, const f32x4& b) { u32x4 w; w.x = cvt_pk_bf16(a[0], a[1]); w.y = cvt_pk_bf16(a[2], a[3]); w.z = cvt_pk_bf16(b[0], b[1]); w.w = cvt_pk_bf16(b[2], b[3]); return w; }
__device__ __forceinline__ void unpack8(const u32x4& w, f32x4& a, f32x4& b) { a[0] = bf_lo(w.x); a[1] = bf_hi(w.x); a[2] = bf_lo(w.y); a[3] = bf_hi(w.y); b[0] = bf_lo(w.z); b[1] = bf_hi(w.z); b[2] = bf_lo(w.w); b[3] = bf_hi(w.w); }
__device__ __forceinline__ float dot4(const f32x4& a) { return (a[0] * a[0] + a[1] * a[1]) + (a[2] * a[2] + a[3] * a[3]); }

struct Bf16Plain {
    static constexpr int ID = 10;
    static constexpr bool PERM = true;
    bf16_t* O; int ldc; int col0;
    __device__ __forceinline__ void operator()(const Acc& acc, const Unit& u, int wr, int wc, int fr, int fq) const {
#pragma unroll
        for (int ai = 0; ai < 2; ++ai)
#pragma unroll
            for (int m = 0; m < 4; ++m) { const int row = u.pm * 256 + ai * 128 + wr * 64 + m * 16 + fr; bf16_t* rp = O + (size_t)row * ldc + (u.pn * 256 - col0 + wc * 32 + fq * 8);
#pragma unroll
                for (int bj = 0; bj < 2; ++bj) st_nt((u32x4*)(rp + bj * 128), (u32x4)(pack8(acc[ai][bj][m][0], acc[ai][bj][m][1]))); }
    }
};
struct Cmp1 {
    static constexpr int ID = 20;
    static constexpr bool PERM = true;
    unsigned char* ws;
    __device__ __forceinline__ void operator()(const Acc& acc, const Unit& u, int wr, int wc, int fr, int fq) const {
        bf16_t* H = (bf16_t*)(ws + WS_HID);
        const float* bb = (const float*)(ws + WS_CBIAS) + (u.pm >> 5) * 256;
        f32x4 bv[2][2];
#pragma unroll
        for (int bj = 0; bj < 2; ++bj)
#pragma unroll
            for (int n = 0; n < 2; ++n) bv[bj][n] = *(const f32x4*)(bb + bj * 128 + wc * 32 + fq * 8 + n * 4);
#pragma unroll
        for (int ai = 0; ai < 2; ++ai)
#pragma unroll
            for (int m = 0; m < 4; ++m) { const int row = u.pm * 256 + ai * 128 + wr * 64 + m * 16 + fr; bf16_t* rp = H + (size_t)row * 256 + (wc * 32 + fq * 8);
#pragma unroll
                for (int bj = 0; bj < 2; ++bj) { f32x4 v0 = acc[ai][bj][m][0] + bv[bj][0], v1 = acc[ai][bj][m][1] + bv[bj][1];
#pragma unroll
                    for (int x = 0; x < 4; ++x) { v0[x] = siluf_(v0[x]); v1[x] = siluf_(v1[x]); }
                    *(u32x4*)(rp + bj * 128) = pack8(v0, v1); } }
    }
};
struct NsaIn {
    static constexpr int ID = 30;
    static constexpr bool PERM = true;
    unsigned char* ws; unsigned char* dout;
    __device__ __forceinline__ void operator()(const Acc& acc, const Unit& u, int wr, int wc, int fr, int fq) const {
        const int pn = u.pn;
        const float* rowscale = (const float*)(ws + WS_ROWSC0); const float* gains = (const float*)(ws + WS_GAINS);
        const float *q_g = gains, *ks_g = gains + 128, *kw_g = gains + 192;
        bf16_t* Q = (bf16_t*)(dout + DO_Q); bf16_t* Z = (bf16_t*)(dout + DO_Z);
        const bool normed = (pn < 4) || pn == 6 || pn == 8;
        f32x4 gq[2][2];
        if (normed) { const float* gp = (pn < 4) ? q_g : (pn == 6 ? ks_g : kw_g); const float sc = (pn < 4) ? 0.125f * LOG2E : 1.0f;
#pragma unroll
            for (int bj = 0; bj < 2; ++bj)
#pragma unroll
                for (int n = 0; n < 2; ++n) gq[bj][n] = *(const f32x4*)(gp + bj * 32 + fq * 8 + n * 4) * sc; }
        bf16_t* dst; int ldc, cbase;
        if (pn < 4) { dst = Q; ldc = 1024; cbase = pn * 256; }
        else if (pn < 10) { dst = (bf16_t*)(ws + WS_KC + (size_t)(pn - 4) * (16 * MiB)); ldc = 256; cbase = 0; }
        else { dst = Z; ldc = 1024; cbase = (pn - 10) * 256; }
        float rsc[8];
#pragma unroll
        for (int i = 0; i < 8; ++i) rsc[i] = rowscale[u.pm * 256 + (i >> 2) * 128 + wr * 64 + (i & 3) * 16 + fr];
#pragma unroll
        for (int ai = 0; ai < 2; ++ai)
#pragma unroll
            for (int m = 0; m < 4; ++m) {
                const int row = u.pm * 256 + ai * 128 + wr * 64 + m * 16 + fr; const float s = rsc[ai * 4 + m];
                f32x4 v[2][2];
#pragma unroll
                for (int bj = 0; bj < 2; ++bj)
#pragma unroll
                    for (int n = 0; n < 2; ++n) v[bj][n] = acc[ai][bj][m][n] * s;
                if (normed) { float ss = (dot4(v[0][0]) + dot4(v[0][1])) + (dot4(v[1][0]) + dot4(v[1][1]));
                    ss += __shfl_xor(ss, 16); ss += __shfl_xor(ss, 32);
                    const float rn = __builtin_amdgcn_rsqf(ss * (1.0f / 64.0f) + RMS_EPS);
#pragma unroll
                    for (int bj = 0; bj < 2; ++bj)
#pragma unroll
                        for (int n = 0; n < 2; ++n) v[bj][n] = v[bj][n] * rn * gq[bj][n]; }
                else if (pn >= 10) {
#pragma unroll
                    for (int bj = 0; bj < 2; ++bj)
#pragma unroll
                        for (int n = 0; n < 2; ++n)
#pragma unroll
                            for (int x = 0; x < 4; ++x) v[bj][n][x] = siluf_(v[bj][n][x]); }
                bf16_t* rp = dst + (size_t)row * ldc + cbase + wc * 64 + fq * 8;
#pragma unroll
                for (int bj = 0; bj < 2; ++bj) st_nt((u32x4*)(rp + bj * 32), (u32x4)(pack8(v[bj][0], v[bj][1])));
            }
    }
#if defined(PROBE_ST)
    __device__ __forceinline__ void probe(const Acc& acc, const Unit& u, int wr, int wc, int fr, int fq) const {
        bf16_t* base = (bf16_t*)(ws + WS_E1);
#pragma unroll
        for (int ai = 0; ai < 2; ++ai)
#pragma unroll
            for (int m = 0; m < 4; ++m) {
                const int row = (PROBE_ST == 1) ? (int)blockIdx.x * 16 + fr : u.pm * 256 + ai * 128 + wr * 64 + m * 16 + fr;
                bf16_t* rp = base + (size_t)row * 1024 + (u.pn & 3) * 256 + wc * 64 + fq * 8;
#pragma unroll
                for (int bj = 0; bj < 2; ++bj) {
#if PROBE_ST == 3
                    __builtin_nontemporal_store(pack8(acc[ai][bj][m][0], acc[ai][bj][m][1]), (u32x4*)(rp + bj * 32));
#else
                    st_nt((u32x4*)(rp + bj * 32), (u32x4)(pack8(acc[ai][bj][m][0], acc[ai][bj][m][1])));
#endif
                }
            }
    }
#endif
};
template <int LAYER> struct Res {
    static constexpr int ID = 40 + LAYER;
    static constexpr bool PERM = true;
    const float* x; unsigned char* ws;
    __device__ __forceinline__ void operator()(const Acc& acc, const Unit& u, int wr, int wc, int fr, int fq) const {
        const bf16_t* xinb = (const bf16_t*)(ws + WS_XB); bf16_t* xb = (bf16_t*)(ws + (LAYER == 0 ? WS_X1B : WS_X3B));
        const unsigned base = (unsigned)(u.pm * 256 + wr * 64 + fr) * 1024u + (unsigned)(u.pn * 256 + wc * 32 + fq * 8);
        f32x4 ra[2][4], rc[2][4]; u32x4 rb[2][4];
#define RES_ISSUE(k) { _Pragma("unroll") for (int mm = 0; mm < 2; ++mm) _Pragma("unroll") for (int bj = 0; bj < 2; ++bj) { \
            const unsigned off = base + (unsigned)((((k) >> 1) * 128 + (((k) & 1) * 2 + mm) * 16) * 1024 + bj * 128); \
            if (LAYER == 0) { ra[(k) & 1][mm * 2 + bj] = *(const f32x4*)(x + off); rc[(k) & 1][mm * 2 + bj] = *(const f32x4*)(x + off + 4); } \
            else rb[(k) & 1][mm * 2 + bj] = *(const u32x4*)(xinb + off); } }
        RES_ISSUE(0)
#pragma unroll
        for (int k = 0; k < 4; ++k) {
            if (k < 3) RES_ISSUE(k + 1)
            const int ai = k >> 1;
#pragma unroll
            for (int mm = 0; mm < 2; ++mm) { const int m = (k & 1) * 2 + mm;
#pragma unroll
                for (int bj = 0; bj < 2; ++bj) { const unsigned off = base + (unsigned)((ai * 128 + m * 16) * 1024 + bj * 128);
                    f32x4 r0, r1;
                    if (LAYER == 0) { r0 = ra[k & 1][mm * 2 + bj]; r1 = rc[k & 1][mm * 2 + bj]; } else unpack8(rb[k & 1][mm * 2 + bj], r0, r1);
                    *(u32x4*)(xb + off) = pack8(r0 + acc[ai][bj][m][0], r1 + acc[ai][bj][m][1]); } }
        }
#undef RES_ISSUE
    }
};
template <int LAYER> struct Ple {
    static constexpr int ID = 50 + LAYER;
    static constexpr bool PERM = true; static constexpr bool NEXT = (LAYER == 0);
    unsigned char* ws; unsigned char* dout;
    __device__ __forceinline__ void operator()(const Acc& acc, const Unit& u, int wr, int wc, int fr, int fq) const {
        const bf16_t* xinb = (const bf16_t*)(ws + (LAYER == 0 ? WS_X1B : WS_X3B)); const bf16_t* E = (const bf16_t*)(ws + (LAYER == 0 ? WS_E0 : WS_E1));
        float* xout = (float*)dout; bf16_t* xb = (bf16_t*)(ws + WS_XB); float* rowss = (float*)(ws + WS_ROWSS1);
        const unsigned base = (unsigned)(u.pm * 256 + wr * 64 + fr) * 1024u + (unsigned)(u.pn * 256 + wc * 32 + fq * 8);
        u32x4 eb[2][4], rb[2][4];
#define PLE_ISSUE(k) { _Pragma("unroll") for (int mm = 0; mm < 2; ++mm) _Pragma("unroll") for (int bj = 0; bj < 2; ++bj) { \
            const unsigned off = base + (unsigned)((((k) >> 1) * 128 + (((k) & 1) * 2 + mm) * 16) * 1024 + bj * 128); \
            eb[(k) & 1][mm * 2 + bj] = *(const u32x4*)(E + off); rb[(k) & 1][mm * 2 + bj] = *(const u32x4*)(xinb + off); } }
        PLE_ISSUE(0)
#pragma unroll
        for (int k = 0; k < 4; ++k) {
            if (k < 3) PLE_ISSUE(k + 1)
            const int ai = k >> 1;
#pragma unroll
            for (int mm = 0; mm < 2; ++mm) { const int m = (k & 1) * 2 + mm; float ss = 0.f;
#pragma unroll
                for (int bj = 0; bj < 2; ++bj) { const unsigned off = base + (unsigned)((ai * 128 + m * 16) * 1024 + bj * 128);
                    f32x4 e0, e1, r0, r1; unpack8(eb[k & 1][mm * 2 + bj], e0, e1); unpack8(rb[k & 1][mm * 2 + bj], r0, r1);
                    f32x4 g0 = acc[ai][bj][m][0], g1 = acc[ai][bj][m][1];
#pragma unroll
                    for (int x = 0; x < 4; ++x) { g0[x] = sigmoidf_(g0[x]); g1[x] = sigmoidf_(g1[x]); }
                    const f32x4 o0 = r0 + g0 * e0, o1 = r1 + g1 * e1;
                    if (NEXT) { *(u32x4*)(xb + off) = pack8(o0, o1); ss += dot4(o0) + dot4(o1); }
                    else { st_nt((f32x4*)(xout + off), (f32x4)(o0)); st_nt((f32x4*)(xout + off + 4), (f32x4)(o1)); } }
                if (NEXT) { ss += __shfl_xor(ss, 16); ss += __shfl_xor(ss, 32); if (fq == 0) atomicAdd(rowss + (u.pm * 256 + ai * 128 + wr * 64 + m * 16 + fr), ss); } }
        }
#undef PLE_ISSUE
    }
};

__device__ __forceinline__ size_t qt_index(int b, int tok, int h, int d) { return ((((size_t)(b * 128 + (tok >> 5)) * 4 + h) * 16 + (d >> 4)) * 2 + ((d >> 3) & 1)) * 256 + (tok & 31) * 8 + (d & 7); }
__device__ __forceinline__ size_t tt_index(int bh, int nblk, int row, int tok) { return ((((size_t)bh * nblk + (row >> 5)) * 256 + (tok >> 4)) * 2 + ((tok >> 3) & 1)) * 256 + (row & 31) * 8 + (tok & 7); }
__device__ __forceinline__ float log2_gamma(int h) { return __log2f(1.0f - __builtin_amdgcn_exp2f(-5.0f - (float)h)); }
struct RetQ {
    static constexpr int ID = 60;
    static constexpr bool PERM = true;
    unsigned char* ws;
    __device__ __forceinline__ void operator()(const Acc& acc, const Unit& u, int wr, int wc, int fr, int fq) const {
        const float* rowss = (const float*)(ws + WS_ROWSS1); const float* cosT = (const float*)(ws + WS_COS); const float* sinT = (const float*)(ws + WS_SIN); bf16_t* Qp = (bf16_t*)(ws + WS_QP);
        const int h = u.pn; const float l2g = log2_gamma(h);
        const int rbase = u.pm * 256 + wr * 64 + fr; const int d0 = wc * 32 + fq * 8;
        f32x4 cb[2][4], sb[2][4]; float rs[2][2];
#define RQ_ISSUE(k) { _Pragma("unroll") for (int mm = 0; mm < 2; ++mm) { const int row = rbase + ((k) >> 1) * 128 + (((k) & 1) * 2 + mm) * 16; const int pos = row & (SEQ - 1); \
            rs[(k) & 1][mm] = rowss[row]; \
            _Pragma("unroll") for (int n = 0; n < 2; ++n) { cb[(k) & 1][mm * 2 + n] = *(const f32x4*)(cosT + (size_t)pos * 128 + d0 + n * 4); sb[(k) & 1][mm * 2 + n] = *(const f32x4*)(sinT + (size_t)pos * 128 + d0 + n * 4); } } }
        RQ_ISSUE(0)
#pragma unroll
        for (int k = 0; k < 4; ++k) {
            if (k < 3) RQ_ISSUE(k + 1)
            const int ai = k >> 1;
#pragma unroll
            for (int mm = 0; mm < 2; ++mm) { const int m = (k & 1) * 2 + mm; const int row = rbase + ai * 128 + m * 16;
                const float s = __builtin_amdgcn_rsqf(rs[k & 1][mm] * (1.0f / 1024.0f) + RMS_EPS);
                const int pos = row & (SEQ - 1), il = row & 127; const float dec = __builtin_amdgcn_exp2f((float)(il + 1) * l2g) * s;
                f32x4 y1[2], y2[2];
#pragma unroll
                for (int n = 0; n < 2; ++n) { const f32x4 c4 = cb[k & 1][mm * 2 + n], s4 = sb[k & 1][mm * 2 + n];
                    const f32x4 x1 = acc[ai][0][m][n], x2 = acc[ai][1][m][n]; y1[n] = (x1 * c4 - x2 * s4) * dec; y2[n] = (x1 * s4 + x2 * c4) * dec; }
                bf16_t* rp = Qp + qt_index(row >> 12, pos, h, d0);
                st_nt((u32x4*)rp, (u32x4)(pack8(y1[0], y1[1]))); st_nt((u32x4*)(rp + 8 * 512), (u32x4)(pack8(y2[0], y2[1]))); }
        }
#undef RQ_ISSUE
    }
};
struct RetKV {
    static constexpr int ID = 70;
    static constexpr bool PERM = false;
    unsigned char* ws; unsigned char* dout;
    __device__ __forceinline__ void operator()(const Acc& acc, const Unit& u, int wr, int wc, int fr, int fq) const {
        const float* rowss = (const float*)(ws + WS_ROWSS1); const float* cosT = (const float*)(ws + WS_COST); const float* sinT = (const float*)(ws + WS_SINT);
        bf16_t* Kp = (bf16_t*)dout; bf16_t* Ktp = (bf16_t*)(ws + WS_KTP); bf16_t* Vt = (bf16_t*)(ws + WS_VT);
        const int pn = u.pn; const bool isk = pn < 8; const int h = isk ? pn - 4 : (pn - 8) >> 1; const int ebase = isk ? 0 : ((pn - 8) & 1) * 256;
        const float l2g = log2_gamma(h);
#pragma unroll
        for (int ai = 0; ai < 2; ++ai)
#pragma unroll
            for (int m = 0; m < 4; ++m) { const int row0 = u.pm * 256 + ai * 128 + wr * 64 + m * 16 + fq * 4; const int b = row0 >> 12, t0 = row0 & (SEQ - 1);
                f32x4 s4 = *(const f32x4*)(rowss + row0);
#pragma unroll
                for (int x = 0; x < 4; ++x) s4[x] = __builtin_amdgcn_rsqf(s4[x] * (1.0f / 1024.0f) + RMS_EPS);
                if (isk) {
                    f32x4 kd;
#pragma unroll
                    for (int x = 0; x < 4; ++x) kd[x] = __builtin_amdgcn_exp2f((float)(127 - ((t0 + x) & 127)) * l2g) * 0.0625f * s4[x];
#pragma unroll
                    for (int n = 0; n < 2; ++n) { const int d = wc * 32 + n * 16 + fr;
                        const f32x4 c4 = *(const f32x4*)(cosT + (size_t)d * SEQ + t0), s4r = *(const f32x4*)(sinT + (size_t)d * SEQ + t0);
                        const f32x4 x1 = acc[ai][0][m][n], x2 = acc[ai][1][m][n];
                        const f32x4 y1 = (x1 * c4 - x2 * s4r) * kd, y2 = (x1 * s4r + x2 * c4) * kd;
                        u32x2 w1, w2; w1.x = cvt_pk_bf16(y1[0], y1[1]); w1.y = cvt_pk_bf16(y1[2], y1[3]); w2.x = cvt_pk_bf16(y2[0], y2[1]); w2.y = cvt_pk_bf16(y2[2], y2[3]);
                        bf16_t* tp = Ktp + tt_index(b * 4 + h, 8, d, t0); st_nt((u32x2*)tp, (u32x2)(w1)); st_nt((u32x2*)(tp + (size_t)4 * 256 * 512), (u32x2)(w2));
                        bf16_t* rp = Kp + qt_index(b, t0, h, d);
                        rp[0] = (bf16_t)(w1.x & 0xffffu); rp[8] = (bf16_t)(w1.x >> 16); rp[16] = (bf16_t)(w1.y & 0xffffu); rp[24] = (bf16_t)(w1.y >> 16);
                        rp[8 * 512] = (bf16_t)(w2.x & 0xffffu); rp[8 * 512 + 8] = (bf16_t)(w2.x >> 16); rp[8 * 512 + 16] = (bf16_t)(w2.y & 0xffffu); rp[8 * 512 + 24] = (bf16_t)(w2.y >> 16); }
                } else {
#pragma unroll
                    for (int bj = 0; bj < 2; ++bj)
#pragma unroll
                        for (int n = 0; n < 2; ++n) { const int e = ebase + bj * 128 + wc * 32 + n * 16 + fr; const f32x4 v = acc[ai][bj][m][n] * s4;
                            u32x2 w; w.x = cvt_pk_bf16(v[0], v[1]); w.y = cvt_pk_bf16(v[2], v[3]);
                            st_nt((u32x2*)(Vt + tt_index(b * 4 + h, 16, e, t0)), (u32x2)(w)); }
                }
                if (m & 1) asm volatile("" ::: "memory"); }
    }
};
struct RetZ {
    static constexpr int ID = 80;
    static constexpr bool PERM = true;
    unsigned char* ws; unsigned char* dout;
    __device__ __forceinline__ void operator()(const Acc& acc, const Unit& u, int wr, int wc, int fr, int fq) const {
        const float* rowss = (const float*)(ws + WS_ROWSS1); const float* stats = (const float*)(ws + WS_STATS); bf16_t* O = (bf16_t*)dout;
        const int zt = u.pn - 16, h = zt >> 1;
        const int rbase = u.pm * 256 + wr * 64 + fr;
        const unsigned obase = (unsigned)rbase * 2048u + (unsigned)(zt * 256 + wc * 32 + fq * 8);
        const float* sp0 = stats + ((size_t)((rbase >> 12) * 4 + h) * 2) * SEQ + (rbase & (SEQ - 1));
        u32x4 ob[2][4]; float rs[2][2], s0[2][2], s1[2][2];
#define RZ_ISSUE(k) { _Pragma("unroll") for (int mm = 0; mm < 2; ++mm) { const int ro = ((k) >> 1) * 128 + (((k) & 1) * 2 + mm) * 16; \
            rs[(k) & 1][mm] = rowss[rbase + ro]; s0[(k) & 1][mm] = sp0[ro]; s1[(k) & 1][mm] = sp0[SEQ + ro]; \
            _Pragma("unroll") for (int bj = 0; bj < 2; ++bj) ob[(k) & 1][mm * 2 + bj] = *(const u32x4*)(O + obase + (unsigned)(ro * 2048 + bj * 128)); } }
        RZ_ISSUE(0)
#pragma unroll
        for (int k = 0; k < 4; ++k) {
            if (k < 3) RZ_ISSUE(k + 1)
            const int ai = k >> 1;
#pragma unroll
            for (int mm = 0; mm < 2; ++mm) { const int m = (k & 1) * 2 + mm; const int ro = ai * 128 + m * 16;
                const float s = __builtin_amdgcn_rsqf(rs[k & 1][mm] * (1.0f / 1024.0f) + RMS_EPS);
                const float mu = s0[k & 1][mm] * (1.0f / 512.0f); float var = s1[k & 1][mm] * (1.0f / 512.0f) - mu * mu; var = var > 0.f ? var : 0.f; const float rstd = __builtin_amdgcn_rsqf(var + GN_EPS);
#pragma unroll
                for (int bj = 0; bj < 2; ++bj) { bf16_t* p = O + obase + (unsigned)(ro * 2048 + bj * 128);
                    f32x4 o0, o1; unpack8(ob[k & 1][mm * 2 + bj], o0, o1); f32x4 z0 = acc[ai][bj][m][0] * s, z1 = acc[ai][bj][m][1] * s;
#pragma unroll
                    for (int x = 0; x < 4; ++x) { z0[x] = siluf_(z0[x]); z1[x] = siluf_(z1[x]); }
                    o0 = (o0 - mu) * rstd * z0; o1 = (o1 - mu) * rstd * z1; *(u32x4*)p = pack8(o0, o1); } }
        }
#undef RZ_ISSUE
    }
};
}
#define RLX_AGENT __ATOMIC_RELAXED, __HIP_MEMORY_SCOPE_AGENT
#define LDS_WAIT() asm volatile("s_waitcnt lgkmcnt(0)" ::: "memory")
#define VM_WAIT() asm volatile("s_waitcnt vmcnt(0)" ::: "memory")

#define XB_TMO      128
#define XB_XCNT(j)  (256  + 64 * (j))
#define XB_XSUB(j)  (1280 + 64 * (j))
#define XB_XGEN(j)  (2304 + 64 * (j))
#define XB_TOP      3328
#define XB_TOPGEN   3392
#define XCD_BAR_WORDS 3456
#define XB_SPIN_CAP (1u << 23)
__device__ __forceinline__ unsigned xb_ld(unsigned* p)              { return __hip_atomic_load(p, __ATOMIC_RELAXED, __HIP_MEMORY_SCOPE_AGENT); }
__device__ __forceinline__ unsigned xb_add(unsigned* p, unsigned v) { return __hip_atomic_fetch_add(p, v, __ATOMIC_RELAXED, __HIP_MEMORY_SCOPE_AGENT); }
__device__ __forceinline__ unsigned xb_xcc_id() { return (unsigned)__builtin_amdgcn_s_getreg((3 << 11) | 20) & 0xFu; }
#define XB_SPIN(cond, bar) do { unsigned _sp = 0; while (cond) { __builtin_amdgcn_s_sleep(1); \
    if ((++_sp & 255u) == 0u) { if (xb_ld(&(bar)[XB_TMO])) break; if (_sp > XB_SPIN_CAP) { atomicAdd(&(bar)[XB_TMO], 1u); break; } } } } while (0)
struct XcdBarrier { unsigned* bar; unsigned x; volatile LAS unsigned* st; int wave; };
__device__ __forceinline__ XcdBarrier xcd_barrier_post(unsigned* bar, volatile LAS unsigned* st, int wave) {
    XcdBarrier b; b.bar = bar; b.x = xb_xcc_id(); b.st = st; b.wave = wave;
    if (wave == 0 && lane_id() == 0) (void)xb_add(&bar[XB_XCNT(b.x)], 1u);
    return b;
}
__device__ __forceinline__ void xcd_barrier_complete(unsigned* bar, unsigned x, unsigned& nloc, unsigned& nx) {
    const unsigned G = gridDim.x * gridDim.y * gridDim.z;
    unsigned sum, cnt, mine, sp = 0u;
    for (;;) {
        sum = 0u; cnt = 0u; mine = 0u;
#pragma unroll
        for (unsigned j = 0; j < 16; ++j) { const unsigned c = xb_ld(&bar[XB_XCNT(j)]); sum += c; cnt += (c > 0u) ? 1u : 0u; mine = (j == x) ? c : mine; }
        if (sum == G) break;
        __builtin_amdgcn_s_sleep(1);
        if ((++sp & 255u) == 0u) { if (xb_ld(&bar[XB_TMO])) break; if (sp > XB_SPIN_CAP) { atomicAdd(&bar[XB_TMO], 1u); break; } }
    }
    nloc = mine > 0u ? mine : 1u; nx = cnt > 0u ? cnt : 1u;
}
__device__ __forceinline__ void xcd_barrier(const XcdBarrier& b) {
    asm volatile("s_waitcnt vmcnt(0)" ::: "memory");
    __syncthreads();
    if (b.wave == 0 && lane_id() == 0) {
        unsigned* bar = b.bar;
        __builtin_amdgcn_s_waitcnt(0);
        unsigned nloc = b.st[0], nx = b.st[1];
        if (nloc == 0u) { xcd_barrier_complete(bar, b.x, nloc, nx); b.st[0] = nloc; b.st[1] = nx; }
        const unsigned old = xb_add(&bar[XB_XSUB(b.x)], 1u);
        const unsigned gen = old / nloc;
        if (old + 1u == (gen + 1u) * nloc) {
            __builtin_amdgcn_fence(__ATOMIC_RELEASE, "agent");
            asm volatile("s_waitcnt vmcnt(0)" ::: "memory");
            const unsigned og = xb_add(&bar[XB_TOP], 1u);
            const unsigned tg = og / nx;
            if (og + 1u == (tg + 1u) * nx) xb_add(&bar[XB_TOPGEN], 1u);
            else XB_SPIN(xb_ld(&bar[XB_TOPGEN]) == tg, bar);
            __builtin_amdgcn_fence(__ATOMIC_ACQUIRE, "agent");
            xb_add(&bar[XB_XGEN(b.x)], 1u);
            asm volatile("s_waitcnt vmcnt(0)" ::: "memory");
        } else {
            XB_SPIN(xb_ld(&bar[XB_XGEN(b.x)]) == gen, bar);
            __builtin_amdgcn_fence(__ATOMIC_ACQUIRE, "agent");
            asm volatile("s_waitcnt vmcnt(0)" ::: "memory");
        }
    }
    __syncthreads();
}

struct Frame {
    LAS unsigned char* lds;
    volatile LAS unsigned* MISC;
    unsigned* ctl;
    int wave, vcu, G;
    unsigned char* out; unsigned char* ws;
};
struct Args { const float* in[19]; unsigned char* out; unsigned char* ws; int ph_lo, ph_hi; };
__device__ __forceinline__ float wave_sum(float v) {
#pragma unroll
    for (int o = 1; o < 64; o <<= 1) v += __shfl_xor(v, o);
    return v;
}
__device__ __forceinline__ void tr_item(const float* W, int ldw, int K, int k0, int srcc, bf16_t* WT, int drow, const float* gain, LAS float* scr, int lane) {
    float wv[32];
#pragma unroll
    for (int i = 0; i < 32; ++i) { const int kk = 2 * i + (lane >> 5); wv[i] = W[(size_t)(k0 + kk) * ldw + srcc + (lane & 31)]; }
#pragma unroll
    for (int i = 0; i < 32; ++i) { const int kk = 2 * i + (lane >> 5); float w = wv[i]; if (gain) w *= gain[k0 + kk]; scr[kk * 33 + (lane & 31)] = w; }
    LDS_WAIT(); asm volatile("" ::: "memory");
    const int c = lane & 7;
#pragma unroll
    for (int j = 0; j < 4; ++j) { const int n = (lane >> 3) + 8 * j; const LAS float* s = scr + (8 * c) * 33 + n;
        u32x4 o; o.x = cvt_pk_bf16(s[0 * 33], s[1 * 33]); o.y = cvt_pk_bf16(s[2 * 33], s[3 * 33]); o.z = cvt_pk_bf16(s[4 * 33], s[5 * 33]); o.w = cvt_pk_bf16(s[6 * 33], s[7 * 33]);
        *(u32x4*)(WT + (size_t)(drow + n) * K + k0 + 8 * c) = o; }
    LDS_WAIT(); asm volatile("" ::: "memory");
}
__device__ __forceinline__ void cvt_rows(Frame& F, const float* src, bf16_t* dst, size_t n8) {
    const size_t nthr = (size_t)F.G * 512;
    for (size_t i = (size_t)F.vcu * 512 + F.wave * 64 + lane_id(); i < n8; i += 8 * nthr) { f32x4 a[8], b[8];
#pragma unroll
        for (int j = 0; j < 8; ++j) if (i + j * nthr < n8) { a[j] = *(const f32x4*)(src + (i + j * nthr) * 8); b[j] = *(const f32x4*)(src + (i + j * nthr) * 8 + 4); }
#pragma unroll
        for (int j = 0; j < 8; ++j) if (i + j * nthr < n8) *(u32x4*)(dst + (i + j * nthr) * 8) = epi::pack8(a[j], b[j]); }
}
__device__ __forceinline__ void p0_prologue(Frame& F, const Args& A, bool first = true) {
    LAS float* scr = (LAS float*)(F.lds + F.wave * 16384);
    const int gw = F.vcu * NWAVES + F.wave, NGW = F.G * NWAVES, lane = lane_id();
    unsigned char* ws = F.ws;
    constexpr int I0 = 16 * 112, I1 = 512, I2 = 512, I3 = 512, I4 = 128, I5 = 128, I6 = 16 * 192, I7 = 32 * 32, I8 = 32 * 8, I9 = 32 * 8, I10 = 8, I11 = 8, I12 = 16 * 2;
    constexpr int NITEMS = I0 + I1 + I2 + I3 + I4 + I5 + I6 + I7 + I8 + I9 + I10 + I11 + I12;
    for (int it = gw; it < NITEMS; it += NGW) {
        int r = it;
        if (r < I0) { const int kb = r / 112, gi = r % 112, pn = gi >> 3, gg = gi & 7, bj = gg >> 2, wc = gg & 3; int srcc;
            if (pn < 4) srcc = pn * 256 + wc * 64 + bj * 32; else if (pn < 10) srcc = 1024 + (pn - 4) * 256 + wc * 64 + bj * 32; else srcc = 2608 + (pn - 10) * 256 + wc * 64 + bj * 32;
            tr_item(A.in[3], 3632, 1024, 64 * kb, srcc, (bf16_t*)(ws + WS_WNIN), 32 * gi, A.in[2], scr, lane); continue; } r -= I0;
        if (r < I1) { tr_item(A.in[14], 1024, 1024, 64 * (r / 32), 32 * (r % 32), (bf16_t*)(ws + WS_WNOUT), 32 * (r % 32), nullptr, scr, lane); continue; } r -= I1;
        if (r < I2) { tr_item(A.in[18], 1024, 1024, 64 * (r / 32), 32 * (r % 32), (bf16_t*)(ws + WS_WG0), 32 * (r % 32), nullptr, scr, lane); continue; } r -= I2;
        if (r < I3) { tr_item(A.in[18] + (size_t)1024 * 1024, 1024, 1024, 64 * (r / 32), 32 * (r % 32), (bf16_t*)(ws + WS_WG1), 32 * (r % 32), nullptr, scr, lane); continue; } r -= I3;
        if (r < I4) { tr_item(A.in[17], 1024, 256, 64 * (r / 32), 32 * (r % 32), (bf16_t*)(ws + WS_WP0), 32 * (r % 32), nullptr, scr, lane); continue; } r -= I4;
        if (r < I5) { tr_item(A.in[17] + (size_t)256 * 1024, 1024, 256, 64 * (r / 32), 32 * (r % 32), (bf16_t*)(ws + WS_WP1), 32 * (r % 32), nullptr, scr, lane); continue; } r -= I5;
        if (r < I6) { tr_item(A.in[15], 6144, 1024, 64 * (r / 192), 32 * (r % 192), (bf16_t*)(ws + WS_WRIN), 32 * (r % 192), A.in[2] + 1024, scr, lane); continue; } r -= I6;
        if (r < I7) { tr_item(A.in[16], 1024, 2048, 64 * (r / 32), 32 * (r % 32), (bf16_t*)(ws + WS_WROUT), 32 * (r % 32), nullptr, scr, lane); continue; } r -= I7;
        if (r < I8) { tr_item(A.in[10], 256, 2048, 64 * (r / 8), 32 * (r % 8), (bf16_t*)(ws + WS_WC1K), 32 * (r % 8), nullptr, scr, lane); continue; } r -= I8;
        if (r < I9) { tr_item(A.in[12], 256, 2048, 64 * (r / 8), 32 * (r % 8), (bf16_t*)(ws + WS_WC1V), 32 * (r % 8), nullptr, scr, lane); continue; } r -= I9;
        if (r < I10) { tr_item(A.in[11], 64, 256, 64 * (r / 2), 32 * (r % 2), (bf16_t*)(ws + WS_WC2K), 32 * (r % 2), nullptr, scr, lane); continue; } r -= I10;
        if (r < I11) { tr_item(A.in[13], 64, 256, 64 * (r / 2), 32 * (r % 2), (bf16_t*)(ws + WS_WC2V), 32 * (r % 2), nullptr, scr, lane); continue; } r -= I11;
        tr_item(A.in[3], 3632, 1024, 64 * (r / 2), 2560 + 32 * (r % 2), (bf16_t*)(ws + WS_WGT), 32 * (r % 2), A.in[2], scr, lane);
    }
    { const float* x = A.in[0]; bf16_t* xb = (bf16_t*)(ws + WS_XB); float* rs = (float*)(ws + WS_ROWSC0);
      for (int m = gw; m < T_TOK; m += 4 * NGW) { f32x4 v[4][4]; float s[4];
#pragma unroll
          for (int q = 0; q < 4; ++q) { const int mq = (m + q * NGW < T_TOK) ? m + q * NGW : m; const f32x4* xr = (const f32x4*)(x + (size_t)mq * DM) + lane;
#pragma unroll
              for (int j = 0; j < 4; ++j) v[q][j] = xr[64 * j]; }
#pragma unroll
          for (int q = 0; q < 4; ++q) { float a = 0.f;
#pragma unroll
              for (int j = 0; j < 4; ++j) a += epi::dot4(v[q][j]);
              s[q] = wave_sum(a); }
#pragma unroll
          for (int q = 0; q < 4; ++q) if (m + q * NGW < T_TOK) { const int mq = m + q * NGW; u32x2* o8 = (u32x2*)(xb + (size_t)mq * DM) + lane;
#pragma unroll
              for (int j = 0; j < 4; ++j) { u32x2 w; w.x = cvt_pk_bf16(v[q][j][0], v[q][j][1]); w.y = cvt_pk_bf16(v[q][j][2], v[q][j][3]); o8[64 * j] = w; }
              if (lane == 0) rs[mq] = __builtin_amdgcn_rsqf(s[q] * (1.0f / DM) + RMS_EPS); } } }
    cvt_rows(F, A.in[1], (bf16_t*)(ws + WS_PB0), (size_t)T_TOK * 256 / 8);
    cvt_rows(F, A.in[1] + (size_t)T_TOK * 256, (bf16_t*)(ws + WS_PB1), (size_t)T_TOK * 256 / 8);
    { float* ct = (float*)(ws + WS_COS); float* st = (float*)(ws + WS_SIN); float* ctt = (float*)(ws + WS_COST); float* stt = (float*)(ws + WS_SINT);
      for (int i = F.vcu * 512 + F.wave * 64 + lane_id(); i < 2 * SEQ * 128; i += F.G * 512) { const bool tr = i >= SEQ * 128; const int ii = tr ? i - SEQ * 128 : i; const int pos = tr ? (ii & (SEQ - 1)) : (ii >> 7), j = tr ? (ii >> 12) : (ii & 127);
          const float inv = (float)exp2(-((double)j / 127.0) * 13.287712379549449);
          const float ang = (float)pos * inv;
          double t = (double)ang * 0.15915494309189535; t -= floor(t);
          const float cv = __builtin_amdgcn_cosf((float)t), sv = __builtin_amdgcn_sinf((float)t);
          if (tr) { ctt[ii] = cv; stt[ii] = sv; } else { ct[ii] = cv; st[ii] = sv; } } }
    if (first) for (int task = gw; task < 512; task += NGW) { const int kv = task >> 8, cb = (task >> 6) & 3, kc = task & 63, col = cb * 64 + lane; const float* pos = kv ? A.in[9] : A.in[8]; const float* w1 = kv ? A.in[12] : A.in[10]; float a = 0.f;
#pragma unroll 8
        for (int k = kc * 32; k < kc * 32 + 32; ++k) a += pos[k] * w1[(size_t)k * 256 + col];
        atomicAdd((float*)(ws + WS_CBIAS) + kv * 256 + col, a); }
    if (gw == NGW - 1) { float* gd = (float*)(ws + WS_GAINS); gd[lane] = A.in[4][lane]; gd[64 + lane] = A.in[5][lane]; gd[128 + lane] = A.in[6][lane]; gd[192 + lane] = A.in[7][lane]; }
}
__device__ __forceinline__ void cmp2_task(Frame& F, int task) {
    const float* kcg = (const float*)(F.ws + WS_GAINS) + 64;
    const int lane = lane_id(), r32 = lane & 31, hi = lane >> 5;
    unsigned char* ws = F.ws;
    {
        const int kv = task >> 8, rb = task & 255;
        const bf16_t* H = (const bf16_t*)(ws + WS_HID) + ((size_t)kv * 8192 + rb * 32) * 256;
        const bf16_t* W2 = (const bf16_t*)(ws + (kv ? WS_WC2V : WS_WC2K));
        f32x16 o0 = {}, o1 = {};
#pragma unroll 4
        for (int ks = 0; ks < 16; ++ks) {
            const bf16x8 hb = *(const bf16x8*)(H + (size_t)r32 * 256 + ks * 16 + hi * 8);
            const bf16x8 w0 = *(const bf16x8*)(W2 + (size_t)r32 * 256 + ks * 16 + hi * 8), w1 = *(const bf16x8*)(W2 + (size_t)(32 + r32) * 256 + ks * 16 + hi * 8);
            o0 = __builtin_amdgcn_mfma_f32_32x32x16_bf16(w0, hb, o0, 0, 0, 0); o1 = __builtin_amdgcn_mfma_f32_32x32x16_bf16(w1, hb, o1, 0, 0, 0);
        }
        if (kv == 0) { float ss = 0.f;
#pragma unroll
            for (int r = 0; r < 16; ++r) ss += o0[r] * o0[r] + o1[r] * o1[r];
            ss += __shfl_xor(ss, 32);
            const float rn = __builtin_amdgcn_rsqf(ss * (1.0f / 64.0f) + RMS_EPS); const float* gp = kcg;
#pragma unroll
            for (int r = 0; r < 16; ++r) { const int c = (r & 3) + 8 * (r >> 2) + 4 * hi; o0[r] *= rn * gp[c]; o1[r] *= rn * gp[32 + c]; } }
        const int rowg = rb * 32 + r32;
        if ((rowg & 255) == 255) { o0 = f32x16{}; o1 = f32x16{}; }
        bf16_t* dst = (bf16_t*)(ws + (kv ? WS_VCC : WS_KCC)) + (size_t)rowg * 64;
#pragma unroll
        for (int a = 0; a < 4; ++a) { u32x2 w; w.x = cvt_pk_bf16(o0[4 * a], o0[4 * a + 1]); w.y = cvt_pk_bf16(o0[4 * a + 2], o0[4 * a + 3]); *(u32x2*)(dst + 8 * a + 4 * hi) = w;
            w.x = cvt_pk_bf16(o1[4 * a], o1[4 * a + 1]); w.y = cvt_pk_bf16(o1[4 * a + 2], o1[4 * a + 3]); *(u32x2*)(dst + 32 + 8 * a + 4 * hi) = w; }
    }
}
__device__ __forceinline__ void gates_task(Frame& F, int task) {
    const int lane = lane_id(), r32 = lane & 31, hi = lane >> 5;
    unsigned char* ws = F.ws;
    const bf16_t* X = (const bf16_t*)(ws + WS_XB) + ((size_t)task * 32 + r32) * 1024 + hi * 32;
    const bf16_t* W = (const bf16_t*)(ws + WS_WGT) + (size_t)r32 * 1024 + hi * 32;
    f32x16 o0 = {}, o1 = {};
#pragma unroll 2
    for (int j = 0; j < 16; ++j) { bf16x8 xf[4], w0[4], w1[4];
#pragma unroll
        for (int s_ = 0; s_ < 4; ++s_) { xf[s_] = *(const bf16x8*)(X + j * 64 + s_ * 8); w0[s_] = *(const bf16x8*)(W + j * 64 + s_ * 8); w1[s_] = *(const bf16x8*)(W + (size_t)32 * 1024 + j * 64 + s_ * 8); }
#pragma unroll
        for (int s_ = 0; s_ < 4; ++s_) { o0 = __builtin_amdgcn_mfma_f32_32x32x16_bf16(w0[s_], xf[s_], o0, 0, 0, 0); o1 = __builtin_amdgcn_mfma_f32_32x32x16_bf16(w1[s_], xf[s_], o1, 0, 0, 0); } }
    const int row = task * 32 + r32; const float s = ((const float*)(ws + WS_ROWSC0))[row];
    float* gp = (float*)(ws + WS_G) + (size_t)row * 48;
#pragma unroll
    for (int a = 0; a < 4; ++a) { f32x4 v;
#pragma unroll
        for (int x = 0; x < 4; ++x) v[x] = sigmoidf_(o0[4 * a + x] * s);
        *(f32x4*)(gp + 8 * a + 4 * hi) = v;
        if (a < 2) {
#pragma unroll
            for (int x = 0; x < 4; ++x) v[x] = sigmoidf_(o1[4 * a + x] * s);
            *(f32x4*)(gp + 32 + 8 * a + 4 * hi) = v; } }
}

namespace nsa {
constexpr int L_KV = 0, L_K = 0, L_V = 24576, L_WSF = 49152, L_ACC = 51200, L_GS = 116736, L_LS = 133120, L_MSK = 149504, L_END = 150016;
constexpr int NSLOT = 3, SLOTB = 8192;
#define NSA_NEG (-INFINITY)
#ifndef ODD_NT
#define ODD_NT 1
#endif
#ifndef WIN_PREFETCH
#define WIN_PREFETCH 0
#endif
__device__ __forceinline__ int crow(int r, int hi) { return (r & 3) + 8 * (r >> 2) + 4 * hi; }
__device__ __forceinline__ void qkt(f32x16& p0, f32x16& p1, const LAS unsigned char* Kslot, const bf16x8* qr, int r32, int hi) {
    const LAS unsigned char* kb = Kslot + hi * 1024 + r32 * 16;
    const f32x16 z = {};
#pragma unroll
    for (int d0 = 0; d0 < 4; ++d0) {
        const bf16x8 b0 = *(const LAS bf16x8*)(kb + d0 * 2048), b1 = *(const LAS bf16x8*)(kb + d0 * 2048 + 512);
        if (d0 == 0) { p0 = __builtin_amdgcn_mfma_f32_32x32x16_bf16(b0, qr[0], z, 0, 0, 0); p1 = __builtin_amdgcn_mfma_f32_32x32x16_bf16(b1, qr[0], z, 0, 0, 0); }
        else { p0 = __builtin_amdgcn_mfma_f32_32x32x16_bf16(b0, qr[d0], p0, 0, 0, 0); p1 = __builtin_amdgcn_mfma_f32_32x32x16_bf16(b1, qr[d0], p1, 0, 0, 0); }
    }
}
__device__ __forceinline__ void pv(f32x16* o, int vb, bf16x8 pa0, bf16x8 pa1, bf16x8 pa2, bf16x8 pa3) {
#pragma unroll
    for (int d0 = 0; d0 < 2; ++d0) { s16x4 lo[4], hi[4];
#pragma unroll
        for (int ks = 0; ks < 4; ++ks) {
            asm volatile("ds_read_b64_tr_b16 %0,%1 offset:%c2" : "=&v"(lo[ks]) : "v"(vb), "i"(d0 * 4096 + ks * 1024) : "memory");
            asm volatile("ds_read_b64_tr_b16 %0,%1 offset:%c2" : "=&v"(hi[ks]) : "v"(vb), "i"(d0 * 4096 + ks * 1024 + 512) : "memory"); }
        asm volatile("s_waitcnt lgkmcnt(0)" ::: "memory"); __builtin_amdgcn_sched_barrier(0);
#define NSA_PK(k) (bf16x8){lo[k][0], lo[k][1], lo[k][2], lo[k][3], hi[k][0], hi[k][1], hi[k][2], hi[k][3]}
        o[d0] = __builtin_amdgcn_mfma_f32_32x32x16_bf16(pa0, NSA_PK(0), o[d0], 0, 0, 0);
        o[d0] = __builtin_amdgcn_mfma_f32_32x32x16_bf16(pa1, NSA_PK(1), o[d0], 0, 0, 0);
        o[d0] = __builtin_amdgcn_mfma_f32_32x32x16_bf16(pa2, NSA_PK(2), o[d0], 0, 0, 0);
        o[d0] = __builtin_amdgcn_mfma_f32_32x32x16_bf16(pa3, NSA_PK(3), o[d0], 0, 0, 0);
#undef NSA_PK
    }
}
__device__ __forceinline__ float rowmax(const f32x16& p0, const f32x16& p1) {
    float a = fmaxf(fmaxf(p0[0], p0[1]), p1[0]), b = fmaxf(fmaxf(p0[2], p0[3]), p1[1]); a = fmaxf(fmaxf(a, p1[2]), p1[3]);
#pragma unroll
    for (int r = 4; r < 16; r += 4) { a = fmaxf(fmaxf(a, p0[r]), p0[r + 1]); b = fmaxf(fmaxf(b, p0[r + 2]), p0[r + 3]); a = fmaxf(fmaxf(a, p1[r]), p1[r + 1]); b = fmaxf(fmaxf(b, p1[r + 2]), p1[r + 3]); }
    const float m = fmaxf(a, b);
    auto rr = __builtin_amdgcn_permlane32_swap(__float_as_uint(m), __float_as_uint(m), false, false);
    return fmaxf(__uint_as_float(rr[0]), __uint_as_float(rr[1]));
}
__device__ __forceinline__ float halfsum(float v) {
    auto rr = __builtin_amdgcn_permlane32_swap(__float_as_uint(v), __float_as_uint(v), false, false);
    return __uint_as_float(rr[0]) + __uint_as_float(rr[1]);
}
__device__ __forceinline__ void row_scale(f32x16 (&o)[2], float f, LAS float* wsf, int r32, int hi) {
    if (hi == 0) wsf[r32] = f;
#pragma unroll
    for (int a = 0; a < 4; ++a) { const f32x4 f4 = *(const LAS f32x4*)(wsf + 8 * a + 4 * hi);
#pragma unroll
        for (int x = 0; x < 4; ++x) { o[0][4 * a + x] *= f4[x]; o[1][4 * a + x] *= f4[x]; } }
}
__device__ __forceinline__ void row_fma(f32x16 (&acc)[2], const f32x16 (&o)[2], float f, LAS float* wsf, int r32, int hi) {
    if (hi == 0) wsf[r32] = f;
#pragma unroll
    for (int a = 0; a < 4; ++a) { const f32x4 f4 = *(const LAS f32x4*)(wsf + 8 * a + 4 * hi);
#pragma unroll
        for (int x = 0; x < 4; ++x) { acc[0][4 * a + x] += o[0][4 * a + x] * f4[x]; acc[1][4 * a + x] += o[1][4 * a + x] * f4[x]; } }
}
__device__ __forceinline__ void softmax_step(f32x16& p0, f32x16& p1, float& m, float& l, f32x16 (&o)[2], LAS float* wsf, int r32, int hi) {
    const float rm = rowmax(p0, p1);
    if (__any(rm > m)) {
        const float mn = fmaxf(m, rm), mu = (mn == NSA_NEG) ? 0.f : mn;
        const float alpha = __builtin_amdgcn_exp2f(m - mu);
        l *= alpha; m = mn;
        row_scale(o, alpha, wsf, r32, hi);
    }
    const float mu = (m == NSA_NEG) ? 0.f : m; float s = 0.f;
#pragma unroll
    for (int r = 0; r < 16; ++r) { p0[r] = __builtin_amdgcn_exp2f(p0[r] - mu); p1[r] = __builtin_amdgcn_exp2f(p1[r] - mu); s += p0[r] + p1[r]; }
    l += s;
}

__device__ __forceinline__ void glds16(const void* sbase, unsigned voff, unsigned lds_dst) { unsigned keep;
    asm volatile("s_mov_b32 %0, m0\n\ts_mov_b32 m0, %3\n\ts_nop 0\n\tglobal_load_lds_dwordx4 %1, %2\n\ts_mov_b32 m0, %0" : "=&s"(keep) : "v"(voff), "s"(sbase), "s"(lds_dst) : "memory"); }
__device__ __forceinline__ float max3f(float a, float b, float c) { float r; asm("v_max3_f32 %0, %1, %2, %3" : "=v"(r) : "v"(a), "v"(b), "v"(c)); return r; }
__device__ __forceinline__ float max2f(float a, float b) { float r; asm("v_max_f32_e32 %0, %1, %2" : "=v"(r) : "v"(a), "v"(b)); return r; }
__device__ __forceinline__ float fadd_s(float a, float b) { float r; asm("v_add_f32_e32 %0, %1, %2" : "=v"(r) : "v"(a), "v"(b)); return r; }
__device__ __forceinline__ float fsub_s(float a, float b) { float r; asm("v_sub_f32_e32 %0, %1, %2" : "=v"(r) : "v"(a), "v"(b)); return r; }
typedef LAS const char* lds_cptr;
typedef short v4i16_t __attribute__((ext_vector_type(4)));
__device__ __forceinline__ void kload8(bf16x8* kf, lds_cptr kp) {
    kf[0] = *(const LAS bf16x8*)(kp);        kf[1] = *(const LAS bf16x8*)(kp + 512);
    kf[2] = *(const LAS bf16x8*)(kp + 2048); kf[3] = *(const LAS bf16x8*)(kp + 2560);
    kf[4] = *(const LAS bf16x8*)(kp + 4096); kf[5] = *(const LAS bf16x8*)(kp + 4608);
    kf[6] = *(const LAS bf16x8*)(kp + 6144); kf[7] = *(const LAS bf16x8*)(kp + 6656); }
__device__ __forceinline__ void kload2(bf16x8* kf, lds_cptr kp, int j) { kf[2 * j] = *(const LAS bf16x8*)(kp + j * 2048); kf[2 * j + 1] = *(const LAS bf16x8*)(kp + j * 2048 + 512); }
__device__ __forceinline__ s16x4 vtr(lds_cptr p) { return __builtin_bit_cast(s16x4, __builtin_amdgcn_ds_read_tr16_b64_v4i16((LAS v4i16_t*)p)); }
__device__ __forceinline__ float rowmax_a(const f32x16& p0, const f32x16& p1) {
    float a = max3f(p0[0], p0[1], p1[0]), b = max3f(p0[2], p0[3], p1[1]); a = max3f(a, p1[2], p1[3]);
#pragma unroll
    for (int r = 4; r < 16; r += 4) { a = max3f(a, p0[r], p0[r + 1]); b = max3f(b, p0[r + 2], p0[r + 3]); a = max3f(a, p1[r], p1[r + 1]); b = max3f(b, p1[r + 2], p1[r + 3]); }
    const float m = max2f(a, b);
    auto rr = __builtin_amdgcn_permlane32_swap(__float_as_uint(m), __float_as_uint(m), false, false);
    return max2f(__uint_as_float(rr[0]), __uint_as_float(rr[1]));
}
#define FB_SBAR() __builtin_amdgcn_sched_barrier(0)
#define FB_WAIT_BAR(N) asm volatile("s_waitcnt vmcnt(" #N ") lgkmcnt(0)\n\ts_barrier" ::: "memory")
template <int MODE> __device__ __forceinline__ void mask_tile(f32x16& p0, f32x16& p1, int t, int qb, int nreal, int tl_base, const LAS unsigned long long* mskp) {
    const float NEG = -INFINITY;
    if (t >= nreal) {
#pragma unroll
        for (int r = 0; r < 16; ++r) { p0[r] = NEG; p1[r] = NEG; }
        return; }
    if ((MODE == 0) ? (t == qb) : (t == 0)) { const int l_ = lane_id(); const int lim = tl_base + ((l_ & 31) >> 2) - 4 * (l_ >> 5);
#pragma unroll
        for (int r = 0; r < 16; ++r) { const int cr = (r & 3) + 8 * (r >> 2); if (cr > lim) p0[r] = NEG; if (cr + 32 > lim) p1[r] = NEG; } }
    if (MODE == 1 && t == 8) { const int l_ = lane_id(); const int lim = tl_base + ((l_ & 31) >> 2) - 4 * (l_ >> 5);
#pragma unroll
        for (int r = 0; r < 16; ++r) { const int cr = (r & 3) + 8 * (r >> 2); if (cr <= lim) p0[r] = NEG; if (cr + 32 <= lim) p1[r] = NEG; } }
    if (MODE == 0) { const bool dead = !((*mskp >> t) & 1ull);
        if (__any(dead)) {
#pragma unroll
            for (int r = 0; r < 16; ++r) { p0[r] = dead ? NEG : p0[r]; p1[r] = dead ? NEG : p1[r]; } } }
}
template <int MODE> __device__ __forceinline__ void mask_pos(f32x16& p0, f32x16& p1, int t, int qb, int tl_base) {
    const float NEG = -INFINITY;
    if ((MODE == 0) ? (t == qb) : (t == 0)) { const int l_ = lane_id(); const int lim = tl_base + ((l_ & 31) >> 2) - 4 * (l_ >> 5);
#pragma unroll
        for (int r = 0; r < 16; ++r) { const int cr = (r & 3) + 8 * (r >> 2); if (cr > lim) p0[r] = NEG; if (cr + 32 > lim) p1[r] = NEG; } }
    if (MODE == 1 && t == 8) { const int l_ = lane_id(); const int lim = tl_base + ((l_ & 31) >> 2) - 4 * (l_ >> 5);
#pragma unroll
        for (int r = 0; r < 16; ++r) { const int cr = (r & 3) + 8 * (r >> 2); if (cr <= lim) p0[r] = NEG; if (cr + 32 <= lim) p1[r] = NEG; } }
}
template <int MODE> __device__ __forceinline__ void flash_prefetch(LAS unsigned char* lds, const bf16_t* Kg, const bf16_t* Vg, int qb, int wid) {
    constexpr long PITCH = 256;
    const int nreal = (MODE == 0) ? qb + 1 : (qb >= 8 ? 9 : qb + 1);
    const unsigned lds0 = (unsigned)(uintptr_t)lds; const unsigned kdst = lds0 + L_K + wid * 1024, vdst = lds0 + L_V + wid * 1024;
#define PF_TILE(t) ((MODE == 0) ? (((t) < nreal) ? (t) : nreal - 1) : (qb - (((t) < nreal) ? (t) : nreal - 1)))
    const int l_ = lane_id();
    const unsigned koff = (unsigned)(l_ * (int)PITCH + wid * 8) * 2u, voff = (unsigned)((16 * (wid & 3) + (l_ >> 2)) * (int)PITCH + (wid >> 2) * 32 + (l_ & 3) * 8) * 2u;
    glds16(uni_ptr((const char*)(Kg + (long)PF_TILE(0) * 64 * PITCH)), koff, (unsigned)__builtin_amdgcn_readfirstlane(kdst));
    glds16(uni_ptr((const char*)(Vg + (long)PF_TILE(0) * 64 * PITCH)), voff, (unsigned)__builtin_amdgcn_readfirstlane(vdst));
    glds16(uni_ptr((const char*)(Kg + (long)PF_TILE(1) * 64 * PITCH)), koff, (unsigned)__builtin_amdgcn_readfirstlane(kdst + SLOTB));
    glds16(uni_ptr((const char*)(Kg + (long)PF_TILE(2) * 64 * PITCH)), koff, (unsigned)__builtin_amdgcn_readfirstlane(kdst + 2 * SLOTB));
#undef PF_TILE
}
template <int MODE, bool PRE = false> __device__ __forceinline__ void flash_branch(LAS unsigned char* lds, const bf16_t* Kg, const bf16_t* Vg, const bf16x8 (&qr)[4], int qb, int tl, const LAS unsigned long long* mskp, const LAS float* gatep, int wid, int lane) {
    const int r32 = lane & 31, hi = lane >> 5;
    constexpr long PITCH = 256;
    const int nreal = (MODE == 0) ? qb + 1 : (qb >= 8 ? 9 : qb + 1);
    const int NT = nreal < 4 ? 4 : (ODD_NT ? nreal : ((nreal + 1) & ~1));
#define FB_TILE(t) ((MODE == 0) ? (((t) < nreal) ? (t) : nreal - 1) : (qb - (((t) < nreal) ? (t) : nreal - 1)))
    const unsigned lds0 = (unsigned)(uintptr_t)lds;
    LAS float* wsf = (LAS float*)(lds + L_WSF) + wid * 64;
#define FB_KOFF() ((unsigned)(lane_id() * (int)PITCH + wid * 8) * 2u)
#define FB_VOFF() ({ const int l_ = lane_id(); (unsigned)((16 * (wid & 3) + (l_ >> 2)) * (int)PITCH + (wid >> 2) * 32 + (l_ & 3) * 8) * 2u; })
    const unsigned kdst = lds0 + L_K + wid * 1024, vdst = lds0 + L_V + wid * 1024;
#define DMA_K(t, slot) glds16(uni_ptr((const char*)(Kg + (long)FB_TILE(t) * 64 * PITCH)), FB_KOFF(), (unsigned)__builtin_amdgcn_readfirstlane(kdst + (slot)))
#define DMA_V(t, slot) glds16(uni_ptr((const char*)(Vg + (long)FB_TILE(t) * 64 * PITCH)), FB_VOFF(), (unsigned)__builtin_amdgcn_readfirstlane(vdst + (slot)))
    bf16x8 kf[8];
    const lds_cptr shm3 = (lds_cptr)lds; const lds_cptr kp0 = shm3 + L_K + hi * 1024 + r32 * 16; const lds_cptr vp0 = shm3 + L_V + ((lane >> 4) & 1) * 32 + (lane & 3) * 8 + (4 * hi + ((lane & 15) >> 2)) * 64;
    if (!PRE) { DMA_K(0, 0); DMA_V(0, 0); DMA_K(1, SLOTB); }
    float mhat = 0.f, l_reg = 0.f; f32x16 o[2]; o[0] = f32x16{}; o[1] = f32x16{}; const f32x16 zero16 = f32x16{};
#define CMASK(P0, P1, t) mask_tile<MODE>(P0, P1, (t), qb, nreal, wid * 8, mskp)
    bool resc = false;
#define START(P0, P1) do { const float rm = rowmax_a(P0, P1); resc = false; \
    { const float dl = rm; mhat = fadd_s(mhat, dl); \
      _Pragma("unroll") for (int r = 0; r < 16; ++r) { P0[r] = fsub_s(P0[r], dl); P1[r] = fsub_s(P1[r], dl); } } \
    _Pragma("unroll") for (int r = 0; r < 16; ++r) P0[r] = __builtin_amdgcn_exp2f(P0[r]); } while (0)
#define RESC() do { if (resc) { asm volatile("s_waitcnt lgkmcnt(0)" ::: "memory"); \
      _Pragma("unroll") for (int d_ = 0; d_ < 2; ++d_) _Pragma("unroll") for (int r = 0; r < 16; ++r) o[d_][r] *= wsf[crow(r, hi)]; } } while (0)
    f32x16 pA0, pA1, pB0, pB1;
    int sl_prev = 0, sl_cur = 0, sl_next = SLOTB;
#define ROT() do { sl_prev = sl_cur; sl_cur = sl_next; sl_next = (sl_next == (NSLOT - 1) * SLOTB) ? 0 : sl_next + SLOTB; } while (0)
    if (!PRE) { DMA_K(2, 2 * SLOTB); }
    if (PRE) { FB_WAIT_BAR(7); } else { FB_WAIT_BAR(3); }
    { const lds_cptr kb = kp0;
      const f32x16 z = zero16;
#pragma unroll
      for (int d0 = 0; d0 < 4; ++d0) { const bf16x8 b0 = *(const LAS bf16x8*)(kb + d0 * 2048), b1 = *(const LAS bf16x8*)(kb + d0 * 2048 + 512);
          if (d0 == 0) { pA0 = __builtin_amdgcn_mfma_f32_32x32x16_bf16(b0, qr[0], z, 0, 0, 0); pA1 = __builtin_amdgcn_mfma_f32_32x32x16_bf16(b1, qr[0], z, 0, 0, 0); }
          else { pA0 = __builtin_amdgcn_mfma_f32_32x32x16_bf16(b0, qr[d0], pA0, 0, 0, 0); pA1 = __builtin_amdgcn_mfma_f32_32x32x16_bf16(b1, qr[d0], pA1, 0, 0, 0); } } }
    asm volatile("s_nop 15\n\ts_nop 7" : "+v"(pA0), "+v"(pA1)); CMASK(pA0, pA1, 0);
    START(pA0, pA1);
#pragma unroll
    for (int r = 0; r < 16; ++r) pA1[r] = __builtin_amdgcn_exp2f(pA1[r]);
    FB_WAIT_BAR(0);
    DMA_K(3, 0); DMA_V(1, SLOTB);
    ROT();
    kload8(kf, kp0 + sl_cur);
    FB_WAIT_BAR(2);
    s16x4 vlo[8], vhi[8]; u32x4 pw0, pw1, pw2, pw3;
#define PKW(P, B) cvt_pk_bf16(P[B], P[B + 1])
#define PAF(k) __builtin_bit_cast(bf16x8, pw##k)
#define VFR(i) (bf16x8){vlo[i][0], vlo[i][1], vlo[i][2], vlo[i][3], vhi[i][0], vhi[i][1], vhi[i][2], vhi[i][3]}
#define PIN(x) asm volatile("" : "+v"(x))
#define MX3(a, b, c) __builtin_fmaxf(__builtin_fmaxf((a), (b)), (c))
#define GAPA(MF, A0, A1, A2, A3, W0, W1, PW) do { MF; sacc += A0; sacc += A1; sacc += A2; sacc += A3; PIN(sacc); W0; W1; PIN(PW); FB_SBAR(); } while (0)
#define EX(v) __builtin_amdgcn_exp2f(v)
#define GAPB(MF, X, B) do { MF; X[B] = EX(X[B]); X[B + 1] = EX(X[B + 1]); X[B + 2] = EX(X[B + 2]); X[B + 3] = EX(X[B + 3]); PIN(X); FB_SBAR(); } while (0)
#define VRD(i) do { vlo[i] = vtr(vp_ + (((i) >> 2) * 4096 + ((i) & 3) * 1024)); vhi[i] = vtr(vp_ + (((i) >> 2) * 4096 + ((i) & 3) * 1024 + 512)); } while (0)
#define KRD(G, j) do { if (G) { kload2(kf, kp0 + sl_next, j); FB_SBAR(); } } while (0)
#define STEP(C0, C1, P0, P1, t, GK, GV, GL) do { FB_SBAR(); \
    const lds_cptr vp_ = vp0 + sl_prev; \
    VRD(0); FB_SBAR(); float sacc = (P0[0] + P0[1]); \
    GAPA(C0 = __builtin_amdgcn_mfma_f32_32x32x16_bf16(kf[0], qr[0], zero16, 0, 0, 0), P0[2], P0[3], P0[4], P0[5],     pw0[0] = PKW(P0, 0), pw0[1] = PKW(P0, 2), pw0); \
    VRD(4); FB_SBAR(); GAPA(C1 = __builtin_amdgcn_mfma_f32_32x32x16_bf16(kf[1], qr[0], zero16, 0, 0, 0), P0[6], P0[7], P0[8], P0[9],     pw0[2] = PKW(P0, 4), pw0[3] = PKW(P0, 6), pw0); \
    VRD(1); FB_SBAR(); GAPA(C0 = __builtin_amdgcn_mfma_f32_32x32x16_bf16(kf[2], qr[1], C0, 0, 0, 0),   P0[10], P0[11], P0[12], P0[13], pw1[0] = PKW(P0, 8), pw1[1] = PKW(P0, 10), pw1); \
    VRD(5); FB_SBAR(); GAPA(C1 = __builtin_amdgcn_mfma_f32_32x32x16_bf16(kf[3], qr[1], C1, 0, 0, 0),   P0[14], P0[15], P1[0], P1[1],   pw1[2] = PKW(P0, 12), pw1[3] = PKW(P0, 14), pw1); \
    VRD(2); FB_SBAR(); GAPA(C0 = __builtin_amdgcn_mfma_f32_32x32x16_bf16(kf[4], qr[2], C0, 0, 0, 0),   P1[2], P1[3], P1[4], P1[5],     pw2[0] = PKW(P1, 0), pw2[1] = PKW(P1, 2), pw2); \
    VRD(6); FB_SBAR(); GAPA(C1 = __builtin_amdgcn_mfma_f32_32x32x16_bf16(kf[5], qr[2], C1, 0, 0, 0),   P1[6], P1[7], P1[8], P1[9],     pw2[2] = PKW(P1, 4), pw2[3] = PKW(P1, 6), pw2); \
    VRD(3); FB_SBAR(); GAPA(C0 = __builtin_amdgcn_mfma_f32_32x32x16_bf16(kf[6], qr[3], C0, 0, 0, 0),   P1[10], P1[11], P1[12], P1[13], pw3[0] = PKW(P1, 8), pw3[1] = PKW(P1, 10), pw3); \
    VRD(7); FB_SBAR(); GAPA(C1 = __builtin_amdgcn_mfma_f32_32x32x16_bf16(kf[7], qr[3], C1, 0, 0, 0),   P1[14], P1[15], 0.f, 0.f,       pw3[2] = PKW(P1, 12), pw3[3] = PKW(P1, 14), pw3); \
    l_reg += sacc; \
    if (GK) { DMA_K((t) + 3, sl_cur); } if (GV) { DMA_V((t) + 1, sl_next); } \
    { const bool dead_ = ((t) >= nreal) || (MODE == 0 && !((*mskp >> (t)) & 1ull)); const float mh_ = dead_ ? INFINITY : mhat;       \
      _Pragma("unroll") for (int r = 0; r < 16; ++r) { C0[r] -= mh_; C1[r] -= mh_; } } \
    mask_pos<MODE>(C0, C1, (t), qb, wid * 8); \
    { float a = MX3(C0[0], C0[1], C1[0]), b = MX3(C0[2], C0[3], C1[1]); a = MX3(a, C1[2], C1[3]); \
      _Pragma("unroll") for (int r = 4; r < 16; r += 4) { a = MX3(a, C0[r], C0[r + 1]); b = MX3(b, C0[r + 2], C0[r + 3]); a = MX3(a, C1[r], C1[r + 1]); b = MX3(b, C1[r + 2], C1[r + 3]); } \
      float rm = __builtin_fmaxf(a, b); { auto rr = __builtin_amdgcn_permlane32_swap(__float_as_uint(rm), __float_as_uint(rm), false, false); rm = __builtin_fmaxf(__uint_as_float(rr[0]), __uint_as_float(rr[1])); } \
      resc = false; \
      if (__builtin_expect(__any(rm > 8.0f), 0)) { const float dl = __builtin_fmaxf(rm, 0.f); mhat += dl; \
        _Pragma("unroll") for (int r = 0; r < 16; ++r) { C0[r] -= dl; C1[r] -= dl; } \
        const float f = __builtin_amdgcn_exp2f(-dl); l_reg *= f; if (hi == 0) wsf[r32] = f; resc = true; } } \
    FB_SBAR(); \
    GAPB(o[0] = __builtin_amdgcn_mfma_f32_32x32x16_bf16(PAF(0), VFR(0), o[0], 0, 0, 0), C0, 0); \
    GAPB(o[1] = __builtin_amdgcn_mfma_f32_32x32x16_bf16(PAF(0), VFR(4), o[1], 0, 0, 0), C0, 4); \
    KRD(GL, 0); GAPB(o[0] = __builtin_amdgcn_mfma_f32_32x32x16_bf16(PAF(1), VFR(1), o[0], 0, 0, 0), C0, 8); \
    KRD(GL, 1); GAPB(o[1] = __builtin_amdgcn_mfma_f32_32x32x16_bf16(PAF(1), VFR(5), o[1], 0, 0, 0), C0, 12); \
    KRD(GL, 2); GAPB(o[0] = __builtin_amdgcn_mfma_f32_32x32x16_bf16(PAF(2), VFR(2), o[0], 0, 0, 0), C1, 0); \
    KRD(GL, 3); GAPB(o[1] = __builtin_amdgcn_mfma_f32_32x32x16_bf16(PAF(2), VFR(6), o[1], 0, 0, 0), C1, 4); \
    GAPB(o[0] = __builtin_amdgcn_mfma_f32_32x32x16_bf16(PAF(3), VFR(3), o[0], 0, 0, 0), C1, 8); \
    GAPB(o[1] = __builtin_amdgcn_mfma_f32_32x32x16_bf16(PAF(3), VFR(7), o[1], 0, 0, 0), C1, 12); \
    } while (0)
    int t = 1;
    for (; t + 5 < NT; t += 2) {
        STEP(pB0, pB1, pA0, pA1, t, true, true, true);     FB_WAIT_BAR(2); RESC(); ROT();
        STEP(pA0, pA1, pB0, pB1, t + 1, true, true, true); FB_WAIT_BAR(2); RESC(); ROT();
    }
#define ENDW(tt) do { if ((tt) + 3 < NT) { FB_WAIT_BAR(2); } else if ((tt) + 2 < NT) { FB_WAIT_BAR(1); } else { FB_WAIT_BAR(0); } } while (0)
    for (; t + 1 < NT; t += 2) {
        STEP(pB0, pB1, pA0, pA1, t, (t + 3 < NT), (t + 1 < NT), (t + 1 < NT));         ENDW(t);     RESC(); ROT();
        STEP(pA0, pA1, pB0, pB1, t + 1, (t + 4 < NT), (t + 2 < NT), (t + 2 < NT));     ENDW(t + 1); RESC(); ROT();
    }
#define DRAIN(P0, P1, SL) do { float sacc = P0[0] + P0[1]; \
      _Pragma("unroll") for (int r = 2; r < 16; ++r) sacc += P0[r]; \
      _Pragma("unroll") for (int r = 0; r < 16; ++r) sacc += P1[r]; \
      l_reg += sacc; \
      pw0 = (u32x4){PKW(P0, 0), PKW(P0, 2), PKW(P0, 4), PKW(P0, 6)}; pw1 = (u32x4){PKW(P0, 8), PKW(P0, 10), PKW(P0, 12), PKW(P0, 14)}; \
      pw2 = (u32x4){PKW(P1, 0), PKW(P1, 2), PKW(P1, 4), PKW(P1, 6)}; pw3 = (u32x4){PKW(P1, 8), PKW(P1, 10), PKW(P1, 12), PKW(P1, 14)}; \
      FB_SBAR(); pv(o, (int)(lds0 + L_V) + ((lane >> 4) & 1) * 32 + (lane & 3) * 8 + (4 * hi + ((lane & 15) >> 2)) * 64 + (SL), PAF(0), PAF(1), PAF(2), PAF(3)); } while (0)
    if (t < NT) { STEP(pB0, pB1, pA0, pA1, NT - 1, false, false, false); RESC(); DRAIN(pB0, pB1, sl_cur); }
    else { DRAIN(pA0, pA1, sl_prev); }
#undef DRAIN
    l_reg = halfsum(l_reg);
    if (hi == 0) { const float gate = *gatep; wsf[32 + r32] = (l_reg > 0.f) ? gate / l_reg : 0.f; }
    asm volatile("s_waitcnt lgkmcnt(0)" ::: "memory");
    { LAS float* acc = (LAS float*)(lds + L_ACC) + wid * 2048;
#pragma unroll
      for (int r = 0; r < 16; ++r) { const int orow = crow(r, hi); const float f = wsf[32 + orow];
#pragma unroll
          for (int d0 = 0; d0 < 2; ++d0) acc[orow * 64 + d0 * 32 + r32] += o[d0][r] * f; } }
    asm volatile("s_waitcnt lgkmcnt(0)\n\ts_barrier" ::: "memory");
#undef DMA_K
#undef DMA_V
#undef CMASK
#undef START
#undef RESC
#undef ROT
#undef PKW
#undef PAF
#undef VFR
#undef PIN
#undef MX3
#undef GAPA
#undef GAPB
#undef EX
#undef VRD
#undef KRD
#undef STEP
#undef ENDW
#undef FB_TILE
#undef FB_KOFF
#undef FB_VOFF
}
#define NSA_PACK(P, B) cvt_pk_bf16(P[B], P[B + 1])
#define NSA_PA(P, B) __builtin_bit_cast(bf16x8, (u32x4){NSA_PACK(P, B), NSA_PACK(P, B + 2), NSA_PACK(P, B + 4), NSA_PACK(P, B + 6)})

__device__ __forceinline__ void nsa_unit(Frame& F, int b, int g, int qb) {
    const int lane = lane_id(), wid = F.wave, r32 = lane & 31, hi = lane >> 5;
    LAS unsigned char* lds = F.lds; unsigned char* ws = F.ws;
    const bf16_t* Q = (const bf16_t*)(F.out + DO_Q); const bf16_t* Z = (const bf16_t*)(F.out + DO_Z);
    const float* G = (const float*)(ws + WS_G); bf16_t* ATT = (bf16_t*)(ws + WS_ATT);
    const int tl = wid * 8 + (r32 >> 2), hh = r32 & 3, t = qb * 64 + tl;
    const size_t tokrow = (size_t)b * SEQ + t;
    bf16x8 qr[4];
#pragma unroll
    for (int d0 = 0; d0 < 4; ++d0) qr[d0] = *(const bf16x8*)(Q + tokrow * 1024 + g * 256 + hh * 64 + d0 * 16 + hi * 8);
    LAS float* gl = (LAS float*)(lds + LDS_GATE) + wid * 96 + r32;
    { const float* gp = G + tokrow * 48 + g * 12 + hh * 3; const float g0_ = gp[0], g1_ = gp[1], g2_ = gp[2]; if (hi == 0) { gl[0] = g0_; gl[32] = g1_; gl[64] = g2_; } }
    LAS float* wsf = (LAS float*)(lds + L_WSF) + wid * 64;
    LAS float* GS = (LAS float*)(lds + L_GS) + wid * 512; LAS float* LS = (LAS float*)(lds + L_LS) + wid * 512;
    LAS unsigned long long* MSK = (LAS unsigned long long*)(lds + L_MSK) + wid * 8;
    const int vbl = (int)(unsigned)(uintptr_t)(lds + L_KV + 8192) + ((lane >> 4) & 1) * 32 + (lane & 3) * 8 + (4 * hi + ((lane & 15) >> 2)) * 64;
    f32x16 oacc[2], o[2], p0, p1; oacc[0] = f32x16{}; oacc[1] = f32x16{};
#define NSA_DMA_K(st, base) __builtin_amdgcn_global_load_lds((const unsigned*)(uni_ptr(base) + koff), (LAS unsigned*)(lds + L_KV + (st) * 16384 + wid * 1024), 16, 0, 0)
#define NSA_DMA_V(st, base) __builtin_amdgcn_global_load_lds((const unsigned*)(uni_ptr(base) + voff), (LAS unsigned*)(lds + L_KV + (st) * 16384 + 8192 + wid * 1024), 16, 0, 0)
#ifndef PROBE_NSA
#define PROBE_NSA 0
#endif
    for (int prep = 0; prep < (PROBE_NSA == 1 ? 2 : 1); ++prep) { oacc[0] = f32x16{}; oacc[1] = f32x16{};
    {
        const int nvalid = (4 * qb + 3 < 255) ? 4 * qb + 3 : 255, ntc = (nvalid + 63) >> 6;
        const char* Kc = (const char*)(ws + WS_KCC) + (size_t)(b * 4 + g) * 256 * 128; const char* Vc = (const char*)(ws + WS_VCC) + (size_t)(b * 4 + g) * 256 * 128;
        const unsigned koff = (unsigned)lane * 128u + wid * 16, voff = (unsigned)(16 * (wid & 3) + (lane >> 2)) * 128u + (wid >> 2) * 64 + (lane & 3) * 16;
        for (int i = 0; i < ntc; ++i) {
            __builtin_amdgcn_global_load_lds((const unsigned*)(uni_ptr(Kc + (size_t)i * 8192) + koff), (LAS unsigned*)(lds + i * 8192 + wid * 1024), 16, 0, 0);
            __builtin_amdgcn_global_load_lds((const unsigned*)(uni_ptr(Vc + (size_t)i * 8192) + voff), (LAS unsigned*)(lds + L_ACC + i * 8192 + wid * 1024), 16, 0, 0); }
        const int nrow = (t >= 31) ? ((t - 31) >> 4) : -1;
        VM_WAIT(); __syncthreads();
        if (PROBE_NSA == 4) {
#pragma unroll
            for (int d0 = 0; d0 < 4; ++d0) { qr[d0] = *(const bf16x8*)(Q + tokrow * 1024 + g * 256 + hh * 64 + d0 * 16 + hi * 8); asm volatile("" : "+v"(qr[d0])); }
            for (int i = 0; i < ntc; ++i) {
                __builtin_amdgcn_global_load_lds((const unsigned*)(uni_ptr(Kc + (size_t)i * 8192) + koff), (LAS unsigned*)(lds + i * 8192 + wid * 1024), 16, 0, 0);
                __builtin_amdgcn_global_load_lds((const unsigned*)(uni_ptr(Vc + (size_t)i * 8192) + voff), (LAS unsigned*)(lds + L_ACC + i * 8192 + wid * 1024), 16, 0, 0); }
            VM_WAIT(); __syncthreads(); }
        f32x16 s0[4], s1[4];
        float m = NSA_NEG;
#pragma unroll
        for (int i = 0; i < 4; ++i) if (i < ntc) {
            qkt(s0[i], s1[i], lds + i * 8192, qr, r32, hi);
            const int lim = nrow - 64 * i - 4 * hi;
            if (__any(64 * i + 63 > nrow)) {
#pragma unroll
                for (int r = 0; r < 16; ++r) { const int cr = (r & 3) + 8 * (r >> 2); if (cr > lim) s0[i][r] = NSA_NEG; if (cr + 32 > lim) s1[i][r] = NSA_NEG; } }
#pragma unroll
            for (int r = 0; r < 16; r += 2) m = fmaxf(m, fmaxf(fmaxf(s0[i][r], s0[i][r + 1]), fmaxf(s1[i][r], s1[i][r + 1]))); }
        { auto rr = __builtin_amdgcn_permlane32_swap(__float_as_uint(m), __float_as_uint(m), false, false); m = fmaxf(__uint_as_float(rr[0]), __uint_as_float(rr[1])); }
        const float mu = (m == NSA_NEG) ? 0.f : m; float l = 0.f;
#pragma unroll
        for (int i = 0; i < 4; ++i) if (i < ntc) {
#pragma unroll
            for (int r = 0; r < 16; ++r) { s0[i][r] = __builtin_amdgcn_exp2f(s0[i][r] - mu); s1[i][r] = __builtin_amdgcn_exp2f(s1[i][r] - mu); l += s0[i][r] + s1[i][r]; } }
        l = halfsum(l);
        const float inv_l = l > 0.f ? 1.0f / l : 0.f;
        o[0] = f32x16{}; o[1] = f32x16{};
        const int vbc = (int)(unsigned)(uintptr_t)(lds + L_ACC) + ((lane >> 4) & 1) * 32 + (lane & 3) * 8 + (4 * hi + ((lane & 15) >> 2)) * 64;
#define QSUM(v) do { v += __int_as_float(__builtin_amdgcn_update_dpp(0, __float_as_int(v), 0xB1, 0xf, 0xf, true)); v += __int_as_float(__builtin_amdgcn_update_dpp(0, __float_as_int(v), 0x4E, 0xf, 0xf, true)); } while (0)
#pragma unroll
        for (int i = 0; i < 4; ++i) if (i < ntc) {
#if defined(PROBE_CMP) && PROBE_CMP == 1
            for (int prc = 0; prc < 2; ++prc)
#endif
#pragma unroll
            for (int a = 0; a < 4; ++a) {
                float g0 = ((s0[i][4 * a] + s0[i][4 * a + 1]) + (s0[i][4 * a + 2] + s0[i][4 * a + 3])) * inv_l, l0 = s0[i][4 * a + 3] * inv_l;
                float g1 = ((s1[i][4 * a] + s1[i][4 * a + 1]) + (s1[i][4 * a + 2] + s1[i][4 * a + 3])) * inv_l, l1 = s1[i][4 * a + 3] * inv_l;
                QSUM(g0); QSUM(l0); QSUM(g1); QSUM(l1);
                if (hh == 0) { const int j = 16 * i + 2 * a + hi, tk = r32 >> 2;
                    GS[tk * 64 + j] = g0; GS[tk * 64 + j + 8] = g1; LS[tk * 64 + j + 1] = l0; if (j + 9 < 64) LS[tk * 64 + j + 9] = l1; }
            }
            const bf16x8 pa0 = NSA_PA(s0[i], 0), pa1 = NSA_PA(s0[i], 8), pa2 = NSA_PA(s1[i], 0), pa3 = NSA_PA(s1[i], 8);
            pv(o, vbc + i * 8192, pa0, pa1, pa2, pa3);
#if defined(PROBE_CMP) && PROBE_CMP == 2
            { f32x16 o2[2]; o2[0] = o[0]; o2[1] = o[1]; pv(o2, vbc + i * 8192, pa0, pa1, pa2, pa3); asm volatile("" :: "v"(o2[0]), "v"(o2[1])); }
#endif
        }
#undef QSUM
        { const float gate_c = gl[0] * inv_l; oacc[0] = f32x16{}; oacc[1] = f32x16{}; row_fma(oacc, o, gate_c, wsf, r32, hi); }
        __syncthreads();
    }
#if WIN_PREFETCH
    flash_prefetch<1>(lds, (const bf16_t*)(ws + WS_KW) + (size_t)b * SEQ * 256 + g * 64, (const bf16_t*)(ws + WS_VW) + (size_t)b * SEQ * 256 + g * 64, qb, wid);
#endif
    LDS_WAIT();
    {
        const int tkq = lane >> 3, c8 = lane & 7;
        const LAS float* gsp = GS + tkq * 64 + c8 * 8; const LAS float* lsp = LS + tkq * 64 + c8 * 8;
        const f32x4 ga = *(const LAS f32x4*)gsp, gb = *(const LAS f32x4*)(gsp + 4), la = *(const LAS f32x4*)lsp, lb = *(const LAS f32x4*)(lsp + 4);
        unsigned key[8];
#pragma unroll
        for (int i = 0; i < 8; ++i) { const int j = c8 * 8 + i; const float gv = (i < 4) ? ga[i & 3] : gb[i & 3], lv = (i < 4) ? la[i & 3] : lb[i & 3];
            const float imp = gv + (j > 0 ? lv : 0.f);
            const bool valid = j <= qb, forced = (j == 0) || (j == qb) || (j == qb - 1);
#if defined(PROBE_SELINV)
            const float sc = forced ? 1e4f : (1e3f - imp);
#else
            const float sc = imp + (forced ? 1e4f : 0.f);
#endif
            key[i] = valid ? __float_as_uint(sc) + 1u : 0u; }
#define G8SUM(v) do { v += __builtin_amdgcn_update_dpp(0, v, 0xB1, 0xf, 0xf, true); v += __builtin_amdgcn_update_dpp(0, v, 0x4E, 0xf, 0xf, true); v += __builtin_amdgcn_update_dpp(0, v, 0x141, 0xf, 0xf, true); } while (0)
        unsigned T = 0u;
#if defined(PROBE_TOPK)
        for (int prt = 0; prt < 2; ++prt) { T = 0u;
#pragma unroll
        for (int i = 0; i < 8; ++i) asm volatile("" : "+v"(key[i]));
#endif
        if (qb >= 16) {
#pragma unroll
            for (int bit = 31; bit >= 0; --bit) { const unsigned cand = T | (1u << bit); int cnt = 0;
#pragma unroll
                for (int i = 0; i < 8; ++i) cnt += (key[i] >= cand) ? 1 : 0;
                G8SUM(cnt);
                T = (cnt >= 16) ? cand : T; } }
#if defined(PROBE_TOPK)
        }
#endif
        int gcnt = 0, ecnt = 0;
#pragma unroll
        for (int i = 0; i < 8; ++i) { gcnt += (key[i] > T) ? 1 : 0; ecnt += (key[i] == T) ? 1 : 0; }
        G8SUM(gcnt); const int need = 16 - gcnt;
        int pre = ecnt;
        { const int t1 = __builtin_amdgcn_update_dpp(0, pre, 0x111, 0xf, 0xf, true); pre += (c8 >= 1) ? t1 : 0;
          const int t2 = __builtin_amdgcn_update_dpp(0, pre, 0x112, 0xf, 0xf, true); pre += (c8 >= 2) ? t2 : 0;
          const int t4 = __builtin_amdgcn_update_dpp(0, pre, 0x114, 0xf, 0xf, true); pre += (c8 >= 4) ? t4 : 0; }
        int below = pre - ecnt; unsigned bits = 0u;
#pragma unroll
        for (int i = 0; i < 8; ++i) { const bool eq = key[i] == T; const bool sel = (key[i] != 0u) && ((key[i] > T) || (eq && below < need)); below += eq ? 1 : 0; bits |= sel ? (1u << i) : 0u; }
        ((LAS unsigned char*)MSK)[tkq * 8 + c8] = (unsigned char)bits;
#undef G8SUM
    }
    }
    LDS_WAIT();
    { const char* zsrc = (const char*)Z + ((size_t)b * SEQ + qb * 64 + wid * 8) * 2048 + g * 512 + (lane >> 5) * 2048 + (lane & 31) * 16;
      const unsigned zg = (unsigned)(uintptr_t)(lds + L_GS) + wid * 2048u, zl = (unsigned)(uintptr_t)(lds + L_LS) + wid * 2048u;
      glds16(uni_ptr((const char*)Z + ((size_t)b * SEQ + qb * 64 + wid * 8) * 2048 + g * 512), (unsigned)((lane >> 5) * 2048 + (lane & 31) * 16), (unsigned)__builtin_amdgcn_readfirstlane(zg));
      glds16(uni_ptr((const char*)Z + ((size_t)b * SEQ + qb * 64 + wid * 8 + 2) * 2048 + g * 512), (unsigned)((lane >> 5) * 2048 + (lane & 31) * 16), (unsigned)__builtin_amdgcn_readfirstlane(zg + 1024u));
      glds16(uni_ptr((const char*)Z + ((size_t)b * SEQ + qb * 64 + wid * 8 + 4) * 2048 + g * 512), (unsigned)((lane >> 5) * 2048 + (lane & 31) * 16), (unsigned)__builtin_amdgcn_readfirstlane(zl));
      glds16(uni_ptr((const char*)Z + ((size_t)b * SEQ + qb * 64 + wid * 8 + 6) * 2048 + g * 512), (unsigned)((lane >> 5) * 2048 + (lane & 31) * 16), (unsigned)__builtin_amdgcn_readfirstlane(zl + 1024u));
      (void)zsrc; }
    const LAS unsigned long long* mskp = MSK + (r32 >> 2);
    { LAS float* acc = (LAS float*)(lds + L_ACC) + wid * 2048;
#pragma unroll
      for (int r = 0; r < 16; ++r) { const int orow = crow(r, hi);
#pragma unroll
          for (int d0 = 0; d0 < 2; ++d0) acc[orow * 64 + d0 * 32 + r32] = oacc[d0][r]; } }
    { const bf16_t* Kw = (const bf16_t*)(ws + WS_KW) + (size_t)b * SEQ * 256 + g * 64; const bf16_t* Vw = (const bf16_t*)(ws + WS_VW) + (size_t)b * SEQ * 256 + g * 64;
      flash_branch<1, WIN_PREFETCH != 0>(lds, Kw, Vw, qr, qb, tl, mskp, gl + 64, wid, lane);
      if (PROBE_NSA == 2) flash_branch<1>(lds, Kw, Vw, qr, qb, tl, mskp, (const LAS float*)(lds + LDSCTL_OFF), wid, lane); }
    { const bf16_t* Ks = (const bf16_t*)(ws + WS_KS) + (size_t)b * SEQ * 256 + g * 64; const bf16_t* Vs = (const bf16_t*)(ws + WS_VS) + (size_t)b * SEQ * 256 + g * 64;
      flash_branch<0>(lds, Ks, Vs, qr, qb, tl, mskp, gl + 32, wid, lane);
      if (PROBE_NSA == 3) flash_branch<0>(lds, Ks, Vs, qr, qb, tl, mskp, (const LAS float*)(lds + LDSCTL_OFF), wid, lane); }
    for (int pro = 0; pro < (PROBE_NSA == 5 ? 2 : 1); ++pro)
    {
        const LAS float* acc = (const LAS float*)(lds + L_ACC) + wid * 2048;
#pragma unroll
        for (int i = 0; i < 4; ++i) { const int row = i * 8 + (lane >> 3), ch = lane & 7; const f32x4 a0 = *(const LAS f32x4*)(acc + row * 64 + ch * 8), a1 = *(const LAS f32x4*)(acc + row * 64 + ch * 8 + 4);
            const size_t off = ((size_t)b * SEQ + qb * 64 + wid * 8 + (row >> 2)) * 1024 + g * 256 + (row & 3) * 64 + ch * 8;
            const int tk_ = row >> 2; const LAS unsigned char* zp = lds + (tk_ < 4 ? L_GS : L_LS) + wid * 2048 + (tk_ & 3) * 512 + (row & 3) * 128 + ch * 16;
            const u32x4 zz = *(const LAS u32x4*)zp; f32x4 z0, z1; epi::unpack8(zz, z0, z1);
            *(u32x4*)(ATT + off) = epi::pack8(a0 * z0, a1 * z1); }
        LDS_WAIT();
    }
    __syncthreads();
#undef NSA_DMA_K
#undef NSA_DMA_V
}
__device__ __forceinline__ void nsa_phase(Frame& F) {
    if (F.G == 256) {
        const int bg = F.vcu >> 3, s = F.vcu & 7;
        for (int i = 0; i < 8; ++i) { const int k = i >> 1; const int qb = (i & 1) ? (63 - 8 * k - s) : (8 * k + s); nsa_unit(F, bg >> 2, bg & 3, qb); }
    } else {
        for (int u = F.vcu; u < 2048; u += F.G) nsa_unit(F, u >> 8, (u >> 6) & 3, u & 63);
    }
}
}

namespace ret {
__device__ __forceinline__ int crow(int r, int hi) { return (r & 3) + 8 * (r >> 2) + 4 * hi; }
__device__ __forceinline__ void p_phase(Frame& F) {
    const int lane = lane_id(), wid = F.wave, r32 = lane & 31, hi = lane >> 5;
    const bf16_t* Qp = (const bf16_t*)(F.ws + WS_QP); const bf16_t* Kp = (const bf16_t*)(F.out);
    bf16_t* PT = (bf16_t*)(F.ws + WS_PT);
    const int ib = wid & 3, jb0 = (wid >> 2) * 2;
    for (int it = F.vcu; it < 1024; it += F.G) {
        const int bh = it >> 5, c = it & 31, b = bh >> 2, h = bh & 3;
        const float ginv = __builtin_amdgcn_exp2f(-128.0f * epi::log2_gamma(h));
#pragma unroll
        for (int jj = 0; jj < 2; ++jj) { const int jb = jb0 + jj;
            if (jb > ib) {
#pragma unroll
                for (int a = 0; a < 4; ++a) *(u32x2*)(PT + ((((size_t)it * 4 + ib) * 8 + (2 * jb + (a >> 1))) * 2 + (a & 1)) * 256 + r32 * 8 + 4 * hi) = (u32x2){0u, 0u};
            } else {
                const bf16_t* ka = Kp + epi::qt_index(b, c * 128 + jb * 32, h, 0) + lane * 8; const bf16_t* qa = Qp + epi::qt_index(b, c * 128 + ib * 32, h, 0) + lane * 8;
                bf16x8 fa[16], fb[16];
#pragma unroll
                for (int ks = 0; ks < 16; ++ks) { fa[ks] = *(const bf16x8*)(ka + ks * 512); fb[ks] = *(const bf16x8*)(qa + ks * 512); }
                f32x16 acc = {};
#pragma unroll
                for (int ks = 0; ks < 16; ++ks) acc = __builtin_amdgcn_mfma_f32_32x32x16_bf16(fa[ks], fb[ks], acc, 0, 0, 0);
#pragma unroll
                for (int a = 0; a < 4; ++a) { float v[4];
#pragma unroll
                    for (int x = 0; x < 4; ++x) { const int jl = jb * 32 + 8 * a + 4 * hi + x; v[x] = (jl <= ib * 32 + r32) ? acc[4 * a + x] * ginv : 0.f; }
                    u32x2 w; w.x = cvt_pk_bf16(v[0], v[1]); w.y = cvt_pk_bf16(v[2], v[3]);
                    *(u32x2*)(PT + ((((size_t)it * 4 + ib) * 8 + (2 * jb + (a >> 1))) * 2 + (a & 1)) * 256 + r32 * 8 + 4 * hi) = w; }
            } }
    }
}
constexpr int ST_PITCH = 264;
__device__ __forceinline__ void scan_item(Frame& F, int b, int h, int s, bool do_stats) {
    const int lane = lane_id(), wid = F.wave, r32 = lane & 31, hi = lane >> 5, ib = wid & 3; const bool heavy = wid < 4;
    const bf16_t* Qp = (const bf16_t*)(F.ws + WS_QP); const bf16_t* Ktp = (const bf16_t*)(F.ws + WS_KTP); const bf16_t* Vt = (const bf16_t*)(F.ws + WS_VT); const bf16_t* PT = (const bf16_t*)(F.ws + WS_PT);
    bf16_t* O = (bf16_t*)(F.out); float* stats = (float*)(F.ws + WS_STATS);
    LAS bf16_t* St = (LAS bf16_t*)(F.lds);
    const int bh = b * 4 + h;
    const float l2g = epi::log2_gamma(h), g128 = __builtin_amdgcn_exp2f(128.0f * l2g);
    const bf16_t* vB0 = Vt + epi::tt_index(bh, 16, s * 64, 0) + lane * 8;
    const bf16_t* vB1 = Vt + epi::tt_index(bh, 16, s * 64 + 32, 0) + lane * 8;
    const bf16_t* kA = Ktp + epi::tt_index(bh, 8, wid * 32, 0) + lane * 8;
    const bf16_t* qB = Qp + epi::qt_index(b, ib * 32, h, 0) + lane * 8;
    const bf16_t* pB = PT + (((size_t)bh * 32) * 4 + ib) * 8 * 512 + lane * 8;
    constexpr int ST_BYTES = 64 * ST_PITCH * 2, VT_OFF = 2 * ST_BYTES, OST_OFF = VT_OFF + 32768, OST_BYTES = 128 * 136;
    const bf16_t* vS = Vt + epi::tt_index(bh, 16, s * 64 + (wid >> 2) * 32, 0);
    const unsigned vdst0 = (unsigned)(uintptr_t)(F.lds + VT_OFF) + (unsigned)wid * 2048u;
#define VT_DMA(c_, buf_) do { const char* src_ = (const char*)(vS + (size_t)((c_) * 8 + 2 * (wid & 3)) * 512); \
        nsa::glds16(uni_ptr(src_), (unsigned)lane * 16u, (unsigned)__builtin_amdgcn_readfirstlane(vdst0 + (buf_) * 16384u)); \
        nsa::glds16(uni_ptr(src_ + 1024), (unsigned)lane * 16u, (unsigned)__builtin_amdgcn_readfirstlane(vdst0 + (buf_) * 16384u + 1024u)); } while (0)
    const LAS bf16_t* vl = (const LAS bf16_t*)(F.lds + VT_OFF) + lane * 8;
    f32x16 S0 = {}, S1 = {};
    bf16x8 kaf[8], ipb[8], qf[16];
#define LOAD_KA(c_) do { _Pragma("unroll") for (int ks = 0; ks < 8; ++ks) kaf[ks] = *(const bf16x8*)(kA + (size_t)((c_) * 8 + ks) * 512); } while (0)
#define LOAD_PB(c_) do { _Pragma("unroll") for (int ks = 0; ks < 8; ++ks) ipb[ks] = *(const bf16x8*)(pB + (size_t)(c_) * (4 * 8 * 512) + ks * 512); } while (0)
#define LOAD_Q(c_)  do { _Pragma("unroll") for (int ks = 0; ks < 16; ++ks) qf[ks] = *(const bf16x8*)(qB + (size_t)(c_) * (4 * 4 * 16 * 512) + ks * 512); } while (0)
#define STORE_ROWS(c_) do { _Pragma("unroll") for (int i2 = 0; i2 < 2; ++i2) { const int row = wid * 16 + i2 * 8 + (lane >> 3), q = lane & 7; const LAS unsigned char* os = F.lds + OST_OFF + ((c_) & 1) * OST_BYTES + row * 136 + q * 16; \
            const u32x2 lo = *(const LAS u32x2*)os, hi2 = *(const LAS u32x2*)(os + 8); \
            *(u32x4*)(O + ((size_t)b * SEQ + (c_) * 128 + row) * 2048 + h * 512 + s * 64 + q * 8) = (u32x4){lo.x, lo.y, hi2.x, hi2.y}; } \
        if (heavy && hi == 0 && do_stats) { float* sp = stats + ((size_t)bh * 2) * SEQ + (c_) * 128 + ib * 32 + r32; atomicAdd(sp, ps1); atomicAdd(sp + SEQ, ps2); } } while (0)
    float ps1 = 0.f, ps2 = 0.f;
    VT_DMA(0, 0);
    LOAD_KA(0); if (heavy) LOAD_PB(0);
    asm volatile("s_waitcnt vmcnt(0)\n\ts_barrier" ::: "memory");
    for (int c = 0; c < 32; ++c) {
        const LAS bf16_t* vb = vl + (c & 1) * 8192;
        const LAS bf16_t* sa = St + (c & 1) * (64 * ST_PITCH) + r32 * ST_PITCH + hi * 8;
        LAS bf16_t* Stn = St + ((c + 1) & 1) * (64 * ST_PITCH);
        if (c < 31) VT_DMA(c + 1, (c + 1) & 1);
        if (c > 0) { if (heavy) LOAD_Q(c); STORE_ROWS(c - 1); }
        if (c < 31) {
#pragma unroll
            for (int r = 0; r < 16; ++r) { S0[r] *= g128; S1[r] *= g128; }
#pragma unroll
            for (int ks = 0; ks < 8; ++ks) { S0 = __builtin_amdgcn_mfma_f32_32x32x16_bf16(kaf[ks], *(const LAS bf16x8*)(vb + ks * 512), S0, 0, 0, 0); S1 = __builtin_amdgcn_mfma_f32_32x32x16_bf16(kaf[ks], *(const LAS bf16x8*)(vb + (8 + ks) * 512), S1, 0, 0, 0); }
            if (c < 30) LOAD_KA(c + 1);
#pragma unroll
            for (int a = 0; a < 4; ++a) { u32x2 w; w.x = cvt_pk_bf16(S0[4 * a], S0[4 * a + 1]); w.y = cvt_pk_bf16(S0[4 * a + 2], S0[4 * a + 3]); *(LAS u32x2*)(Stn + r32 * ST_PITCH + wid * 32 + 8 * a + 4 * hi) = w;
                w.x = cvt_pk_bf16(S1[4 * a], S1[4 * a + 1]); w.y = cvt_pk_bf16(S1[4 * a + 2], S1[4 * a + 3]); *(LAS u32x2*)(Stn + (32 + r32) * ST_PITCH + wid * 32 + 8 * a + 4 * hi) = w; }
        }
        if (heavy) {
            f32x16 oc0 = {}, oc1 = {};
#pragma unroll
            for (int ks = 0; ks < 8; ++ks) { oc0 = __builtin_amdgcn_mfma_f32_32x32x16_bf16(*(const LAS bf16x8*)(vb + ks * 512), ipb[ks], oc0, 0, 0, 0); oc1 = __builtin_amdgcn_mfma_f32_32x32x16_bf16(*(const LAS bf16x8*)(vb + (8 + ks) * 512), ipb[ks], oc1, 0, 0, 0); }
            if (c < 31) LOAD_PB(c + 1);
            if (c > 0) {
#pragma unroll
                for (int ks = 0; ks < 16; ++ks) { oc0 = __builtin_amdgcn_mfma_f32_32x32x16_bf16(*(const LAS bf16x8*)(sa + ks * 16), qf[ks], oc0, 0, 0, 0); oc1 = __builtin_amdgcn_mfma_f32_32x32x16_bf16(*(const LAS bf16x8*)(sa + 32 * ST_PITCH + ks * 16), qf[ks], oc1, 0, 0, 0); } }
            float s1 = 0.f, s2 = 0.f;
#pragma unroll
            for (int r = 0; r < 16; ++r) { s1 += oc0[r] + oc1[r]; s2 += oc0[r] * oc0[r] + oc1[r] * oc1[r]; }
            ps1 = nsa::halfsum(s1); ps2 = nsa::halfsum(s2);
            LAS unsigned char* ow = F.lds + OST_OFF + (c & 1) * OST_BYTES + (ib * 32 + r32) * 136 + (4 * hi) * 2;
#pragma unroll
            for (int a = 0; a < 4; ++a) { u32x2 w; w.x = cvt_pk_bf16(oc0[4 * a], oc0[4 * a + 1]); w.y = cvt_pk_bf16(oc0[4 * a + 2], oc0[4 * a + 3]); *(LAS u32x2*)(ow + 16 * a) = w;
                w.x = cvt_pk_bf16(oc1[4 * a], oc1[4 * a + 1]); w.y = cvt_pk_bf16(oc1[4 * a + 2], oc1[4 * a + 3]); *(LAS u32x2*)(ow + 64 + 16 * a) = w; }
        }
        asm volatile("s_waitcnt vmcnt(0) lgkmcnt(0)\n\ts_barrier" ::: "memory");
    }
    STORE_ROWS(31);
#undef LOAD_KA
#undef LOAD_PB
#undef LOAD_Q
#undef STORE_ROWS
#undef VT_DMA
    __syncthreads();
}
__device__ __forceinline__ void scan_phase(Frame& F, bool do_stats) {
    for (int it = F.vcu; it < 256; it += F.G) scan_item(F, it >> 5, (it >> 3) & 3, it & 7, do_stats);
}
}

__global__ void __launch_bounds__(NWAVES * 64, 2) mk_fwd(Args args) {
    extern __shared__ __attribute__((aligned(16))) unsigned char lds_raw[];
    Frame F;
    F.lds = (LAS unsigned char*)lds_raw;
    F.MISC = (volatile LAS unsigned*)(F.lds + MISC_OFF);
    F.wave = __builtin_amdgcn_readfirstlane(threadIdx.x >> 6);
    F.G = gridDim.x; { const int bx = blockIdx.x; F.vcu = (F.G % 8 == 0) ? (bx % 8) * (F.G / 8) + bx / 8 : bx; }
    F.out = args.out; F.ws = args.ws; F.ctl = (unsigned*)(args.ws + WS_CTL);
    unsigned char* ws = F.ws; unsigned char* dout = F.out;
    for (int u = F.wave * 64 + lane_id(); u < (LDS_BYTES - LDSCTL_OFF) / 4; u += NWAVES * 64) ((LAS unsigned*)(F.lds + LDSCTL_OFF))[u] = 0u;
    __syncthreads();
    XcdBarrier bar = xcd_barrier_post(F.ctl + CW_BAR, F.MISC + 8, F.wave);
    cg::grid_group grid = cg::this_grid();
    const int lo = args.ph_lo, hi = args.ph_hi, bx = (int)blockIdx.x, G = F.G;
#ifndef PROBE_PH
#define PROBE_PH (-1)
#endif
#ifndef PROBE_GEMM
#define PROBE_GEMM 0
#endif
#define REPS(k, isgemm) (((PROBE_PH) == (k) || ((isgemm) && PROBE_GEMM)) ? 2 : 1)
#define IN(k) (lo <= (k) && (k) < hi)
#if defined(PROBE_BAR)
#define SEAM(k) do { if (IN(k) && IN((k) + 1)) { xcd_barrier(bar); xcd_barrier(bar); } } while (0)
#else
#define SEAM(k) do { if (IN(k) && IN((k) + 1)) xcd_barrier(bar); } while (0)
#endif
    LAS unsigned char* ring = F.lds;

    if (IN(0)) { for (int rep = 0; rep < REPS(0, 0); ++rep) p0_prologue(F, args, rep == 0); if (IN(1)) grid.sync(); }

    if (IN(1)) for (int rep = 0; rep < REPS(1, 1); ++rep) {
        pg8::Gemm g{(const char*)(ws + WS_XB), (const char*)(ws + WS_WNIN), 2048u, 2048u, 128u, 128u, 1024};
        pg8::SchedStd S; S.init(128, 14, 0, G, bx, (size_t)256 * 2048, (size_t)256 * 2048);
        epi::NsaIn E{ws, dout};
        pg8::gemm_phase<epi::NsaIn, pg8::SchedStd, false>(ring, F.wave, g, S, E);
    }
    SEAM(1);
    if (IN(2)) for (int rep = 0; rep < REPS(2, 0); ++rep) {
        const bool cmp_cu = (G == 256) ? (bx < 64) : true, other_cu = (G == 256) ? (bx >= 64) : true;
        if (cmp_cu) {
            pg8::Gemm g{(const char*)(ws + WS_KC), (const char*)(ws + WS_WC1K), 8192u, 4096u, 512u, 128u, 2048};
            pg8::SchedCmp S{G, bx, WS_VC - WS_KC, WS_WC1V - WS_WC1K};
            epi::Cmp1 E{ws};
            pg8::gemm_phase<epi::Cmp1, pg8::SchedCmp, false>(ring, F.wave, g, S, E);
            VM_WAIT(); __syncthreads();
            __builtin_amdgcn_fence(__ATOMIC_ACQUIRE, "agent"); VM_WAIT();
            for (int u = bx; u < 64; u += G) cmp2_task(F, (u >> 5) * 256 + (u & 31) * 8 + F.wave);
        }
        { const int G2 = (G == 256) ? (cmp_cu ? 64 : 192) : G, c2 = (G == 256) ? (cmp_cu ? bx : bx - 64) : bx, u0 = (G == 256 && !cmp_cu) ? 64 : 0, u1 = (G == 256 && cmp_cu) ? 64 : 512;
          { pg8::Gemm g{(const char*)(ws + WS_PB0), (const char*)(ws + WS_WP0), 512u, 512u, 128u, 128u, 256};
            pg8::SchedStd S; S.init(128, 4, 0, G2, c2, (size_t)256 * 512, (size_t)256 * 512); S.range(u0, u1);
            epi::Bf16Plain E{(bf16_t*)(ws + WS_E0), 1024, 0};
            pg8::gemm_phase<epi::Bf16Plain, pg8::SchedStd, false>(ring, F.wave, g, S, E); }
          { pg8::Gemm g{(const char*)(ws + WS_PB1), (const char*)(ws + WS_WP1), 512u, 512u, 128u, 128u, 256};
            pg8::SchedStd S; S.init(128, 4, 0, G2, c2, (size_t)256 * 512, (size_t)256 * 512); S.range(u0, u1);
            epi::Bf16Plain E{(bf16_t*)(ws + WS_E1), 1024, 0};
            pg8::gemm_phase<epi::Bf16Plain, pg8::SchedStd, false>(ring, F.wave, g, S, E); }
          if (G == 256) { if (bx >= 128) for (int task = (bx - 128) * NWAVES + F.wave; task < 1024; task += 128 * NWAVES) gates_task(F, task); }
          else for (int task = bx * NWAVES + F.wave; task < 1024; task += G * NWAVES) gates_task(F, task);
          (void)other_cu; }
    }
    SEAM(3);
    if (IN(4)) for (int rep = 0; rep < REPS(4, 0); ++rep) nsa::nsa_phase(F);
    SEAM(4);
    if (IN(5)) for (int rep = 0; rep < REPS(5, 1); ++rep) {
        pg8::Gemm g{(const char*)(ws + WS_ATT), (const char*)(ws + WS_WNOUT), 2048u, 2048u, 128u, 128u, 1024};
        pg8::SchedStd S; S.init(128, 4, 0, G, bx, (size_t)256 * 2048, (size_t)256 * 2048);
        epi::Res<0> E{args.in[0], ws};
        pg8::gemm_phase<epi::Res<0>, pg8::SchedStd, false>(ring, F.wave, g, S, E);
    }
    SEAM(5);
    if (IN(6)) {
        pg8::Gemm g{(const char*)(ws + WS_X1B), (const char*)(ws + WS_WG0), 2048u, 2048u, 128u, 128u, 1024};
        pg8::SchedStd S; S.init(128, 4, 0, G, bx, (size_t)256 * 2048, (size_t)256 * 2048);
        epi::Ple<0> E{ws, dout};
        pg8::gemm_phase<epi::Ple<0>, pg8::SchedStd, false>(ring, F.wave, g, S, E);
    }
    SEAM(6);
    if (IN(7)) for (int rep = 0; rep < REPS(7, 1); ++rep) {
        pg8::Gemm g{(const char*)(ws + WS_XB), (const char*)(ws + WS_WRIN), 2048u, 2048u, 128u, 128u, 1024};
        { pg8::SchedStd S; S.init(128, 4, 0, G, bx, (size_t)256 * 2048, (size_t)256 * 2048);
          epi::RetQ E{ws};
          pg8::gemm_phase<epi::RetQ, pg8::SchedStd, false>(ring, F.wave, g, S, E);
#if defined(PROBE_P7) && PROBE_P7 == 1
          pg8::gemm_phase<epi::RetQ, pg8::SchedStd, false>(ring, F.wave, g, S, E);
#endif
          }
        { pg8::SchedStd S; S.init(128, 12, 4, G, bx, (size_t)256 * 2048, (size_t)256 * 2048);
          epi::RetKV E{ws, dout};
          pg8::gemm_phase<epi::RetKV, pg8::SchedStd, true>(ring, F.wave, g, S, E);
#if defined(PROBE_P7) && PROBE_P7 == 2
          pg8::gemm_phase<epi::RetKV, pg8::SchedStd, true>(ring, F.wave, g, S, E);
#endif
          }
    }
    SEAM(7);
    if (IN(8)) for (int rep = 0; rep < REPS(8, 0); ++rep) ret::p_phase(F);
    SEAM(8);
    if (IN(9)) for (int rep = 0; rep < REPS(9, 0); ++rep) ret::scan_phase(F, rep == 0);
    SEAM(9);
    if (IN(10)) {
        pg8::Gemm g{(const char*)(ws + WS_XB), (const char*)(ws + WS_WRIN), 2048u, 2048u, 128u, 128u, 1024};
        pg8::SchedStd S; S.init(128, 8, 16, G, bx, (size_t)256 * 2048, (size_t)256 * 2048);
        epi::RetZ E{ws, dout};
        pg8::gemm_phase<epi::RetZ, pg8::SchedStd, false>(ring, F.wave, g, S, E);
    }
    SEAM(10);
    if (IN(11)) for (int rep = 0; rep < REPS(11, 1); ++rep) {
        { pg8::Gemm g{(const char*)dout, (const char*)(ws + WS_WROUT), 4096u, 4096u, 128u, 128u, 2048};
          pg8::SchedStd S; S.init(128, 4, 0, G, bx, (size_t)256 * 4096, (size_t)256 * 4096);
          epi::Res<1> E{nullptr, ws};
          pg8::gemm_phase<epi::Res<1>, pg8::SchedStd, false>(ring, F.wave, g, S, E); }
    }
    SEAM(11);
    if (IN(12)) for (int rep = 0; rep < REPS(12, 1); ++rep) {
        pg8::Gemm g{(const char*)(ws + WS_X3B), (const char*)(ws + WS_WG1), 2048u, 2048u, 128u, 128u, 1024};
        pg8::SchedStd S; S.init(128, 4, 0, G, bx, (size_t)256 * 2048, (size_t)256 * 2048);
        epi::Ple<1> E{ws, dout};
        pg8::gemm_phase<epi::Ple<1>, pg8::SchedStd, false>(ring, F.wave, g, S, E);
    }
#undef IN
#undef SEAM
}

extern "C" void kernel_launch(void* const* d_in, const int* in_sizes, int n_in, void* d_out, int out_size, void* d_ws, size_t ws_size, hipStream_t stream) {
    static int grid = 0;
    if (grid == 0) {
        if (n_in != 19 || out_size != T_TOK * DM || ws_size < WS_END) { fprintf(stderr, "kernel_launch: unexpected problem (n_in %d, out %d, ws %zu)\n", n_in, out_size, ws_size); grid = -1; return; }
        int dev = 0, cus = 0, per_cu = 0;
        (void)hipGetDevice(&dev); (void)hipDeviceGetAttribute(&cus, hipDeviceAttributeMultiprocessorCount, dev);
        if (hipFuncSetAttribute((const void*)mk_fwd, hipFuncAttributeMaxDynamicSharedMemorySize, LDS_BYTES) != hipSuccess) { fprintf(stderr, "kernel_launch: hipFuncSetAttribute failed\n"); grid = -1; return; }
        if (hipOccupancyMaxActiveBlocksPerMultiprocessor(&per_cu, (const void*)mk_fwd, NWAVES * 64, LDS_BYTES) != hipSuccess || per_cu < 1) { fprintf(stderr, "kernel_launch: occupancy query gave %d\n", per_cu); per_cu = 1; }
        (void)hipGetLastError();
        if (per_cu > 1) per_cu = 1;
        grid = cus * per_cu;
    }
    if (grid < 0) return;
    (void)hipMemsetAsync((char*)d_ws + WS_CTL, 0, ZERO_BYTES, stream);
    Args a{};
    for (int i = 0; i < 19; ++i) a.in[i] = (const float*)d_in[i];
    a.out = (unsigned char*)d_out; a.ws = (unsigned char*)d_ws; a.ph_lo = 0; a.ph_hi = 13;
    void* kargs[] = {&a};
    hipError_t e = hipLaunchCooperativeKernel((const void*)mk_fwd, dim3(grid), dim3(NWAVES * 64), kargs, LDS_BYTES, stream);
    if (e != hipSuccess) fprintf(stderr, "kernel_launch: cooperative launch failed: %s (grid %d)\n", hipGetErrorString(e), grid);
}
```

```cpp
#include <hip/hip_runtime.h>
#include <hip/hip_cooperative_groups.h>
#include <cstdio>
#include <cstdint>
namespace cg = cooperative_groups;

#define LAS __attribute__((address_space(3)))
#define GAS __attribute__((address_space(1)))
typedef unsigned short bf16_t;
typedef short bf16x8 __attribute__((ext_vector_type(8)));
typedef short s16x4 __attribute__((ext_vector_type(4)));
typedef float f32x2 __attribute__((ext_vector_type(2)));
typedef float f32x4 __attribute__((ext_vector_type(4)));
typedef float f32x16 __attribute__((ext_vector_type(16)));
typedef unsigned u32x2 __attribute__((ext_vector_type(2)));
typedef unsigned u32x4 __attribute__((ext_vector_type(4)));

constexpr int T_TOK = 32768, SEQ = 4096, NB = 8, DM = 1024;
constexpr float LOG2E = 1.4426950408889634f;
constexpr float RMS_EPS = 1e-6f, GN_EPS = 1e-5f;

typedef __bf16 bf16x2_t __attribute__((ext_vector_type(2)));
__device__ __forceinline__ unsigned cvt_pk_bf16(float lo, float hi) { const f32x2 v = {lo, hi}; const bf16x2_t b = __builtin_convertvector(v, bf16x2_t); return __builtin_bit_cast(unsigned, b); }
__device__ __forceinline__ float bf_lo(unsigned w) { return __uint_as_float(w << 16); }
__device__ __forceinline__ float bf_hi(unsigned w) { return __uint_as_float(w & 0xffff0000u); }
__device__ __forceinline__ int lane_id() { int l; asm volatile("v_mbcnt_lo_u32_b32 %0, -1, 0\n\tv_mbcnt_hi_u32_b32 %0, -1, %0" : "=v"(l)); return l; }
__device__ __forceinline__ const char* uni_ptr(const char* p) {
    const unsigned long long v = (unsigned long long)p; const unsigned lo = __builtin_amdgcn_readfirstlane((unsigned)v), hi = __builtin_amdgcn_readfirstlane((unsigned)(v >> 32));
    return (const char*)(((unsigned long long)hi << 32) | lo); }
__device__ __forceinline__ float fast_rcp(float x) { return __builtin_amdgcn_rcpf(x); }
__device__ __forceinline__ float sigmoidf_(float x) { return fast_rcp(1.0f + __builtin_amdgcn_exp2f(-x * LOG2E)); }
__device__ __forceinline__ float siluf_(float x) { return x * sigmoidf_(x); }

template <class T> __device__ __forceinline__ void st_nt(T* p, const T v) { __builtin_nontemporal_store(v, p); }
namespace pg8 {
constexpr int BM = 256, BK = 64, HALF = 128, HTB = HALF * BK * 2, STAGE_BYTES = 8 * HTB, NXCD = 8, WGM = 8;
__host__ __device__ __forceinline__ int lds_byte(int r, int c) { const int st = (r >> 4) * 2 + (c >> 5), rr = r & 15, cc = c & 31, ob = rr * 64 + cc * 2; return st * 1024 + (ob ^ (((ob >> 9) & 1) << 5)); }
__host__ __device__ __forceinline__ void stage_rc(int b, int& R, int& C) { const int st = b / 1024, sb = b % 1024, swz = sb ^ (((sb >> 9) & 1) << 5); R = (st >> 1) * 16 + swz / 64; C = (st & 1) * 32 + (swz % 64) / 2; }
__host__ __device__ __forceinline__ int perm32(int rho) { const int n = rho >> 4, i = rho & 15; return 8 * (i >> 2) + 4 * n + (i & 3); }

struct Unit { int pm, pn; };
struct Gemm { const char* A; const char* Bt; unsigned lda, ldb; unsigned ksA, ksB; int K; };

struct SchedStd {
    int nM, nN, nwg, G, c, pn0, first, last; size_t a_ts, b_ts;
    __device__ __forceinline__ void init(int nM_, int nN_, int pn0_, int G_, int c_, size_t a_ts_, size_t b_ts_) { nM = nM_; nN = nN_; nwg = nM * nN; G = G_; c = c_; pn0 = pn0_; a_ts = a_ts_; b_ts = b_ts_; first = 0; last = nwg; }
    __device__ __forceinline__ void range(int first_, int last_) { first = first_; last = last_; }
    __device__ __forceinline__ bool next(int i, Unit& u) const {
        const long L = (long)first + (long)i * G + c; if (L >= last) return false;
        int wgid = (int)L; { const int q = nwg / NXCD, r = nwg % NXCD, xcd = wgid % NXCD, off = wgid / NXCD; wgid = (xcd < r ? xcd * (q + 1) : r * (q + 1) + (xcd - r) * q) + off; }
#if defined(SCHED_PNMAJOR)
        u.pm = (int)(L % nM); u.pn = pn0 + (int)(L / nM); return true;
#else
        const int nig = WGM * nN, gid = wgid / nig, fm = gid * WGM, gsz = (nM - fm) < WGM ? (nM - fm) : WGM;
        u.pm = fm + ((wgid % nig) % gsz); u.pn = pn0 + (wgid % nig) / gsz; return true;
#endif
    }
    __device__ __forceinline__ unsigned a_off(const Unit& u) const { return (unsigned)u.pm * (unsigned)a_ts; }
    __device__ __forceinline__ unsigned b_off(const Unit& u) const { return (unsigned)u.pn * (unsigned)b_ts; }
};
struct SchedCmp {
    int G, c; size_t kv_stride_a, kv_stride_b;
    __device__ __forceinline__ bool next(int i, Unit& u) const { const int L = i * G + c; if (L >= 64) return false; u.pm = L; u.pn = 0; return true; }
    __device__ __forceinline__ unsigned a_off(const Unit& u) const { return (unsigned)(u.pm >> 5) * (unsigned)kv_stride_a + (unsigned)((u.pm >> 2) & 7) * (unsigned)(SEQ * 512) + (unsigned)(u.pm & 3) * 128u; }
    __device__ __forceinline__ unsigned b_off(const Unit& u) const { return (unsigned)(u.pm >> 5) * (unsigned)kv_stride_b; }
};

template <class Epi, class Sched, bool SWAP>
__device__ __forceinline__ void gemm_phase(LAS unsigned char* lds, const int wid, const Gemm g, const Sched& S, const Epi& E) {
    const int lane = lane_id(), tid = wid * 64 + lane, wr = wid >> 2, wc = wid & 3, fr = lane & 15, fq = lane >> 4;
    const int nt = g.K / BK;
    unsigned voffA[2], voffB[2];
#pragma unroll
    for (int i = 0; i < 2; ++i) { int R, C; stage_rc(tid * 16 + i * 8192, R, C); const int Rb = (!SWAP) ? ((R & ~31) + perm32(R & 31)) : R;
        voffA[i] = (unsigned)R * g.lda + (unsigned)C * 2u; voffB[i] = (unsigned)Rb * g.ldb + (unsigned)C * 2u; }
    const unsigned ksA = g.ksA, ksB = g.ksB;
    const unsigned hsA = (unsigned)HALF * g.lda, hsB = (unsigned)HALF * g.ldb;
    const unsigned ldsw = (unsigned)wid * 1024u;
    const int aoff = lds_byte(wr * 64 + fr, fq * 8), boff = lds_byte(wc * 32 + fr, fq * 8);
    const __amdgpu_buffer_rsrc_t rsA = __builtin_amdgcn_make_buffer_rsrc((void*)g.A, (short)0, 0x7fffffff, 0x00020000);
    const __amdgpu_buffer_rsrc_t rsB = __builtin_amdgcn_make_buffer_rsrc((void*)g.Bt, (short)0, 0x7fffffff, 0x00020000);
#define PG8_SA(b, h) (((b) * 2 + (h)) * HTB)
#define PG8_SB(b, h) ((4 + (b) * 2 + (h)) * HTB)
#define PG8_STAGE(bufoff, rs, soff, voff) do { _Pragma("unroll") for (int _i = 0; _i < 2; ++_i) \
        __builtin_amdgcn_raw_ptr_buffer_load_lds((rs), (LAS unsigned*)(lds + (bufoff) + ldsw + _i * 8192), 16, (int)(voff)[_i], (int)(soff), 0, 0); } while (0)
#define PG8_LDA(dst, b, h) do { _Pragma("unroll") for (int m = 0; m < 4; ++m) _Pragma("unroll") for (int k = 0; k < 2; ++k) dst[m][k] = *(const LAS bf16x8*)(lds + PG8_SA(b, h) + aoff + m * 2048 + k * 1024); } while (0)
#define PG8_LDB(dst, b, h) do { _Pragma("unroll") for (int n = 0; n < 2; ++n) _Pragma("unroll") for (int k = 0; k < 2; ++k) dst[n][k] = *(const LAS bf16x8*)(lds + PG8_SB(b, h) + boff + n * 2048 + k * 1024); } while (0)
#define PG8_MMA(ai, bj, At, Bt) do { __builtin_amdgcn_s_setprio(1); _Pragma("unroll") for (int m = 0; m < 4; ++m) _Pragma("unroll") for (int n = 0; n < 2; ++n) _Pragma("unroll") for (int k = 0; k < 2; ++k) \
        acc[ai][bj][m][n] = SWAP ? __builtin_amdgcn_mfma_f32_16x16x32_bf16(At[m][k], Bt[n][k], acc[ai][bj][m][n], 0, 0, 0) : __builtin_amdgcn_mfma_f32_16x16x32_bf16(Bt[n][k], At[m][k], acc[ai][bj][m][n], 0, 0, 0); __builtin_amdgcn_s_setprio(0); } while (0)
#define PG8_WAIT_V(n) asm volatile("s_waitcnt vmcnt(" #n ")" ::: "memory")
#define PG8_WAIT_L(n) asm volatile("s_waitcnt lgkmcnt(" #n ")" ::: "memory")
#define PG8_BAR __builtin_amdgcn_s_barrier()
#define PG8_SCHED __builtin_amdgcn_sched_barrier(0)
    Unit cur, nxt; int ui = 0;
    if (!S.next(0, cur)) return;
    f32x4 acc[2][2][4][2];
#pragma unroll
    for (int a = 0; a < 2; ++a)
#pragma unroll
        for (int b = 0; b < 2; ++b)
#pragma unroll
            for (int m = 0; m < 4; ++m)
#pragma unroll
                for (int n = 0; n < 2; ++n) acc[a][b][m][n] = (f32x4){0.f, 0.f, 0.f, 0.f};
    bf16x8 At[4][2], B0[2][2], B1[2][2];
    unsigned cA = S.a_off(cur), cB = S.b_off(cur);
    PG8_STAGE(PG8_SB(0, 0), rsB, cB, voffB); PG8_STAGE(PG8_SB(0, 1), rsB, cB + hsB, voffB); PG8_STAGE(PG8_SA(0, 0), rsA, cA, voffA); PG8_STAGE(PG8_SA(0, 1), rsA, cA + hsA, voffA);
    if (wr == 1) PG8_BAR;
    PG8_WAIT_V(2); PG8_BAR;
    PG8_STAGE(PG8_SB(1, 0), rsB, cB + ksB, voffB); PG8_STAGE(PG8_SA(1, 0), rsA, cA + ksA, voffA); PG8_STAGE(PG8_SB(1, 1), rsB, cB + hsB + ksB, voffB);
    PG8_WAIT_V(6); PG8_BAR;
    for (;;) {
        const bool has_next = S.next(ui + 1, nxt);
        const unsigned nA = has_next ? S.a_off(nxt) : cA, nB = has_next ? S.b_off(nxt) : cB;
        for (int t = 0; t < nt; t += 2) {
            const bool last = (t == nt - 2);
            const unsigned a1 = cA + (unsigned)(t + 1) * ksA;
            const unsigned a2 = last ? nA : cA + (unsigned)(t + 2) * ksA, b2 = last ? nB : cB + (unsigned)(t + 2) * ksB;
            const unsigned a3 = a2 + ksA, b3 = b2 + ksB;
            PG8_LDB(B0, 0, 0); PG8_LDB(B1, 0, 1); PG8_SCHED; PG8_LDA(At, 0, 0); PG8_STAGE(PG8_SA(1, 1), rsA, a1 + hsA, voffA);
            PG8_WAIT_V(8); PG8_WAIT_L(0); PG8_BAR; PG8_MMA(0, 0, At, B0); PG8_MMA(0, 1, At, B1); PG8_BAR; PG8_SCHED;
            PG8_LDA(At, 0, 1); PG8_STAGE(PG8_SB(0, 0), rsB, b2, voffB); PG8_STAGE(PG8_SB(0, 1), rsB, b2 + hsB, voffB); PG8_STAGE(PG8_SA(0, 0), rsA, a2, voffA);
            PG8_WAIT_V(8); PG8_WAIT_L(0); PG8_BAR; PG8_MMA(1, 0, At, B0); PG8_MMA(1, 1, At, B1); PG8_BAR; PG8_SCHED;
            PG8_LDB(B0, 1, 0); PG8_LDB(B1, 1, 1); PG8_SCHED; PG8_LDA(At, 1, 0); PG8_STAGE(PG8_SA(0, 1), rsA, a2 + hsA, voffA);
            PG8_WAIT_V(8); PG8_WAIT_L(0); PG8_BAR; PG8_MMA(0, 0, At, B0); PG8_MMA(0, 1, At, B1); PG8_BAR; PG8_SCHED;
            PG8_LDA(At, 1, 1); PG8_STAGE(PG8_SB(1, 0), rsB, b3, voffB); PG8_STAGE(PG8_SB(1, 1), rsB, b3 + hsB, voffB); PG8_STAGE(PG8_SA(1, 0), rsA, a3, voffA);
            PG8_WAIT_V(8); PG8_WAIT_L(0); PG8_BAR; PG8_MMA(1, 0, At, B0); PG8_MMA(1, 1, At, B1); PG8_BAR; PG8_SCHED;
        }
        if (wr == 0) PG8_BAR;
        E(acc, cur, wr, wc, fr, fq);
#if defined(PROBE_EPI)
        if (Epi::ID == PROBE_EPI) { asm volatile("" ::: "memory"); E(acc, cur, wr, wc, fr, fq); }
#endif
#if defined(PROBE_ST)
        if constexpr (Epi::ID == 30) { if (PROBE_ST != 4 || (blockIdx.x & 8)) { asm volatile("" ::: "memory"); E.probe(acc, cur, wr, wc, fr, fq); } }
#endif
        if (!has_next) break;
#pragma unroll
        for (int a = 0; a < 2; ++a)
#pragma unroll
            for (int b = 0; b < 2; ++b)
#pragma unroll
                for (int m = 0; m < 4; ++m)
#pragma unroll
                    for (int n = 0; n < 2; ++n) acc[a][b][m][n] = (f32x4){0.f, 0.f, 0.f, 0.f};
        cur = nxt; cA = nA; cB = nB; ++ui;
        if (wr == 1) PG8_BAR;
    }
    PG8_WAIT_V(0);
    PG8_BAR;
#undef PG8_SA
#undef PG8_SB
#undef PG8_STAGE
#undef PG8_LDA
#undef PG8_LDB
#undef PG8_MMA
#undef PG8_WAIT_V
#undef PG8_WAIT_L
#undef PG8_BAR
#undef PG8_SCHED
}
typedef f32x4 Acc[2][2][4][2];
}

constexpr size_t MiB = 1u << 20;
constexpr size_t WS_CTL = 0, WS_ROWSC0 = 1 * MiB, WS_ROWSS1 = 1 * MiB + 128 * 1024, WS_CBIAS = 1 * MiB + 256 * 1024, WS_GAINS = 1 * MiB + 264 * 1024, WS_STATS = 2 * MiB, ZERO_BYTES = 3 * MiB;
constexpr size_t WS_WRIN = 3 * MiB, WS_WROUT = 15 * MiB, WS_WG1 = 19 * MiB, WS_WP1 = 21 * MiB;
constexpr size_t WS_X2 = 22 * MiB;
constexpr size_t WS_XB = 150 * MiB;
constexpr size_t WS_PB0 = 214 * MiB;
constexpr size_t WS_KC = 230 * MiB, WS_VC = 246 * MiB, WS_KS = 262 * MiB, WS_VS = 278 * MiB, WS_KW = 294 * MiB, WS_VW = 310 * MiB;
constexpr size_t WS_G = 326 * MiB, WS_E0 = 332 * MiB, WS_ATT = 396 * MiB;
constexpr size_t WS_COS = 470 * MiB, WS_SIN = 472 * MiB, WS_COST = 102 * MiB, WS_SINT = 104 * MiB;
constexpr size_t WS_WNIN = 474 * MiB, WS_WNOUT = 482 * MiB, WS_WG0 = 484 * MiB, WS_WP0 = 486 * MiB, WS_WC1K = 487 * MiB, WS_WC1V = 488 * MiB, WS_WC2K = 489 * MiB, WS_WC2V = 489 * MiB + 65536, WS_WGT = 490 * MiB;
constexpr size_t WS_HID = 492 * MiB, WS_KCC = 500 * MiB, WS_VCC = 501 * MiB;
constexpr size_t WS_X1B = 230 * MiB;
constexpr size_t WS_QP = 214 * MiB, WS_KTP = 278 * MiB, WS_VT = 342 * MiB, WS_PT = 470 * MiB, WS_PB1 = 22 * MiB;
constexpr size_t WS_X3B = 342 * MiB, WS_E1 = 38 * MiB;
constexpr size_t WS_END = 512 * MiB;
constexpr size_t DO_Q = 0, DO_Z = 64 * MiB;
constexpr int CW_BAR = 4096;
constexpr int RING_BYTES = 131072, LDSCTL_OFF = 150016, MISC_OFF = LDSCTL_OFF + 320, LDS_GATE = 151552, LDS_BYTES = 154624;
constexpr int NWAVES = 8;


namespace epi {
using pg8::Unit; using pg8::Acc;
__device__ __forceinline__ u32x4 pack8(const f32x4& a, const f32x4& b) { u32x4 w; w.x = cvt_pk_bf16(a[0], a[1]); w.y = cvt_pk_bf16(a[2], a[3]); w.z = cvt_pk_bf16(b[0], b[1]); w.w = cvt_pk_bf16(b[2], b[3]); return w; }
__device__ __forceinline__ void unpack8(const u32x4& w, f32x4& a, f32x4& b) { a[0] = bf_lo(w.x); a[1] = bf_hi(w.x); a[2] = bf_lo(w.y); a[3] = bf_hi(w.y); b[0] = bf_lo(w.z); b[1] = bf_hi(w.z); b[2] = bf_lo(w.w); b[3] = bf_hi(w.w); }
__device__ __forceinline__ float dot4(const f32x4& a) { return (a[0] * a[0] + a[1] * a[1]) + (a[2] * a[2] + a[3] * a[3]); }

struct Bf16Plain {
    static constexpr int ID = 10;
    static constexpr bool PERM = true;
    bf16_t* O; int ldc; int col0;
    __device__ __forceinline__ void operator()(const Acc& acc, const Unit& u, int wr, int wc, int fr, int fq) const {
#pragma unroll
        for (int ai = 0; ai < 2; ++ai)
#pragma unroll
            for (int m = 0; m < 4; ++m) { const int row = u.pm * 256 + ai * 128 + wr * 64 + m * 16 + fr; bf16_t* rp = O + (size_t)row * ldc + (u.pn * 256 - col0 + wc * 32 + fq * 8);
#pragma unroll
                for (int bj = 0; bj < 2; ++bj) st_nt((u32x4*)(rp + bj * 128), (u32x4)(pack8(acc[ai][bj][m][0], acc[ai][bj][m][1]))); }
    }
};
struct Cmp1 {
    static constexpr int ID = 20;
    static constexpr bool PERM = true;
    unsigned char* ws;
    __device__ __forceinline__ void operator()(const Acc& acc, const Unit& u, int wr, int wc, int fr, int fq) const {
        bf16_t* H = (bf16_t*)(ws + WS_HID);
        const float* bb = (const float*)(ws + WS_CBIAS) + (u.pm >> 5) * 256;
        f32x4 bv[2][2];
#pragma unroll
        for (int bj = 0; bj < 2; ++bj)
#pragma unroll
            for (int n = 0; n < 2; ++n) bv[bj][n] = *(const f32x4*)(bb + bj * 128 + wc * 32 + fq * 8 + n * 4);
#pragma unroll
        for (int ai = 0; ai < 2; ++ai)
#pragma unroll
            for (int m = 0; m < 4; ++m) { const int row = u.pm * 256 + ai * 128 + wr * 64 + m * 16 + fr; bf16_t* rp = H + (size_t)row * 256 + (wc * 32 + fq * 8);
#pragma unroll
                for (int bj = 0; bj < 2; ++bj) { f32x4 v0 = acc[ai][bj][m][0] + bv[bj][0], v1 = acc[ai][bj][m][1] + bv[bj][1];
#pragma unroll
                    for (int x = 0; x < 4; ++x) { v0[x] = siluf_(v0[x]); v1[x] = siluf_(v1[x]); }
                    *(u32x4*)(rp + bj * 128) = pack8(v0, v1); } }
    }
};
struct NsaIn {
    static constexpr int ID = 30;
    static constexpr bool PERM = true;
    unsigned char* ws; unsigned char* dout;
    __device__ __forceinline__ void operator()(const Acc& acc, const Unit& u, int wr, int wc, int fr, int fq) const {
        const int pn = u.pn;
        const float* rowscale = (const float*)(ws + WS_ROWSC0); const float* gains = (const float*)(ws + WS_GAINS);
        const float *q_g = gains, *ks_g = gains + 128, *kw_g = gains + 192;
        bf16_t* Q = (bf16_t*)(dout + DO_Q); bf16_t* Z = (bf16_t*)(dout + DO_Z);
        const bool normed = (pn < 4) || pn == 6 || pn == 8;
        f32x4 gq[2][2];
        if (normed) { const float* gp = (pn < 4) ? q_g : (pn == 6 ? ks_g : kw_g); const float sc = (pn < 4) ? 0.125f * LOG2E : 1.0f;
#pragma unroll
            for (int bj = 0; bj < 2; ++bj)
#pragma unroll
                for (int n = 0; n < 2; ++n) gq[bj][n] = *(const f32x4*)(gp + bj * 32 + fq * 8 + n * 4) * sc; }
        bf16_t* dst; int ldc, cbase;
        if (pn < 4) { dst = Q; ldc = 1024; cbase = pn * 256; }
        else if (pn < 10) { dst = (bf16_t*)(ws + WS_KC + (size_t)(pn - 4) * (16 * MiB)); ldc = 256; cbase = 0; }
        else { dst = Z; ldc = 1024; cbase = (pn - 10) * 256; }
        float rsc[8];
#pragma unroll
        for (int i = 0; i < 8; ++i) rsc[i] = rowscale[u.pm * 256 + (i >> 2) * 128 + wr * 64 + (i & 3) * 16 + fr];
#pragma unroll
        for (int ai = 0; ai < 2; ++ai)
#pragma unroll
            for (int m = 0; m < 4; ++m) {
                const int row = u.pm * 256 + ai * 128 + wr * 64 + m * 16 + fr; const float s = rsc[ai * 4 + m];
                f32x4 v[2][2];
#pragma unroll
                for (int bj = 0; bj < 2; ++bj)
#pragma unroll
                    for (int n = 0; n < 2; ++n) v[bj][n] = acc[ai][bj][m][n] * s;
                if (normed) { float ss = (dot4(v[0][0]) + dot4(v[0][1])) + (dot4(v[1][0]) + dot4(v[1][1]));
                    ss += __shfl_xor(ss, 16); ss += __shfl_xor(ss, 32);
                    const float rn = __builtin_amdgcn_rsqf(ss * (1.0f / 64.0f) + RMS_EPS);
#pragma unroll
                    for (int bj = 0; bj < 2; ++bj)
#pragma unroll
                        for (int n = 0; n < 2; ++n) v[bj][n] = v[bj][n] * rn * gq[bj][n]; }
                else if (pn >= 10) {
#pragma unroll
                    for (int bj = 0; bj < 2; ++bj)
#pragma unroll
                        for (int n = 0; n < 2; ++n)
#pragma unroll
                            for (int x = 0; x < 4; ++x) v[bj][n][x] = siluf_(v[bj][n][x]); }
                bf16_t* rp = dst + (size_t)row * ldc + cbase + wc * 64 + fq * 8;
#pragma unroll
                for (int bj = 0; bj < 2; ++bj) st_nt((u32x4*)(rp + bj * 32), (u32x4)(pack8(v[bj][0], v[bj][1])));
            }
    }
#if defined(PROBE_ST)
    __device__ __forceinline__ void probe(const Acc& acc, const Unit& u, int wr, int wc, int fr, int fq) const {
        bf16_t* base = (bf16_t*)(ws + WS_E1);
#pragma unroll
        for (int ai = 0; ai < 2; ++ai)
#pragma unroll
            for (int m = 0; m < 4; ++m) {
                const int row = (PROBE_ST == 1) ? (int)blockIdx.x * 16 + fr : u.pm * 256 + ai * 128 + wr * 64 + m * 16 + fr;
                bf16_t* rp = (PROBE_ST >= 5) ? base + ((size_t)(u.pm * 4 + (u.pn & 3)) * 65536) + (size_t)((((wr * 4 + wc) * 2 + ai) * 4 + m) * 2) * 512 + (fq * 16 + fr) * 8
                                             : base + (size_t)row * 1024 + (u.pn & 3) * 256 + wc * 64 + fq * 8;
#pragma unroll
                for (int bj = 0; bj < 2; ++bj) { u32x4* dp = (u32x4*)(rp + bj * (PROBE_ST >= 5 ? 512 : 32));
                    if (PROBE_ST == 3 || PROBE_ST == 6) __builtin_nontemporal_store(pack8(acc[ai][bj][m][0], acc[ai][bj][m][1]), dp);
                    else *dp = pack8(acc[ai][bj][m][0], acc[ai][bj][m][1]); }
            }
    }
#endif
};
template <int LAYER> struct Res {
    static constexpr int ID = 40 + LAYER;
    static constexpr bool PERM = true;
    const float* x; unsigned char* ws;
    __device__ __forceinline__ void operator()(const Acc& acc, const Unit& u, int wr, int wc, int fr, int fq) const {
        const bf16_t* xinb = (const bf16_t*)(ws + WS_XB); bf16_t* xb = (bf16_t*)(ws + (LAYER == 0 ? WS_X1B : WS_X3B));
        const unsigned base = (unsigned)(u.pm * 256 + wr * 64 + fr) * 1024u + (unsigned)(u.pn * 256 + wc * 32 + fq * 8);
        f32x4 ra[2][4], rc[2][4]; u32x4 rb[2][4];
#define RES_ISSUE(k) { _Pragma("unroll") for (int mm = 0; mm < 2; ++mm) _Pragma("unroll") for (int bj = 0; bj < 2; ++bj) { \
            const unsigned off = base + (unsigned)((((k) >> 1) * 128 + (((k) & 1) * 2 + mm) * 16) * 1024 + bj * 128); \
            if (LAYER == 0) { ra[(k) & 1][mm * 2 + bj] = *(const f32x4*)(x + off); rc[(k) & 1][mm * 2 + bj] = *(const f32x4*)(x + off + 4); } \
            else rb[(k) & 1][mm * 2 + bj] = *(const u32x4*)(xinb + off); } }
        RES_ISSUE(0)
#pragma unroll
        for (int k = 0; k < 4; ++k) {
            if (k < 3) RES_ISSUE(k + 1)
            const int ai = k >> 1;
#pragma unroll
            for (int mm = 0; mm < 2; ++mm) { const int m = (k & 1) * 2 + mm;
#pragma unroll
                for (int bj = 0; bj < 2; ++bj) { const unsigned off = base + (unsigned)((ai * 128 + m * 16) * 1024 + bj * 128);
                    f32x4 r0, r1;
                    if (LAYER == 0) { r0 = ra[k & 1][mm * 2 + bj]; r1 = rc[k & 1][mm * 2 + bj]; } else unpack8(rb[k & 1][mm * 2 + bj], r0, r1);
                    *(u32x4*)(xb + off) = pack8(r0 + acc[ai][bj][m][0], r1 + acc[ai][bj][m][1]); } }
        }
#undef RES_ISSUE
    }
};
template <int LAYER> struct Ple {
    static constexpr int ID = 50 + LAYER;
    static constexpr bool PERM = true; static constexpr bool NEXT = (LAYER == 0);
    unsigned char* ws; unsigned char* dout;
    __device__ __forceinline__ void operator()(const Acc& acc, const Unit& u, int wr, int wc, int fr, int fq) const {
        const bf16_t* xinb = (const bf16_t*)(ws + (LAYER == 0 ? WS_X1B : WS_X3B)); const bf16_t* E = (const bf16_t*)(ws + (LAYER == 0 ? WS_E0 : WS_E1));
        float* xout = (float*)dout; bf16_t* xb = (bf16_t*)(ws + WS_XB); float* rowss = (float*)(ws + WS_ROWSS1);
        const unsigned base = (unsigned)(u.pm * 256 + wr * 64 + fr) * 1024u + (unsigned)(u.pn * 256 + wc * 32 + fq * 8);
        u32x4 eb[2][4], rb[2][4];
#define PLE_ISSUE(k) { _Pragma("unroll") for (int mm = 0; mm < 2; ++mm) _Pragma("unroll") for (int bj = 0; bj < 2; ++bj) { \
            const unsigned off = base + (unsigned)((((k) >> 1) * 128 + (((k) & 1) * 2 + mm) * 16) * 1024 + bj * 128); \
            eb[(k) & 1][mm * 2 + bj] = *(const u32x4*)(E + off); rb[(k) & 1][mm * 2 + bj] = *(const u32x4*)(xinb + off); } }
        PLE_ISSUE(0)
#pragma unroll
        for (int k = 0; k < 4; ++k) {
            if (k < 3) PLE_ISSUE(k + 1)
            const int ai = k >> 1;
#pragma unroll
            for (int mm = 0; mm < 2; ++mm) { const int m = (k & 1) * 2 + mm; float ss = 0.f;
#pragma unroll
                for (int bj = 0; bj < 2; ++bj) { const unsigned off = base + (unsigned)((ai * 128 + m * 16) * 1024 + bj * 128);
                    f32x4 e0, e1, r0, r1; unpack8(eb[k & 1][mm * 2 + bj], e0, e1); unpack8(rb[k & 1][mm * 2 + bj], r0, r1);
                    f32x4 g0 = acc[ai][bj][m][0], g1 = acc[ai][bj][m][1];
#pragma unroll
                    for (int x = 0; x < 4; ++x) { g0[x] = sigmoidf_(g0[x]); g1[x] = sigmoidf_(g1[x]); }
                    const f32x4 o0 = r0 + g0 * e0, o1 = r1 + g1 * e1;
                    if (NEXT) { *(u32x4*)(xb + off) = pack8(o0, o1); ss += dot4(o0) + dot4(o1); }
                    else { st_nt((f32x4*)(xout + off), (f32x4)(o0)); st_nt((f32x4*)(xout + off + 4), (f32x4)(o1)); } }
                if (NEXT) { ss += __shfl_xor(ss, 16); ss += __shfl_xor(ss, 32); if (fq == 0) atomicAdd(rowss + (u.pm * 256 + ai * 128 + wr * 64 + m * 16 + fr), ss); } }
        }
#undef PLE_ISSUE
    }
};

__device__ __forceinline__ size_t qt_index(int b, int tok, int h, int d) { return ((((size_t)(b * 128 + (tok >> 5)) * 4 + h) * 16 + (d >> 4)) * 2 + ((d >> 3) & 1)) * 256 + (tok & 31) * 8 + (d & 7); }
__device__ __forceinline__ size_t tt_index(int bh, int nblk, int row, int tok) { return ((((size_t)bh * nblk + (row >> 5)) * 256 + (tok >> 4)) * 2 + ((tok >> 3) & 1)) * 256 + (row & 31) * 8 + (tok & 7); }
__device__ __forceinline__ float log2_gamma(int h) { return __log2f(1.0f - __builtin_amdgcn_exp2f(-5.0f - (float)h)); }
struct RetQ {
    static constexpr int ID = 60;
    static constexpr bool PERM = true;
    unsigned char* ws;
    __device__ __forceinline__ void operator()(const Acc& acc, const Unit& u, int wr, int wc, int fr, int fq) const {
        const float* rowss = (const float*)(ws + WS_ROWSS1); const float* cosT = (const float*)(ws + WS_COS); const float* sinT = (const float*)(ws + WS_SIN); bf16_t* Qp = (bf16_t*)(ws + WS_QP);
        const int h = u.pn; const float l2g = log2_gamma(h);
        const int rbase = u.pm * 256 + wr * 64 + fr; const int d0 = wc * 32 + fq * 8;
        f32x4 cb[2][4], sb[2][4]; float rs[2][2];
#define RQ_ISSUE(k) { _Pragma("unroll") for (int mm = 0; mm < 2; ++mm) { const int row = rbase + ((k) >> 1) * 128 + (((k) & 1) * 2 + mm) * 16; const int pos = row & (SEQ - 1); \
            rs[(k) & 1][mm] = rowss[row]; \
            _Pragma("unroll") for (int n = 0; n < 2; ++n) { cb[(k) & 1][mm * 2 + n] = *(const f32x4*)(cosT + (size_t)pos * 128 + d0 + n * 4); sb[(k) & 1][mm * 2 + n] = *(const f32x4*)(sinT + (size_t)pos * 128 + d0 + n * 4); } } }
        RQ_ISSUE(0)
#pragma unroll
        for (int k = 0; k < 4; ++k) {
            if (k < 3) RQ_ISSUE(k + 1)
            const int ai = k >> 1;
#pragma unroll
            for (int mm = 0; mm < 2; ++mm) { const int m = (k & 1) * 2 + mm; const int row = rbase + ai * 128 + m * 16;
                const float s = __builtin_amdgcn_rsqf(rs[k & 1][mm] * (1.0f / 1024.0f) + RMS_EPS);
                const int pos = row & (SEQ - 1), il = row & 127; const float dec = __builtin_amdgcn_exp2f((float)(il + 1) * l2g) * s;
                f32x4 y1[2], y2[2];
#pragma unroll
                for (int n = 0; n < 2; ++n) { const f32x4 c4 = cb[k & 1][mm * 2 + n], s4 = sb[k & 1][mm * 2 + n];
                    const f32x4 x1 = acc[ai][0][m][n], x2 = acc[ai][1][m][n]; y1[n] = (x1 * c4 - x2 * s4) * dec; y2[n] = (x1 * s4 + x2 * c4) * dec; }
                bf16_t* rp = Qp + qt_index(row >> 12, pos, h, d0);
                st_nt((u32x4*)rp, (u32x4)(pack8(y1[0], y1[1]))); st_nt((u32x4*)(rp + 8 * 512), (u32x4)(pack8(y2[0], y2[1]))); }
        }
#undef RQ_ISSUE
    }
};
struct RetKV {
    static constexpr int ID = 70;
    static constexpr bool PERM = false;
    unsigned char* ws; unsigned char* dout;
    __device__ __forceinline__ void operator()(const Acc& acc, const Unit& u, int wr, int wc, int fr, int fq) const {
        const float* rowss = (const float*)(ws + WS_ROWSS1); const float* cosT = (const float*)(ws + WS_COST); const float* sinT = (const float*)(ws + WS_SINT);
        bf16_t* Kp = (bf16_t*)dout; bf16_t* Ktp = (bf16_t*)(ws + WS_KTP); bf16_t* Vt = (bf16_t*)(ws + WS_VT);
        const int pn = u.pn; const bool isk = pn < 8; const int h = isk ? pn - 4 : (pn - 8) >> 1; const int ebase = isk ? 0 : ((pn - 8) & 1) * 256;
        const float l2g = log2_gamma(h);
#pragma unroll
        for (int ai = 0; ai < 2; ++ai)
#pragma unroll
            for (int m = 0; m < 4; ++m) { const int row0 = u.pm * 256 + ai * 128 + wr * 64 + m * 16 + fq * 4; const int b = row0 >> 12, t0 = row0 & (SEQ - 1);
                f32x4 s4 = *(const f32x4*)(rowss + row0);
#pragma unroll
                for (int x = 0; x < 4; ++x) s4[x] = __builtin_amdgcn_rsqf(s4[x] * (1.0f / 1024.0f) + RMS_EPS);
                if (isk) {
                    f32x4 kd;
#pragma unroll
                    for (int x = 0; x < 4; ++x) kd[x] = __builtin_amdgcn_exp2f((float)(127 - ((t0 + x) & 127)) * l2g) * 0.0625f * s4[x];
#pragma unroll
                    for (int n = 0; n < 2; ++n) { const int d = wc * 32 + n * 16 + fr;
                        const f32x4 c4 = *(const f32x4*)(cosT + (size_t)d * SEQ + t0), s4r = *(const f32x4*)(sinT + (size_t)d * SEQ + t0);
                        const f32x4 x1 = acc[ai][0][m][n], x2 = acc[ai][1][m][n];
                        const f32x4 y1 = (x1 * c4 - x2 * s4r) * kd, y2 = (x1 * s4r + x2 * c4) * kd;
                        u32x2 w1, w2; w1.x = cvt_pk_bf16(y1[0], y1[1]); w1.y = cvt_pk_bf16(y1[2], y1[3]); w2.x = cvt_pk_bf16(y2[0], y2[1]); w2.y = cvt_pk_bf16(y2[2], y2[3]);
                        bf16_t* tp = Ktp + tt_index(b * 4 + h, 8, d, t0); st_nt((u32x2*)tp, (u32x2)(w1)); st_nt((u32x2*)(tp + (size_t)4 * 256 * 512), (u32x2)(w2));
                        bf16_t* rp = Kp + qt_index(b, t0, h, d);
                        rp[0] = (bf16_t)(w1.x & 0xffffu); rp[8] = (bf16_t)(w1.x >> 16); rp[16] = (bf16_t)(w1.y & 0xffffu); rp[24] = (bf16_t)(w1.y >> 16);
                        rp[8 * 512] = (bf16_t)(w2.x & 0xffffu); rp[8 * 512 + 8] = (bf16_t)(w2.x >> 16); rp[8 * 512 + 16] = (bf16_t)(w2.y & 0xffffu); rp[8 * 512 + 24] = (bf16_t)(w2.y >> 16); }
                } else {
#pragma unroll
                    for (int bj = 0; bj < 2; ++bj)
#pragma unroll
                        for (int n = 0; n < 2; ++n) { const int e = ebase + bj * 128 + wc * 32 + n * 16 + fr; const f32x4 v = acc[ai][bj][m][n] * s4;
                            u32x2 w; w.x = cvt_pk_bf16(v[0], v[1]); w.y = cvt_pk_bf16(v[2], v[3]);
                            st_nt((u32x2*)(Vt + tt_index(b * 4 + h, 16, e, t0)), (u32x2)(w)); }
                }
                if (m & 1) asm volatile("" ::: "memory"); }
    }
};
struct RetZ {
    static constexpr int ID = 80;
    static constexpr bool PERM = true;
    unsigned char* ws; unsigned char* dout;
    __device__ __forceinline__ void operator()(const Acc& acc, const Unit& u, int wr, int wc, int fr, int fq) const {
        const float* rowss = (const float*)(ws + WS_ROWSS1); const float* stats = (const float*)(ws + WS_STATS); bf16_t* O = (bf16_t*)dout;
        const int zt = u.pn - 16, h = zt >> 1;
        const int rbase = u.pm * 256 + wr * 64 + fr;
        const unsigned obase = (unsigned)rbase * 2048u + (unsigned)(zt * 256 + wc * 32 + fq * 8);
        const float* sp0 = stats + ((size_t)((rbase >> 12) * 4 + h) * 2) * SEQ + (rbase & (SEQ - 1));
        u32x4 ob[2][4]; float rs[2][2], s0[2][2], s1[2][2];
#define RZ_ISSUE(k) { _Pragma("unroll") for (int mm = 0; mm < 2; ++mm) { const int ro = ((k) >> 1) * 128 + (((k) & 1) * 2 + mm) * 16; \
            rs[(k) & 1][mm] = rowss[rbase + ro]; s0[(k) & 1][mm] = sp0[ro]; s1[(k) & 1][mm] = sp0[SEQ + ro]; \
            _Pragma("unroll") for (int bj = 0; bj < 2; ++bj) ob[(k) & 1][mm * 2 + bj] = *(const u32x4*)(O + obase + (unsigned)(ro * 2048 + bj * 128)); } }
        RZ_ISSUE(0)
#pragma unroll
        for (int k = 0; k < 4; ++k) {
            if (k < 3) RZ_ISSUE(k + 1)
            const int ai = k >> 1;
#pragma unroll
            for (int mm = 0; mm < 2; ++mm) { const int m = (k & 1) * 2 + mm; const int ro = ai * 128 + m * 16;
                const float s = __builtin_amdgcn_rsqf(rs[k & 1][mm] * (1.0f / 1024.0f) + RMS_EPS);
                const float mu = s0[k & 1][mm] * (1.0f / 512.0f); float var = s1[k & 1][mm] * (1.0f / 512.0f) - mu * mu; var = var > 0.f ? var : 0.f; const float rstd = __builtin_amdgcn_rsqf(var + GN_EPS);
#pragma unroll
                for (int bj = 0; bj < 2; ++bj) { bf16_t* p = O + obase + (unsigned)(ro * 2048 + bj * 128);
                    f32x4 o0, o1; unpack8(ob[k & 1][mm * 2 + bj], o0, o1); f32x4 z0 = acc[ai][bj][m][0] * s, z1 = acc[ai][bj][m][1] * s;
#pragma unroll
                    for (int x = 0; x < 4; ++x) { z0[x] = siluf_(z0[x]); z1[x] = siluf_(z1[x]); }
                    o0 = (o0 - mu) * rstd * z0; o1 = (o1 - mu) * rstd * z1; *(u32x4*)p = pack8(o0, o1); } }
        }
#undef RZ_ISSUE
    }
};
}
#define RLX_AGENT __ATOMIC_RELAXED, __HIP_MEMORY_SCOPE_AGENT
#define LDS_WAIT() asm volatile("s_waitcnt lgkmcnt(0)" ::: "memory")
#define VM_WAIT() asm volatile("s_waitcnt vmcnt(0)" ::: "memory")

#define XB_TMO      128
#define XB_XCNT(j)  (256  + 64 * (j))
#define XB_XSUB(j)  (1280 + 64 * (j))
#define XB_XGEN(j)  (2304 + 64 * (j))
#define XB_TOP      3328
#define XB_TOPGEN   3392
#define XCD_BAR_WORDS 3456
#define XB_SPIN_CAP (1u << 23)
__device__ __forceinline__ unsigned xb_ld(unsigned* p)              { return __hip_atomic_load(p, __ATOMIC_RELAXED, __HIP_MEMORY_SCOPE_AGENT); }
__device__ __forceinline__ unsigned xb_add(unsigned* p, unsigned v) { return __hip_atomic_fetch_add(p, v, __ATOMIC_RELAXED, __HIP_MEMORY_SCOPE_AGENT); }
__device__ __forceinline__ unsigned xb_xcc_id() { return (unsigned)__builtin_amdgcn_s_getreg((3 << 11) | 20) & 0xFu; }
#define XB_SPIN(cond, bar) do { unsigned _sp = 0; while (cond) { __builtin_amdgcn_s_sleep(1); \
    if ((++_sp & 255u) == 0u) { if (xb_ld(&(bar)[XB_TMO])) break; if (_sp > XB_SPIN_CAP) { atomicAdd(&(bar)[XB_TMO], 1u); break; } } } } while (0)
struct XcdBarrier { unsigned* bar; unsigned x; volatile LAS unsigned* st; int wave; };
__device__ __forceinline__ XcdBarrier xcd_barrier_post(unsigned* bar, volatile LAS unsigned* st, int wave) {
    XcdBarrier b; b.bar = bar; b.x = xb_xcc_id(); b.st = st; b.wave = wave;
    if (wave == 0 && lane_id() == 0) (void)xb_add(&bar[XB_XCNT(b.x)], 1u);
    return b;
}
__device__ __forceinline__ void xcd_barrier_complete(unsigned* bar, unsigned x, unsigned& nloc, unsigned& nx) {
    const unsigned G = gridDim.x * gridDim.y * gridDim.z;
    unsigned sum, cnt, mine, sp = 0u;
    for (;;) {
        sum = 0u; cnt = 0u; mine = 0u;
#pragma unroll
        for (unsigned j = 0; j < 16; ++j) { const unsigned c = xb_ld(&bar[XB_XCNT(j)]); sum += c; cnt += (c > 0u) ? 1u : 0u; mine = (j == x) ? c : mine; }
        if (sum == G) break;
        __builtin_amdgcn_s_sleep(1);
        if ((++sp & 255u) == 0u) { if (xb_ld(&bar[XB_TMO])) break; if (sp > XB_SPIN_CAP) { atomicAdd(&bar[XB_TMO], 1u); break; } }
    }
    nloc = mine > 0u ? mine : 1u; nx = cnt > 0u ? cnt : 1u;
}
__device__ __forceinline__ void xcd_barrier(const XcdBarrier& b) {
    asm volatile("s_waitcnt vmcnt(0)" ::: "memory");
    __syncthreads();
    if (b.wave == 0 && lane_id() == 0) {
        unsigned* bar = b.bar;
        __builtin_amdgcn_s_waitcnt(0);
        unsigned nloc = b.st[0], nx = b.st[1];
        if (nloc == 0u) { xcd_barrier_complete(bar, b.x, nloc, nx); b.st[0] = nloc; b.st[1] = nx; }
        const unsigned old = xb_add(&bar[XB_XSUB(b.x)], 1u);
        const unsigned gen = old / nloc;
        if (old + 1u == (gen + 1u) * nloc) {
            __builtin_amdgcn_fence(__ATOMIC_RELEASE, "agent");
            asm volatile("s_waitcnt vmcnt(0)" ::: "memory");
            const unsigned og = xb_add(&bar[XB_TOP], 1u);
            const unsigned tg = og / nx;
            if (og + 1u == (tg + 1u) * nx) xb_add(&bar[XB_TOPGEN], 1u);
            else XB_SPIN(xb_ld(&bar[XB_TOPGEN]) == tg, bar);
            __builtin_amdgcn_fence(__ATOMIC_ACQUIRE, "agent");
            xb_add(&bar[XB_XGEN(b.x)], 1u);
            asm volatile("s_waitcnt vmcnt(0)" ::: "memory");
        } else {
            XB_SPIN(xb_ld(&bar[XB_XGEN(b.x)]) == gen, bar);
            __builtin_amdgcn_fence(__ATOMIC_ACQUIRE, "agent");
            asm volatile("s_waitcnt vmcnt(0)" ::: "memory");
        }
    }
    __syncthreads();
}

struct Frame {
    LAS unsigned char* lds;
    volatile LAS unsigned* MISC;
    unsigned* ctl;
    int wave, vcu, G;
    unsigned char* out; unsigned char* ws;
};
struct Args { const float* in[19]; unsigned char* out; unsigned char* ws; int ph_lo, ph_hi; };
__device__ __forceinline__ float wave_sum(float v) {
#pragma unroll
    for (int o = 1; o < 64; o <<= 1) v += __shfl_xor(v, o);
    return v;
}
__device__ __forceinline__ void tr_item(const float* W, int ldw, int K, int k0, int srcc, bf16_t* WT, int drow, const float* gain, LAS float* scr, int lane) {
    float wv[32];
#pragma unroll
    for (int i = 0; i < 32; ++i) { const int kk = 2 * i + (lane >> 5); wv[i] = W[(size_t)(k0 + kk) * ldw + srcc + (lane & 31)]; }
#pragma unroll
    for (int i = 0; i < 32; ++i) { const int kk = 2 * i + (lane >> 5); float w = wv[i]; if (gain) w *= gain[k0 + kk]; scr[kk * 33 + (lane & 31)] = w; }
    LDS_WAIT(); asm volatile("" ::: "memory");
    const int c = lane & 7;
#pragma unroll
    for (int j = 0; j < 4; ++j) { const int n = (lane >> 3) + 8 * j; const LAS float* s = scr + (8 * c) * 33 + n;
        u32x4 o; o.x = cvt_pk_bf16(s[0 * 33], s[1 * 33]); o.y = cvt_pk_bf16(s[2 * 33], s[3 * 33]); o.z = cvt_pk_bf16(s[4 * 33], s[5 * 33]); o.w = cvt_pk_bf16(s[6 * 33], s[7 * 33]);
        *(u32x4*)(WT + (size_t)(drow + n) * K + k0 + 8 * c) = o; }
    LDS_WAIT(); asm volatile("" ::: "memory");
}
__device__ __forceinline__ void cvt_rows(Frame& F, const float* src, bf16_t* dst, size_t n8) {
    const size_t nthr = (size_t)F.G * 512;
    for (size_t i = (size_t)F.vcu * 512 + F.wave * 64 + lane_id(); i < n8; i += 8 * nthr) { f32x4 a[8], b[8];
#pragma unroll
        for (int j = 0; j < 8; ++j) if (i + j * nthr < n8) { a[j] = *(const f32x4*)(src + (i + j * nthr) * 8); b[j] = *(const f32x4*)(src + (i + j * nthr) * 8 + 4); }
#pragma unroll
        for (int j = 0; j < 8; ++j) if (i + j * nthr < n8) *(u32x4*)(dst + (i + j * nthr) * 8) = epi::pack8(a[j], b[j]); }
}
__device__ __forceinline__ void p0_prologue(Frame& F, const Args& A, bool first = true) {
    LAS float* scr = (LAS float*)(F.lds + F.wave * 16384);
    const int gw = F.vcu * NWAVES + F.wave, NGW = F.G * NWAVES, lane = lane_id();
    unsigned char* ws = F.ws;
    constexpr int I0 = 16 * 112, I1 = 512, I2 = 512, I3 = 512, I4 = 128, I5 = 128, I6 = 16 * 192, I7 = 32 * 32, I8 = 32 * 8, I9 = 32 * 8, I10 = 8, I11 = 8, I12 = 16 * 2;
    constexpr int NITEMS = I0 + I1 + I2 + I3 + I4 + I5 + I6 + I7 + I8 + I9 + I10 + I11 + I12;
    for (int it = gw; it < NITEMS; it += NGW) {
        int r = it;
        if (r < I0) { const int kb = r / 112, gi = r % 112, pn = gi >> 3, gg = gi & 7, bj = gg >> 2, wc = gg & 3; int srcc;
            if (pn < 4) srcc = pn * 256 + wc * 64 + bj * 32; else if (pn < 10) srcc = 1024 + (pn - 4) * 256 + wc * 64 + bj * 32; else srcc = 2608 + (pn - 10) * 256 + wc * 64 + bj * 32;
            tr_item(A.in[3], 3632, 1024, 64 * kb, srcc, (bf16_t*)(ws + WS_WNIN), 32 * gi, A.in[2], scr, lane); continue; } r -= I0;
        if (r < I1) { tr_item(A.in[14], 1024, 1024, 64 * (r / 32), 32 * (r % 32), (bf16_t*)(ws + WS_WNOUT), 32 * (r % 32), nullptr, scr, lane); continue; } r -= I1;
        if (r < I2) { tr_item(A.in[18], 1024, 1024, 64 * (r / 32), 32 * (r % 32), (bf16_t*)(ws + WS_WG0), 32 * (r % 32), nullptr, scr, lane); continue; } r -= I2;
        if (r < I3) { tr_item(A.in[18] + (size_t)1024 * 1024, 1024, 1024, 64 * (r / 32), 32 * (r % 32), (bf16_t*)(ws + WS_WG1), 32 * (r % 32), nullptr, scr, lane); continue; } r -= I3;
        if (r < I4) { tr_item(A.in[17], 1024, 256, 64 * (r / 32), 32 * (r % 32), (bf16_t*)(ws + WS_WP0), 32 * (r % 32), nullptr, scr, lane); continue; } r -= I4;
        if (r < I5) { tr_item(A.in[17] + (size_t)256 * 1024, 1024, 256, 64 * (r / 32), 32 * (r % 32), (bf16_t*)(ws + WS_WP1), 32 * (r % 32), nullptr, scr, lane); continue; } r -= I5;
        if (r < I6) { tr_item(A.in[15], 6144, 1024, 64 * (r / 192), 32 * (r % 192), (bf16_t*)(ws + WS_WRIN), 32 * (r % 192), A.in[2] + 1024, scr, lane); continue; } r -= I6;
        if (r < I7) { tr_item(A.in[16], 1024, 2048, 64 * (r / 32), 32 * (r % 32), (bf16_t*)(ws + WS_WROUT), 32 * (r % 32), nullptr, scr, lane); continue; } r -= I7;
        if (r < I8) { tr_item(A.in[10], 256, 2048, 64 * (r / 8), 32 * (r % 8), (bf16_t*)(ws + WS_WC1K), 32 * (r % 8), nullptr, scr, lane); continue; } r -= I8;
        if (r < I9) { tr_item(A.in[12], 256, 2048, 64 * (r / 8), 32 * (r % 8), (bf16_t*)(ws + WS_WC1V), 32 * (r % 8), nullptr, scr, lane); continue; } r -= I9;
        if (r < I10) { tr_item(A.in[11], 64, 256, 64 * (r / 2), 32 * (r % 2), (bf16_t*)(ws + WS_WC2K), 32 * (r % 2), nullptr, scr, lane); continue; } r -= I10;
        if (r < I11) { tr_item(A.in[13], 64, 256, 64 * (r / 2), 32 * (r % 2), (bf16_t*)(ws + WS_WC2V), 32 * (r % 2), nullptr, scr, lane); continue; } r -= I11;
        tr_item(A.in[3], 3632, 1024, 64 * (r / 2), 2560 + 32 * (r % 2), (bf16_t*)(ws + WS_WGT), 32 * (r % 2), A.in[2], scr, lane);
    }
    { const float* x = A.in[0]; bf16_t* xb = (bf16_t*)(ws + WS_XB); float* rs = (float*)(ws + WS_ROWSC0);
      for (int m = gw; m < T_TOK; m += 4 * NGW) { f32x4 v[4][4]; float s[4];
#pragma unroll
          for (int q = 0; q < 4; ++q) { const int mq = (m + q * NGW < T_TOK) ? m + q * NGW : m; const f32x4* xr = (const f32x4*)(x + (size_t)mq * DM) + lane;
#pragma unroll
              for (int j = 0; j < 4; ++j) v[q][j] = xr[64 * j]; }
#pragma unroll
          for (int q = 0; q < 4; ++q) { float a = 0.f;
#pragma unroll
              for (int j = 0; j < 4; ++j) a += epi::dot4(v[q][j]);
              s[q] = wave_sum(a); }
#pragma unroll
          for (int q = 0; q < 4; ++q) if (m + q * NGW < T_TOK) { const int mq = m + q * NGW; u32x2* o8 = (u32x2*)(xb + (size_t)mq * DM) + lane;
#pragma unroll
              for (int j = 0; j < 4; ++j) { u32x2 w; w.x = cvt_pk_bf16(v[q][j][0], v[q][j][1]); w.y = cvt_pk_bf16(v[q][j][2], v[q][j][3]); o8[64 * j] = w; }
              if (lane == 0) rs[mq] = __builtin_amdgcn_rsqf(s[q] * (1.0f / DM) + RMS_EPS); } } }
    cvt_rows(F, A.in[1], (bf16_t*)(ws + WS_PB0), (size_t)T_TOK * 256 / 8);
    cvt_rows(F, A.in[1] + (size_t)T_TOK * 256, (bf16_t*)(ws + WS_PB1), (size_t)T_TOK * 256 / 8);
    { float* ct = (float*)(ws + WS_COS); float* st = (float*)(ws + WS_SIN); float* ctt = (float*)(ws + WS_COST); float* stt = (float*)(ws + WS_SINT);
      for (int i = F.vcu * 512 + F.wave * 64 + lane_id(); i < 2 * SEQ * 128; i += F.G * 512) { const bool tr = i >= SEQ * 128; const int ii = tr ? i - SEQ * 128 : i; const int pos = tr ? (ii & (SEQ - 1)) : (ii >> 7), j = tr ? (ii >> 12) : (ii & 127);
          const float inv = (float)exp2(-((double)j / 127.0) * 13.287712379549449);
          const float ang = (float)pos * inv;
          double t = (double)ang * 0.15915494309189535; t -= floor(t);
          const float cv = __builtin_amdgcn_cosf((float)t), sv = __builtin_amdgcn_sinf((float)t);
          if (tr) { ctt[ii] = cv; stt[ii] = sv; } else { ct[ii] = cv; st[ii] = sv; } } }
    if (first) for (int task = gw; task < 512; task += NGW) { const int kv = task >> 8, cb = (task >> 6) & 3, kc = task & 63, col = cb * 64 + lane; const float* pos = kv ? A.in[9] : A.in[8]; const float* w1 = kv ? A.in[12] : A.in[10]; float a = 0.f;
#pragma unroll 8
        for (int k = kc * 32; k < kc * 32 + 32; ++k) a += pos[k] * w1[(size_t)k * 256 + col];
        atomicAdd((float*)(ws + WS_CBIAS) + kv * 256 + col, a); }
    if (gw == NGW - 1) { float* gd = (float*)(ws + WS_GAINS); gd[lane] = A.in[4][lane]; gd[64 + lane] = A.in[5][lane]; gd[128 + lane] = A.in[6][lane]; gd[192 + lane] = A.in[7][lane]; }
}
__device__ __forceinline__ void cmp2_task(Frame& F, int task) {
    const float* kcg = (const float*)(F.ws + WS_GAINS) + 64;
    const int lane = lane_id(), r32 = lane & 31, hi = lane >> 5;
    unsigned char* ws = F.ws;
    {
        const int kv = task >> 8, rb = task & 255;
        const bf16_t* H = (const bf16_t*)(ws + WS_HID) + ((size_t)kv * 8192 + rb * 32) * 256;
        const bf16_t* W2 = (const bf16_t*)(ws + (kv ? WS_WC2V : WS_WC2K));
        f32x16 o0 = {}, o1 = {};
#pragma unroll 4
        for (int ks = 0; ks < 16; ++ks) {
            const bf16x8 hb = *(const bf16x8*)(H + (size_t)r32 * 256 + ks * 16 + hi * 8);
            const bf16x8 w0 = *(const bf16x8*)(W2 + (size_t)r32 * 256 + ks * 16 + hi * 8), w1 = *(const bf16x8*)(W2 + (size_t)(32 + r32) * 256 + ks * 16 + hi * 8);
            o0 = __builtin_amdgcn_mfma_f32_32x32x16_bf16(w0, hb, o0, 0, 0, 0); o1 = __builtin_amdgcn_mfma_f32_32x32x16_bf16(w1, hb, o1, 0, 0, 0);
        }
        if (kv == 0) { float ss = 0.f;
#pragma unroll
            for (int r = 0; r < 16; ++r) ss += o0[r] * o0[r] + o1[r] * o1[r];
            ss += __shfl_xor(ss, 32);
            const float rn = __builtin_amdgcn_rsqf(ss * (1.0f / 64.0f) + RMS_EPS); const float* gp = kcg;
#pragma unroll
            for (int r = 0; r < 16; ++r) { const int c = (r & 3) + 8 * (r >> 2) + 4 * hi; o0[r] *= rn * gp[c]; o1[r] *= rn * gp[32 + c]; } }
        const int rowg = rb * 32 + r32;
        if ((rowg & 255) == 255) { o0 = f32x16{}; o1 = f32x16{}; }
        bf16_t* dst = (bf16_t*)(ws + (kv ? WS_VCC : WS_KCC)) + (size_t)rowg * 64;
#pragma unroll
        for (int a = 0; a < 4; ++a) { u32x2 w; w.x = cvt_pk_bf16(o0[4 * a], o0[4 * a + 1]); w.y = cvt_pk_bf16(o0[4 * a + 2], o0[4 * a + 3]); *(u32x2*)(dst + 8 * a + 4 * hi) = w;
            w.x = cvt_pk_bf16(o1[4 * a], o1[4 * a + 1]); w.y = cvt_pk_bf16(o1[4 * a + 2], o1[4 * a + 3]); *(u32x2*)(dst + 32 + 8 * a + 4 * hi) = w; }
    }
}
__device__ __forceinline__ void gates_task(Frame& F, int task) {
    const int lane = lane_id(), r32 = lane & 31, hi = lane >> 5;
    unsigned char* ws = F.ws;
    const bf16_t* X = (const bf16_t*)(ws + WS_XB) + ((size_t)task * 32 + r32) * 1024 + hi * 32;
    const bf16_t* W = (const bf16_t*)(ws + WS_WGT) + (size_t)r32 * 1024 + hi * 32;
    f32x16 o0 = {}, o1 = {};
#pragma unroll 2
    for (int j = 0; j < 16; ++j) { bf16x8 xf[4], w0[4], w1[4];
#pragma unroll
        for (int s_ = 0; s_ < 4; ++s_) { xf[s_] = *(const bf16x8*)(X + j * 64 + s_ * 8); w0[s_] = *(const bf16x8*)(W + j * 64 + s_ * 8); w1[s_] = *(const bf16x8*)(W + (size_t)32 * 1024 + j * 64 + s_ * 8); }
#pragma unroll
        for (int s_ = 0; s_ < 4; ++s_) { o0 = __builtin_amdgcn_mfma_f32_32x32x16_bf16(w0[s_], xf[s_], o0, 0, 0, 0); o1 = __builtin_amdgcn_mfma_f32_32x32x16_bf16(w1[s_], xf[s_], o1, 0, 0, 0); } }
    const int row = task * 32 + r32; const float s = ((const float*)(ws + WS_ROWSC0))[row];
    float* gp = (float*)(ws + WS_G) + (size_t)row * 48;
#pragma unroll
    for (int a = 0; a < 4; ++a) { f32x4 v;
#pragma unroll
        for (int x = 0; x < 4; ++x) v[x] = sigmoidf_(o0[4 * a + x] * s);
        *(f32x4*)(gp + 8 * a + 4 * hi) = v;
        if (a < 2) {
#pragma unroll
            for (int x = 0; x < 4; ++x) v[x] = sigmoidf_(o1[4 * a + x] * s);
            *(f32x4*)(gp + 32 + 8 * a + 4 * hi) = v; } }
}

namespace nsa {
constexpr int L_KV = 0, L_K = 0, L_V = 24576, L_WSF = 49152, L_ACC = 51200, L_GS = 116736, L_LS = 133120, L_MSK = 149504, L_END = 150016;
constexpr int NSLOT = 3, SLOTB = 8192;
#define NSA_NEG (-INFINITY)
#ifndef FB_OFF_REGS
#define FB_OFF_REGS 0
#endif
#ifndef ODD_NT
#define ODD_NT 1
#endif
#ifndef WIN_PREFETCH
#define WIN_PREFETCH 0
#endif
__device__ __forceinline__ int crow(int r, int hi) { return (r & 3) + 8 * (r >> 2) + 4 * hi; }
__device__ __forceinline__ void qkt(f32x16& p0, f32x16& p1, const LAS unsigned char* Kslot, const bf16x8* qr, int r32, int hi) {
    const LAS unsigned char* kb = Kslot + hi * 1024 + r32 * 16;
    const f32x16 z = {};
#pragma unroll
    for (int d0 = 0; d0 < 4; ++d0) {
        const bf16x8 b0 = *(const LAS bf16x8*)(kb + d0 * 2048), b1 = *(const LAS bf16x8*)(kb + d0 * 2048 + 512);
        if (d0 == 0) { p0 = __builtin_amdgcn_mfma_f32_32x32x16_bf16(b0, qr[0], z, 0, 0, 0); p1 = __builtin_amdgcn_mfma_f32_32x32x16_bf16(b1, qr[0], z, 0, 0, 0); }
        else { p0 = __builtin_amdgcn_mfma_f32_32x32x16_bf16(b0, qr[d0], p0, 0, 0, 0); p1 = __builtin_amdgcn_mfma_f32_32x32x16_bf16(b1, qr[d0], p1, 0, 0, 0); }
    }
}
__device__ __forceinline__ void pv(f32x16* o, int vb, bf16x8 pa0, bf16x8 pa1, bf16x8 pa2, bf16x8 pa3) {
#pragma unroll
    for (int d0 = 0; d0 < 2; ++d0) { s16x4 lo[4], hi[4];
#pragma unroll
        for (int ks = 0; ks < 4; ++ks) {
            asm volatile("ds_read_b64_tr_b16 %0,%1 offset:%c2" : "=&v"(lo[ks]) : "v"(vb), "i"(d0 * 4096 + ks * 1024) : "memory");
            asm volatile("ds_read_b64_tr_b16 %0,%1 offset:%c2" : "=&v"(hi[ks]) : "v"(vb), "i"(d0 * 4096 + ks * 1024 + 512) : "memory"); }
        asm volatile("s_waitcnt lgkmcnt(0)" ::: "memory"); __builtin_amdgcn_sched_barrier(0);
#define NSA_PK(k) (bf16x8){lo[k][0], lo[k][1], lo[k][2], lo[k][3], hi[k][0], hi[k][1], hi[k][2], hi[k][3]}
        o[d0] = __builtin_amdgcn_mfma_f32_32x32x16_bf16(pa0, NSA_PK(0), o[d0], 0, 0, 0);
        o[d0] = __builtin_amdgcn_mfma_f32_32x32x16_bf16(pa1, NSA_PK(1), o[d0], 0, 0, 0);
        o[d0] = __builtin_amdgcn_mfma_f32_32x32x16_bf16(pa2, NSA_PK(2), o[d0], 0, 0, 0);
        o[d0] = __builtin_amdgcn_mfma_f32_32x32x16_bf16(pa3, NSA_PK(3), o[d0], 0, 0, 0);
#undef NSA_PK
    }
}
__device__ __forceinline__ float rowmax(const f32x16& p0, const f32x16& p1) {
    float a = fmaxf(fmaxf(p0[0], p0[1]), p1[0]), b = fmaxf(fmaxf(p0[2], p0[3]), p1[1]); a = fmaxf(fmaxf(a, p1[2]), p1[3]);
#pragma unroll
    for (int r = 4; r < 16; r += 4) { a = fmaxf(fmaxf(a, p0[r]), p0[r + 1]); b = fmaxf(fmaxf(b, p0[r + 2]), p0[r + 3]); a = fmaxf(fmaxf(a, p1[r]), p1[r + 1]); b = fmaxf(fmaxf(b, p1[r + 2]), p1[r + 3]); }
    const float m = fmaxf(a, b);
    auto rr = __builtin_amdgcn_permlane32_swap(__float_as_uint(m), __float_as_uint(m), false, false);
    return fmaxf(__uint_as_float(rr[0]), __uint_as_float(rr[1]));
}
__device__ __forceinline__ float halfsum(float v) {
    auto rr = __builtin_amdgcn_permlane32_swap(__float_as_uint(v), __float_as_uint(v), false, false);
    return __uint_as_float(rr[0]) + __uint_as_float(rr[1]);
}
__device__ __forceinline__ void row_scale(f32x16 (&o)[2], float f, LAS float* wsf, int r32, int hi) {
    if (hi == 0) wsf[r32] = f;
#pragma unroll
    for (int a = 0; a < 4; ++a) { const f32x4 f4 = *(const LAS f32x4*)(wsf + 8 * a + 4 * hi);
#pragma unroll
        for (int x = 0; x < 4; ++x) { o[0][4 * a + x] *= f4[x]; o[1][4 * a + x] *= f4[x]; } }
}
__device__ __forceinline__ void row_fma(f32x16 (&acc)[2], const f32x16 (&o)[2], float f, LAS float* wsf, int r32, int hi) {
    if (hi == 0) wsf[r32] = f;
#pragma unroll
    for (int a = 0; a < 4; ++a) { const f32x4 f4 = *(const LAS f32x4*)(wsf + 8 * a + 4 * hi);
#pragma unroll
        for (int x = 0; x < 4; ++x) { acc[0][4 * a + x] += o[0][4 * a + x] * f4[x]; acc[1][4 * a + x] += o[1][4 * a + x] * f4[x]; } }
}
__device__ __forceinline__ void softmax_step(f32x16& p0, f32x16& p1, float& m, float& l, f32x16 (&o)[2], LAS float* wsf, int r32, int hi) {
    const float rm = rowmax(p0, p1);
    if (__any(rm > m)) {
        const float mn = fmaxf(m, rm), mu = (mn == NSA_NEG) ? 0.f : mn;
        const float alpha = __builtin_amdgcn_exp2f(m - mu);
        l *= alpha; m = mn;
        row_scale(o, alpha, wsf, r32, hi);
    }
    const float mu = (m == NSA_NEG) ? 0.f : m; float s = 0.f;
#pragma unroll
    for (int r = 0; r < 16; ++r) { p0[r] = __builtin_amdgcn_exp2f(p0[r] - mu); p1[r] = __builtin_amdgcn_exp2f(p1[r] - mu); s += p0[r] + p1[r]; }
    l += s;
}

__device__ __forceinline__ void glds16(const void* sbase, unsigned voff, unsigned lds_dst) { unsigned keep;
    asm volatile("s_mov_b32 %0, m0\n\ts_mov_b32 m0, %3\n\ts_nop 0\n\tglobal_load_lds_dwordx4 %1, %2\n\ts_mov_b32 m0, %0" : "=&s"(keep) : "v"(voff), "s"(sbase), "s"(lds_dst) : "memory"); }
__device__ __forceinline__ float max3f(float a, float b, float c) { float r; asm("v_max3_f32 %0, %1, %2, %3" : "=v"(r) : "v"(a), "v"(b), "v"(c)); return r; }
__device__ __forceinline__ float max2f(float a, float b) { float r; asm("v_max_f32_e32 %0, %1, %2" : "=v"(r) : "v"(a), "v"(b)); return r; }
__device__ __forceinline__ float fadd_s(float a, float b) { float r; asm("v_add_f32_e32 %0, %1, %2" : "=v"(r) : "v"(a), "v"(b)); return r; }
__device__ __forceinline__ float fsub_s(float a, float b) { float r; asm("v_sub_f32_e32 %0, %1, %2" : "=v"(r) : "v"(a), "v"(b)); return r; }
typedef LAS const char* lds_cptr;
typedef short v4i16_t __attribute__((ext_vector_type(4)));
__device__ __forceinline__ void kload8(bf16x8* kf, lds_cptr kp) {
    kf[0] = *(const LAS bf16x8*)(kp);        kf[1] = *(const LAS bf16x8*)(kp + 512);
    kf[2] = *(const LAS bf16x8*)(kp + 2048); kf[3] = *(const LAS bf16x8*)(kp + 2560);
    kf[4] = *(const LAS bf16x8*)(kp + 4096); kf[5] = *(const LAS bf16x8*)(kp + 4608);
    kf[6] = *(const LAS bf16x8*)(kp + 6144); kf[7] = *(const LAS bf16x8*)(kp + 6656); }
__device__ __forceinline__ void kload2(bf16x8* kf, lds_cptr kp, int j) { kf[2 * j] = *(const LAS bf16x8*)(kp + j * 2048); kf[2 * j + 1] = *(const LAS bf16x8*)(kp + j * 2048 + 512); }
__device__ __forceinline__ s16x4 vtr(lds_cptr p) { return __builtin_bit_cast(s16x4, __builtin_amdgcn_ds_read_tr16_b64_v4i16((LAS v4i16_t*)p)); }
__device__ __forceinline__ float rowmax_a(const f32x16& p0, const f32x16& p1) {
    float a = max3f(p0[0], p0[1], p1[0]), b = max3f(p0[2], p0[3], p1[1]); a = max3f(a, p1[2], p1[3]);
#pragma unroll
    for (int r = 4; r < 16; r += 4) { a = max3f(a, p0[r], p0[r + 1]); b = max3f(b, p0[r + 2], p0[r + 3]); a = max3f(a, p1[r], p1[r + 1]); b = max3f(b, p1[r + 2], p1[r + 3]); }
    const float m = max2f(a, b);
    auto rr = __builtin_amdgcn_permlane32_swap(__float_as_uint(m), __float_as_uint(m), false, false);
    return max2f(__uint_as_float(rr[0]), __uint_as_float(rr[1]));
}
#define FB_SBAR() __builtin_amdgcn_sched_barrier(0)
#define FB_WAIT_BAR(N) asm volatile("s_waitcnt vmcnt(" #N ") lgkmcnt(0)\n\ts_barrier" ::: "memory")
template <int MODE> __device__ __forceinline__ void mask_tile(f32x16& p0, f32x16& p1, int t, int qb, int nreal, int tl_base, const LAS unsigned long long* mskp) {
    const float NEG = -INFINITY;
    if (t >= nreal) {
#pragma unroll
        for (int r = 0; r < 16; ++r) { p0[r] = NEG; p1[r] = NEG; }
        return; }
    if ((MODE == 0) ? (t == qb) : (t == 0)) { const int l_ = lane_id(); const int lim = tl_base + ((l_ & 31) >> 2) - 4 * (l_ >> 5);
#pragma unroll
        for (int r = 0; r < 16; ++r) { const int cr = (r & 3) + 8 * (r >> 2); if (cr > lim) p0[r] = NEG; if (cr + 32 > lim) p1[r] = NEG; } }
    if (MODE == 1 && t == 8) { const int l_ = lane_id(); const int lim = tl_base + ((l_ & 31) >> 2) - 4 * (l_ >> 5);
#pragma unroll
        for (int r = 0; r < 16; ++r) { const int cr = (r & 3) + 8 * (r >> 2); if (cr <= lim) p0[r] = NEG; if (cr + 32 <= lim) p1[r] = NEG; } }
    if (MODE == 0) { const bool dead = !((*mskp >> t) & 1ull);
        if (__any(dead)) {
#pragma unroll
            for (int r = 0; r < 16; ++r) { p0[r] = dead ? NEG : p0[r]; p1[r] = dead ? NEG : p1[r]; } } }
}
template <int MODE> __device__ __forceinline__ void mask_pos(f32x16& p0, f32x16& p1, int t, int qb, int tl_base) {
    const float NEG = -INFINITY;
    if ((MODE == 0) ? (t == qb) : (t == 0)) { const int l_ = lane_id(); const int lim = tl_base + ((l_ & 31) >> 2) - 4 * (l_ >> 5);
#pragma unroll
        for (int r = 0; r < 16; ++r) { const int cr = (r & 3) + 8 * (r >> 2); if (cr > lim) p0[r] = NEG; if (cr + 32 > lim) p1[r] = NEG; } }
    if (MODE == 1 && t == 8) { const int l_ = lane_id(); const int lim = tl_base + ((l_ & 31) >> 2) - 4 * (l_ >> 5);
#pragma unroll
        for (int r = 0; r < 16; ++r) { const int cr = (r & 3) + 8 * (r >> 2); if (cr <= lim) p0[r] = NEG; if (cr + 32 <= lim) p1[r] = NEG; } }
}
template <int MODE> __device__ __forceinline__ void flash_prefetch(LAS unsigned char* lds, const bf16_t* Kg, const bf16_t* Vg, int qb, int wid) {
    constexpr long PITCH = 256;
    const int nreal = (MODE == 0) ? qb + 1 : (qb >= 8 ? 9 : qb + 1);
    const unsigned lds0 = (unsigned)(uintptr_t)lds; const unsigned kdst = lds0 + L_K + wid * 1024, vdst = lds0 + L_V + wid * 1024;
#define PF_TILE(t) ((MODE == 0) ? (((t) < nreal) ? (t) : nreal - 1) : (qb - (((t) < nreal) ? (t) : nreal - 1)))
    const int l_ = lane_id();
    const unsigned koff = (unsigned)(l_ * (int)PITCH + wid * 8) * 2u, voff = (unsigned)((16 * (wid & 3) + (l_ >> 2)) * (int)PITCH + (wid >> 2) * 32 + (l_ & 3) * 8) * 2u;
    glds16(uni_ptr((const char*)(Kg + (long)PF_TILE(0) * 64 * PITCH)), koff, (unsigned)__builtin_amdgcn_readfirstlane(kdst));
    glds16(uni_ptr((const char*)(Vg + (long)PF_TILE(0) * 64 * PITCH)), voff, (unsigned)__builtin_amdgcn_readfirstlane(vdst));
    glds16(uni_ptr((const char*)(Kg + (long)PF_TILE(1) * 64 * PITCH)), koff, (unsigned)__builtin_amdgcn_readfirstlane(kdst + SLOTB));
    glds16(uni_ptr((const char*)(Kg + (long)PF_TILE(2) * 64 * PITCH)), koff, (unsigned)__builtin_amdgcn_readfirstlane(kdst + 2 * SLOTB));
#undef PF_TILE
}
template <int MODE, bool PRE = false> __device__ __forceinline__ void flash_branch(LAS unsigned char* lds, const bf16_t* Kg, const bf16_t* Vg, const bf16x8 (&qr)[4], int qb, int tl, const LAS unsigned long long* mskp, const LAS float* gatep, int wid, int lane) {
    const int r32 = lane & 31, hi = lane >> 5;
    constexpr long PITCH = 256;
    const int nreal = (MODE == 0) ? qb + 1 : (qb >= 8 ? 9 : qb + 1);
    const int NT = nreal < 4 ? 4 : (ODD_NT ? nreal : ((nreal + 1) & ~1));
#define FB_TILE(t) ((MODE == 0) ? (((t) < nreal) ? (t) : nreal - 1) : (qb - (((t) < nreal) ? (t) : nreal - 1)))
    const unsigned lds0 = (unsigned)(uintptr_t)lds;
    LAS float* wsf = (LAS float*)(lds + L_WSF) + wid * 64;
#define FB_KOFF() ((unsigned)(lane_id() * (int)PITCH + wid * 8) * 2u)
#define FB_VOFF() ({ const int l_ = lane_id(); (unsigned)((16 * (wid & 3) + (l_ >> 2)) * (int)PITCH + (wid >> 2) * 32 + (l_ & 3) * 8) * 2u; })
    const unsigned kdst = lds0 + L_K + wid * 1024, vdst = lds0 + L_V + wid * 1024;
#if FB_OFF_REGS
    const unsigned koff_r = FB_KOFF(), voff_r = FB_VOFF();
#define DMA_K(t, slot) glds16(uni_ptr((const char*)(Kg + (long)FB_TILE(t) * 64 * PITCH)), koff_r, (unsigned)__builtin_amdgcn_readfirstlane(kdst + (slot)))
#define DMA_V(t, slot) glds16(uni_ptr((const char*)(Vg + (long)FB_TILE(t) * 64 * PITCH)), voff_r, (unsigned)__builtin_amdgcn_readfirstlane(vdst + (slot)))
#else
#define DMA_K(t, slot) glds16(uni_ptr((const char*)(Kg + (long)FB_TILE(t) * 64 * PITCH)), FB_KOFF(), (unsigned)__builtin_amdgcn_readfirstlane(kdst + (slot)))
#define DMA_V(t, slot) glds16(uni_ptr((const char*)(Vg + (long)FB_TILE(t) * 64 * PITCH)), FB_VOFF(), (unsigned)__builtin_amdgcn_readfirstlane(vdst + (slot)))
#endif
    bf16x8 kf[8];
    const lds_cptr shm3 = (lds_cptr)lds; const lds_cptr kp0 = shm3 + L_K + hi * 1024 + r32 * 16; const lds_cptr vp0 = shm3 + L_V + ((lane >> 4) & 1) * 32 + (lane & 3) * 8 + (4 * hi + ((lane & 15) >> 2)) * 64;
    if (!PRE) { DMA_K(0, 0); DMA_V(0, 0); DMA_K(1, SLOTB); }
    float mhat = 0.f, l_reg = 0.f; f32x16 o[2]; o[0] = f32x16{}; o[1] = f32x16{}; const f32x16 zero16 = f32x16{};
#define CMASK(P0, P1, t) mask_tile<MODE>(P0, P1, (t), qb, nreal, wid * 8, mskp)
    bool resc = false;
#define START(P0, P1) do { const float rm = rowmax_a(P0, P1); resc = false; \
    { const float dl = rm; mhat = fadd_s(mhat, dl); \
      _Pragma("unroll") for (int r = 0; r < 16; ++r) { P0[r] = fsub_s(P0[r], dl); P1[r] = fsub_s(P1[r], dl); } } \
    _Pragma("unroll") for (int r = 0; r < 16; ++r) P0[r] = __builtin_amdgcn_exp2f(P0[r]); } while (0)
#define RESC() do { if (resc) { asm volatile("s_waitcnt lgkmcnt(0)" ::: "memory"); \
      _Pragma("unroll") for (int d_ = 0; d_ < 2; ++d_) _Pragma("unroll") for (int r = 0; r < 16; ++r) o[d_][r] *= wsf[crow(r, hi)]; } } while (0)
    f32x16 pA0, pA1, pB0, pB1;
    int sl_prev = 0, sl_cur = 0, sl_next = SLOTB;
#define ROT() do { sl_prev = sl_cur; sl_cur = sl_next; sl_next = (sl_next == (NSLOT - 1) * SLOTB) ? 0 : sl_next + SLOTB; } while (0)
    if (!PRE) { DMA_K(2, 2 * SLOTB); }
    if (PRE) { FB_WAIT_BAR(7); } else { FB_WAIT_BAR(3); }
    { const lds_cptr kb = kp0;
      const f32x16 z = zero16;
#pragma unroll
      for (int d0 = 0; d0 < 4; ++d0) { const bf16x8 b0 = *(const LAS bf16x8*)(kb + d0 * 2048), b1 = *(const LAS bf16x8*)(kb + d0 * 2048 + 512);
          if (d0 == 0) { pA0 = __builtin_amdgcn_mfma_f32_32x32x16_bf16(b0, qr[0], z, 0, 0, 0); pA1 = __builtin_amdgcn_mfma_f32_32x32x16_bf16(b1, qr[0], z, 0, 0, 0); }
          else { pA0 = __builtin_amdgcn_mfma_f32_32x32x16_bf16(b0, qr[d0], pA0, 0, 0, 0); pA1 = __builtin_amdgcn_mfma_f32_32x32x16_bf16(b1, qr[d0], pA1, 0, 0, 0); } } }
    asm volatile("s_nop 15\n\ts_nop 7" : "+v"(pA0), "+v"(pA1)); CMASK(pA0, pA1, 0);
    START(pA0, pA1);
#pragma unroll
    for (int r = 0; r < 16; ++r) pA1[r] = __builtin_amdgcn_exp2f(pA1[r]);
    FB_WAIT_BAR(0);
    DMA_K(3, 0); DMA_V(1, SLOTB);
    ROT();
    kload8(kf, kp0 + sl_cur);
    FB_WAIT_BAR(2);
    s16x4 vlo[8], vhi[8]; u32x4 pw0, pw1, pw2, pw3;
#define PKW(P, B) cvt_pk_bf16(P[B], P[B + 1])
#define PAF(k) __builtin_bit_cast(bf16x8, pw##k)
#define VFR(i) (bf16x8){vlo[i][0], vlo[i][1], vlo[i][2], vlo[i][3], vhi[i][0], vhi[i][1], vhi[i][2], vhi[i][3]}
#define PIN(x) asm volatile("" : "+v"(x))
#define MX3(a, b, c) __builtin_fmaxf(__builtin_fmaxf((a), (b)), (c))
#define GAPA(MF, A0, A1, A2, A3, W0, W1, PW) do { MF; sacc += A0; sacc += A1; sacc += A2; sacc += A3; PIN(sacc); W0; W1; PIN(PW); FB_SBAR(); } while (0)
#define EX(v) __builtin_amdgcn_exp2f(v)
#define GAPB(MF, X, B) do { MF; X[B] = EX(X[B]); X[B + 1] = EX(X[B + 1]); X[B + 2] = EX(X[B + 2]); X[B + 3] = EX(X[B + 3]); PIN(X); FB_SBAR(); } while (0)
#define VRD(i) do { vlo[i] = vtr(vp_ + (((i) >> 2) * 4096 + ((i) & 3) * 1024)); vhi[i] = vtr(vp_ + (((i) >> 2) * 4096 + ((i) & 3) * 1024 + 512)); } while (0)
#define KRD(G, j) do { if (G) { kload2(kf, kp0 + sl_next, j); FB_SBAR(); } } while (0)
#define STEP(C0, C1, P0, P1, t, GK, GV, GL) do { FB_SBAR(); \
    const lds_cptr vp_ = vp0 + sl_prev; \
    VRD(0); FB_SBAR(); float sacc = (P0[0] + P0[1]); \
    GAPA(C0 = __builtin_amdgcn_mfma_f32_32x32x16_bf16(kf[0], qr[0], zero16, 0, 0, 0), P0[2], P0[3], P0[4], P0[5],     pw0[0] = PKW(P0, 0), pw0[1] = PKW(P0, 2), pw0); \
    VRD(4); FB_SBAR(); GAPA(C1 = __builtin_amdgcn_mfma_f32_32x32x16_bf16(kf[1], qr[0], zero16, 0, 0, 0), P0[6], P0[7], P0[8], P0[9],     pw0[2] = PKW(P0, 4), pw0[3] = PKW(P0, 6), pw0); \
    VRD(1); FB_SBAR(); GAPA(C0 = __builtin_amdgcn_mfma_f32_32x32x16_bf16(kf[2], qr[1], C0, 0, 0, 0),   P0[10], P0[11], P0[12], P0[13], pw1[0] = PKW(P0, 8), pw1[1] = PKW(P0, 10), pw1); \
    VRD(5); FB_SBAR(); GAPA(C1 = __builtin_amdgcn_mfma_f32_32x32x16_bf16(kf[3], qr[1], C1, 0, 0, 0),   P0[14], P0[15], P1[0], P1[1],   pw1[2] = PKW(P0, 12), pw1[3] = PKW(P0, 14), pw1); \
    VRD(2); FB_SBAR(); GAPA(C0 = __builtin_amdgcn_mfma_f32_32x32x16_bf16(kf[4], qr[2], C0, 0, 0, 0),   P1[2], P1[3], P1[4], P1[5],     pw2[0] = PKW(P1, 0), pw2[1] = PKW(P1, 2), pw2); \
    VRD(6); FB_SBAR(); GAPA(C1 = __builtin_amdgcn_mfma_f32_32x32x16_bf16(kf[5], qr[2], C1, 0, 0, 0),   P1[6], P1[7], P1[8], P1[9],     pw2[2] = PKW(P1, 4), pw2[3] = PKW(P1, 6), pw2); \
    VRD(3); FB_SBAR(); GAPA(C0 = __builtin_amdgcn_mfma_f32_32x32x16_bf16(kf[6], qr[3], C0, 0, 0, 0),   P1[10], P1[11], P1[12], P1[13], pw3[0] = PKW(P1, 8), pw3[1] = PKW(P1, 10), pw3); \
    VRD(7); FB_SBAR(); GAPA(C1 = __builtin_amdgcn_mfma_f32_32x32x16_bf16(kf[7], qr[3], C1, 0, 0, 0),   P1[14], P1[15], 0.f, 0.f,       pw3[2] = PKW(P1, 12), pw3[3] = PKW(P1, 14), pw3); \
    l_reg += sacc; \
    if (GK) { DMA_K((t) + 3, sl_cur); } if (GV) { DMA_V((t) + 1, sl_next); } \
    { const bool dead_ = ((t) >= nreal) || (MODE == 0 && !((*mskp >> (t)) & 1ull)); const float mh_ = dead_ ? INFINITY : mhat;       \
      _Pragma("unroll") for (int r = 0; r < 16; ++r) { C0[r] -= mh_; C1[r] -= mh_; } } \
    mask_pos<MODE>(C0, C1, (t), qb, wid * 8); \
    { float a = MX3(C0[0], C0[1], C1[0]), b = MX3(C0[2], C0[3], C1[1]); a = MX3(a, C1[2], C1[3]); \
      _Pragma("unroll") for (int r = 4; r < 16; r += 4) { a = MX3(a, C0[r], C0[r + 1]); b = MX3(b, C0[r + 2], C0[r + 3]); a = MX3(a, C1[r], C1[r + 1]); b = MX3(b, C1[r + 2], C1[r + 3]); } \
      float rm = __builtin_fmaxf(a, b); { auto rr = __builtin_amdgcn_permlane32_swap(__float_as_uint(rm), __float_as_uint(rm), false, false); rm = __builtin_fmaxf(__uint_as_float(rr[0]), __uint_as_float(rr[1])); } \
      resc = false; \
      if (__builtin_expect(__any(rm > 8.0f), 0)) { const float dl = __builtin_fmaxf(rm, 0.f); mhat += dl; \
        _Pragma("unroll") for (int r = 0; r < 16; ++r) { C0[r] -= dl; C1[r] -= dl; } \
        const float f = __builtin_amdgcn_exp2f(-dl); l_reg *= f; if (hi == 0) wsf[r32] = f; resc = true; } } \
    FB_SBAR(); \
    GAPB(o[0] = __builtin_amdgcn_mfma_f32_32x32x16_bf16(PAF(0), VFR(0), o[0], 0, 0, 0), C0, 0); \
    GAPB(o[1] = __builtin_amdgcn_mfma_f32_32x32x16_bf16(PAF(0), VFR(4), o[1], 0, 0, 0), C0, 4); \
    KRD(GL, 0); GAPB(o[0] = __builtin_amdgcn_mfma_f32_32x32x16_bf16(PAF(1), VFR(1), o[0], 0, 0, 0), C0, 8); \
    KRD(GL, 1); GAPB(o[1] = __builtin_amdgcn_mfma_f32_32x32x16_bf16(PAF(1), VFR(5), o[1], 0, 0, 0), C0, 12); \
    KRD(GL, 2); GAPB(o[0] = __builtin_amdgcn_mfma_f32_32x32x16_bf16(PAF(2), VFR(2), o[0], 0, 0, 0), C1, 0); \
    KRD(GL, 3); GAPB(o[1] = __builtin_amdgcn_mfma_f32_32x32x16_bf16(PAF(2), VFR(6), o[1], 0, 0, 0), C1, 4); \
    GAPB(o[0] = __builtin_amdgcn_mfma_f32_32x32x16_bf16(PAF(3), VFR(3), o[0], 0, 0, 0), C1, 8); \
    GAPB(o[1] = __builtin_amdgcn_mfma_f32_32x32x16_bf16(PAF(3), VFR(7), o[1], 0, 0, 0), C1, 12); \
    } while (0)
    int t = 1;
    for (; t + 5 < NT; t += 2) {
        STEP(pB0, pB1, pA0, pA1, t, true, true, true);     FB_WAIT_BAR(2); RESC(); ROT();
        STEP(pA0, pA1, pB0, pB1, t + 1, true, true, true); FB_WAIT_BAR(2); RESC(); ROT();
    }
#define ENDW(tt) do { if ((tt) + 3 < NT) { FB_WAIT_BAR(2); } else if ((tt) + 2 < NT) { FB_WAIT_BAR(1); } else { FB_WAIT_BAR(0); } } while (0)
    for (; t + 1 < NT; t += 2) {
        STEP(pB0, pB1, pA0, pA1, t, (t + 3 < NT), (t + 1 < NT), (t + 1 < NT));         ENDW(t);     RESC(); ROT();
        STEP(pA0, pA1, pB0, pB1, t + 1, (t + 4 < NT), (t + 2 < NT), (t + 2 < NT));     ENDW(t + 1); RESC(); ROT();
    }
#define DRAIN(P0, P1, SL) do { float sacc = P0[0] + P0[1]; \
      _Pragma("unroll") for (int r = 2; r < 16; ++r) sacc += P0[r]; \
      _Pragma("unroll") for (int r = 0; r < 16; ++r) sacc += P1[r]; \
      l_reg += sacc; \
      pw0 = (u32x4){PKW(P0, 0), PKW(P0, 2), PKW(P0, 4), PKW(P0, 6)}; pw1 = (u32x4){PKW(P0, 8), PKW(P0, 10), PKW(P0, 12), PKW(P0, 14)}; \
      pw2 = (u32x4){PKW(P1, 0), PKW(P1, 2), PKW(P1, 4), PKW(P1, 6)}; pw3 = (u32x4){PKW(P1, 8), PKW(P1, 10), PKW(P1, 12), PKW(P1, 14)}; \
      FB_SBAR(); pv(o, (int)(lds0 + L_V) + ((lane >> 4) & 1) * 32 + (lane & 3) * 8 + (4 * hi + ((lane & 15) >> 2)) * 64 + (SL), PAF(0), PAF(1), PAF(2), PAF(3)); } while (0)
    if (t < NT) { STEP(pB0, pB1, pA0, pA1, NT - 1, false, false, false); RESC(); DRAIN(pB0, pB1, sl_cur); }
    else { DRAIN(pA0, pA1, sl_prev); }
#undef DRAIN
    l_reg = halfsum(l_reg);
    if (hi == 0) { const float gate = *gatep; wsf[32 + r32] = (l_reg > 0.f) ? gate / l_reg : 0.f; }
    asm volatile("s_waitcnt lgkmcnt(0)" ::: "memory");
    { LAS float* acc = (LAS float*)(lds + L_ACC) + wid * 2048;
#pragma unroll
      for (int r = 0; r < 16; ++r) { const int orow = crow(r, hi); const float f = wsf[32 + orow];
#pragma unroll
          for (int d0 = 0; d0 < 2; ++d0) acc[orow * 64 + d0 * 32 + r32] += o[d0][r] * f; } }
    asm volatile("s_waitcnt lgkmcnt(0)\n\ts_barrier" ::: "memory");
#undef DMA_K
#undef DMA_V
#undef CMASK
#undef START
#undef RESC
#undef ROT
#undef PKW
#undef PAF
#undef VFR
#undef PIN
#undef MX3
#undef GAPA
#undef GAPB
#undef EX
#undef VRD
#undef KRD
#undef STEP
#undef ENDW
#undef FB_TILE
#undef FB_KOFF
#undef FB_VOFF
}
#define NSA_PACK(P, B) cvt_pk_bf16(P[B], P[B + 1])
#define NSA_PA(P, B) __builtin_bit_cast(bf16x8, (u32x4){NSA_PACK(P, B), NSA_PACK(P, B + 2), NSA_PACK(P, B + 4), NSA_PACK(P, B + 6)})

__device__ __forceinline__ void nsa_unit(Frame& F, int b, int g, int qb) {
    const int lane = lane_id(), wid = F.wave, r32 = lane & 31, hi = lane >> 5;
    LAS unsigned char* lds = F.lds; unsigned char* ws = F.ws;
    const bf16_t* Q = (const bf16_t*)(F.out + DO_Q); const bf16_t* Z = (const bf16_t*)(F.out + DO_Z);
    const float* G = (const float*)(ws + WS_G); bf16_t* ATT = (bf16_t*)(ws + WS_ATT);
    const int tl = wid * 8 + (r32 >> 2), hh = r32 & 3, t = qb * 64 + tl;
    const size_t tokrow = (size_t)b * SEQ + t;
    bf16x8 qr[4];
#pragma unroll
    for (int d0 = 0; d0 < 4; ++d0) qr[d0] = *(const bf16x8*)(Q + tokrow * 1024 + g * 256 + hh * 64 + d0 * 16 + hi * 8);
    LAS float* gl = (LAS float*)(lds + LDS_GATE) + wid * 96 + r32;
    { const float* gp = G + tokrow * 48 + g * 12 + hh * 3; const float g0_ = gp[0], g1_ = gp[1], g2_ = gp[2]; if (hi == 0) { gl[0] = g0_; gl[32] = g1_; gl[64] = g2_; } }
    LAS float* wsf = (LAS float*)(lds + L_WSF) + wid * 64;
    LAS float* GS = (LAS float*)(lds + L_GS) + wid * 512; LAS float* LS = (LAS float*)(lds + L_LS) + wid * 512;
    LAS unsigned long long* MSK = (LAS unsigned long long*)(lds + L_MSK) + wid * 8;
    const int vbl = (int)(unsigned)(uintptr_t)(lds + L_KV + 8192) + ((lane >> 4) & 1) * 32 + (lane & 3) * 8 + (4 * hi + ((lane & 15) >> 2)) * 64;
    f32x16 oacc[2], o[2], p0, p1; oacc[0] = f32x16{}; oacc[1] = f32x16{};
#define NSA_DMA_K(st, base) __builtin_amdgcn_global_load_lds((const unsigned*)(uni_ptr(base) + koff), (LAS unsigned*)(lds + L_KV + (st) * 16384 + wid * 1024), 16, 0, 0)
#define NSA_DMA_V(st, base) __builtin_amdgcn_global_load_lds((const unsigned*)(uni_ptr(base) + voff), (LAS unsigned*)(lds + L_KV + (st) * 16384 + 8192 + wid * 1024), 16, 0, 0)
#ifndef PROBE_NSA
#define PROBE_NSA 0
#endif
    for (int prep = 0; prep < (PROBE_NSA == 1 ? 2 : 1); ++prep) { oacc[0] = f32x16{}; oacc[1] = f32x16{};
    {
        const int nvalid = (4 * qb + 3 < 255) ? 4 * qb + 3 : 255, ntc = (nvalid + 63) >> 6;
        const char* Kc = (const char*)(ws + WS_KCC) + (size_t)(b * 4 + g) * 256 * 128; const char* Vc = (const char*)(ws + WS_VCC) + (size_t)(b * 4 + g) * 256 * 128;
        const unsigned koff = (unsigned)lane * 128u + wid * 16, voff = (unsigned)(16 * (wid & 3) + (lane >> 2)) * 128u + (wid >> 2) * 64 + (lane & 3) * 16;
        for (int i = 0; i < ntc; ++i) {
            __builtin_amdgcn_global_load_lds((const unsigned*)(uni_ptr(Kc + (size_t)i * 8192) + koff), (LAS unsigned*)(lds + i * 8192 + wid * 1024), 16, 0, 0);
            __builtin_amdgcn_global_load_lds((const unsigned*)(uni_ptr(Vc + (size_t)i * 8192) + voff), (LAS unsigned*)(lds + L_ACC + i * 8192 + wid * 1024), 16, 0, 0); }
        const int nrow = (t >= 31) ? ((t - 31) >> 4) : -1;
        VM_WAIT(); __syncthreads();
        if (PROBE_NSA == 4) {
#pragma unroll
            for (int d0 = 0; d0 < 4; ++d0) { qr[d0] = *(const bf16x8*)(Q + tokrow * 1024 + g * 256 + hh * 64 + d0 * 16 + hi * 8); asm volatile("" : "+v"(qr[d0])); }
            for (int i = 0; i < ntc; ++i) {
                __builtin_amdgcn_global_load_lds((const unsigned*)(uni_ptr(Kc + (size_t)i * 8192) + koff), (LAS unsigned*)(lds + i * 8192 + wid * 1024), 16, 0, 0);
                __builtin_amdgcn_global_load_lds((const unsigned*)(uni_ptr(Vc + (size_t)i * 8192) + voff), (LAS unsigned*)(lds + L_ACC + i * 8192 + wid * 1024), 16, 0, 0); }
            VM_WAIT(); __syncthreads(); }
        f32x16 s0[4], s1[4];
        float m = NSA_NEG;
#pragma unroll
        for (int i = 0; i < 4; ++i) if (i < ntc) {
            qkt(s0[i], s1[i], lds + i * 8192, qr, r32, hi);
            const int lim = nrow - 64 * i - 4 * hi;
            if (__any(64 * i + 63 > nrow)) {
#pragma unroll
                for (int r = 0; r < 16; ++r) { const int cr = (r & 3) + 8 * (r >> 2); if (cr > lim) s0[i][r] = NSA_NEG; if (cr + 32 > lim) s1[i][r] = NSA_NEG; } }
#pragma unroll
            for (int r = 0; r < 16; r += 2) m = fmaxf(m, fmaxf(fmaxf(s0[i][r], s0[i][r + 1]), fmaxf(s1[i][r], s1[i][r + 1]))); }
        { auto rr = __builtin_amdgcn_permlane32_swap(__float_as_uint(m), __float_as_uint(m), false, false); m = fmaxf(__uint_as_float(rr[0]), __uint_as_float(rr[1])); }
        const float mu = (m == NSA_NEG) ? 0.f : m; float l = 0.f;
#pragma unroll
        for (int i = 0; i < 4; ++i) if (i < ntc) {
#pragma unroll
            for (int r = 0; r < 16; ++r) { s0[i][r] = __builtin_amdgcn_exp2f(s0[i][r] - mu); s1[i][r] = __builtin_amdgcn_exp2f(s1[i][r] - mu); l += s0[i][r] + s1[i][r]; } }
        l = halfsum(l);
        const float inv_l = l > 0.f ? 1.0f / l : 0.f;
        o[0] = f32x16{}; o[1] = f32x16{};
        const int vbc = (int)(unsigned)(uintptr_t)(lds + L_ACC) + ((lane >> 4) & 1) * 32 + (lane & 3) * 8 + (4 * hi + ((lane & 15) >> 2)) * 64;
#define QSUM(v) do { v += __int_as_float(__builtin_amdgcn_update_dpp(0, __float_as_int(v), 0xB1, 0xf, 0xf, true)); v += __int_as_float(__builtin_amdgcn_update_dpp(0, __float_as_int(v), 0x4E, 0xf, 0xf, true)); } while (0)
#pragma unroll
        for (int i = 0; i < 4; ++i) if (i < ntc) {
#if defined(PROBE_CMP) && PROBE_CMP == 1
            for (int prc = 0; prc < 2; ++prc)
#endif
#pragma unroll
            for (int a = 0; a < 4; ++a) {
                float g0 = ((s0[i][4 * a] + s0[i][4 * a + 1]) + (s0[i][4 * a + 2] + s0[i][4 * a + 3])) * inv_l, l0 = s0[i][4 * a + 3] * inv_l;
                float g1 = ((s1[i][4 * a] + s1[i][4 * a + 1]) + (s1[i][4 * a + 2] + s1[i][4 * a + 3])) * inv_l, l1 = s1[i][4 * a + 3] * inv_l;
                QSUM(g0); QSUM(l0); QSUM(g1); QSUM(l1);
                if (hh == 0) { const int j = 16 * i + 2 * a + hi, tk = r32 >> 2;
                    GS[tk * 64 + j] = g0; GS[tk * 64 + j + 8] = g1; LS[tk * 64 + j + 1] = l0; if (j + 9 < 64) LS[tk * 64 + j + 9] = l1; }
            }
            const bf16x8 pa0 = NSA_PA(s0[i], 0), pa1 = NSA_PA(s0[i], 8), pa2 = NSA_PA(s1[i], 0), pa3 = NSA_PA(s1[i], 8);
            pv(o, vbc + i * 8192, pa0, pa1, pa2, pa3);
#if defined(PROBE_CMP) && PROBE_CMP == 2
            { f32x16 o2[2]; o2[0] = o[0]; o2[1] = o[1]; pv(o2, vbc + i * 8192, pa0, pa1, pa2, pa3); asm volatile("" :: "v"(o2[0]), "v"(o2[1])); }
#endif
        }
#undef QSUM
        { const float gate_c = gl[0] * inv_l; oacc[0] = f32x16{}; oacc[1] = f32x16{}; row_fma(oacc, o, gate_c, wsf, r32, hi); }
        __syncthreads();
    }
#if WIN_PREFETCH
    flash_prefetch<1>(lds, (const bf16_t*)(ws + WS_KW) + (size_t)b * SEQ * 256 + g * 64, (const bf16_t*)(ws + WS_VW) + (size_t)b * SEQ * 256 + g * 64, qb, wid);
#endif
    LDS_WAIT();
    {
        const int tkq = lane >> 3, c8 = lane & 7;
        const LAS float* gsp = GS + tkq * 64 + c8 * 8; const LAS float* lsp = LS + tkq * 64 + c8 * 8;
        const f32x4 ga = *(const LAS f32x4*)gsp, gb = *(const LAS f32x4*)(gsp + 4), la = *(const LAS f32x4*)lsp, lb = *(const LAS f32x4*)(lsp + 4);
        unsigned key[8];
#pragma unroll
        for (int i = 0; i < 8; ++i) { const int j = c8 * 8 + i; const float gv = (i < 4) ? ga[i & 3] : gb[i & 3], lv = (i < 4) ? la[i & 3] : lb[i & 3];
            const float imp = gv + (j > 0 ? lv : 0.f);
            const bool valid = j <= qb, forced = (j == 0) || (j == qb) || (j == qb - 1);
#if defined(PROBE_SELINV)
            const float sc = forced ? 1e4f : (1e3f - imp);
#else
            const float sc = imp + (forced ? 1e4f : 0.f);
#endif
            key[i] = valid ? __float_as_uint(sc) + 1u : 0u; }
#define G8SUM(v) do { v += __builtin_amdgcn_update_dpp(0, v, 0xB1, 0xf, 0xf, true); v += __builtin_amdgcn_update_dpp(0, v, 0x4E, 0xf, 0xf, true); v += __builtin_amdgcn_update_dpp(0, v, 0x141, 0xf, 0xf, true); } while (0)
        unsigned T = 0u;
#if defined(PROBE_TOPK)
        for (int prt = 0; prt < 2; ++prt) { T = 0u;
#pragma unroll
        for (int i = 0; i < 8; ++i) asm volatile("" : "+v"(key[i]));
#endif
        if (qb >= 16) {
#pragma unroll
            for (int bit = 31; bit >= 0; --bit) { const unsigned cand = T | (1u << bit); int cnt = 0;
#pragma unroll
                for (int i = 0; i < 8; ++i) cnt += (key[i] >= cand) ? 1 : 0;
                G8SUM(cnt);
                T = (cnt >= 16) ? cand : T; } }
#if defined(PROBE_TOPK)
        }
#endif
        int gcnt = 0, ecnt = 0;
#pragma unroll
        for (int i = 0; i < 8; ++i) { gcnt += (key[i] > T) ? 1 : 0; ecnt += (key[i] == T) ? 1 : 0; }
        G8SUM(gcnt); const int need = 16 - gcnt;
        int pre = ecnt;
        { const int t1 = __builtin_amdgcn_update_dpp(0, pre, 0x111, 0xf, 0xf, true); pre += (c8 >= 1) ? t1 : 0;
          const int t2 = __builtin_amdgcn_update_dpp(0, pre, 0x112, 0xf, 0xf, true); pre += (c8 >= 2) ? t2 : 0;
          const int t4 = __builtin_amdgcn_update_dpp(0, pre, 0x114, 0xf, 0xf, true); pre += (c8 >= 4) ? t4 : 0; }
        int below = pre - ecnt; unsigned bits = 0u;
#pragma unroll
        for (int i = 0; i < 8; ++i) { const bool eq = key[i] == T; const bool sel = (key[i] != 0u) && ((key[i] > T) || (eq && below < need)); below += eq ? 1 : 0; bits |= sel ? (1u << i) : 0u; }
        ((LAS unsigned char*)MSK)[tkq * 8 + c8] = (unsigned char)bits;
#undef G8SUM
    }
    }
    LDS_WAIT();
    { const char* zsrc = (const char*)Z + ((size_t)b * SEQ + qb * 64 + wid * 8) * 2048 + g * 512 + (lane >> 5) * 2048 + (lane & 31) * 16;
      const unsigned zg = (unsigned)(uintptr_t)(lds + L_GS) + wid * 2048u, zl = (unsigned)(uintptr_t)(lds + L_LS) + wid * 2048u;
      glds16(uni_ptr((const char*)Z + ((size_t)b * SEQ + qb * 64 + wid * 8) * 2048 + g * 512), (unsigned)((lane >> 5) * 2048 + (lane & 31) * 16), (unsigned)__builtin_amdgcn_readfirstlane(zg));
      glds16(uni_ptr((const char*)Z + ((size_t)b * SEQ + qb * 64 + wid * 8 + 2) * 2048 + g * 512), (unsigned)((lane >> 5) * 2048 + (lane & 31) * 16), (unsigned)__builtin_amdgcn_readfirstlane(zg + 1024u));
      glds16(uni_ptr((const char*)Z + ((size_t)b * SEQ + qb * 64 + wid * 8 + 4) * 2048 + g * 512), (unsigned)((lane >> 5) * 2048 + (lane & 31) * 16), (unsigned)__builtin_amdgcn_readfirstlane(zl));
      glds16(uni_ptr((const char*)Z + ((size_t)b * SEQ + qb * 64 + wid * 8 + 6) * 2048 + g * 512), (unsigned)((lane >> 5) * 2048 + (lane & 31) * 16), (unsigned)__builtin_amdgcn_readfirstlane(zl + 1024u));
      (void)zsrc; }
    const LAS unsigned long long* mskp = MSK + (r32 >> 2);
    { LAS float* acc = (LAS float*)(lds + L_ACC) + wid * 2048;
#pragma unroll
      for (int r = 0; r < 16; ++r) { const int orow = crow(r, hi);
#pragma unroll
          for (int d0 = 0; d0 < 2; ++d0) acc[orow * 64 + d0 * 32 + r32] = oacc[d0][r]; } }
    { const bf16_t* Kw = (const bf16_t*)(ws + WS_KW) + (size_t)b * SEQ * 256 + g * 64; const bf16_t* Vw = (const bf16_t*)(ws + WS_VW) + (size_t)b * SEQ * 256 + g * 64;
      flash_branch<1, WIN_PREFETCH != 0>(lds, Kw, Vw, qr, qb, tl, mskp, gl + 64, wid, lane);
      if (PROBE_NSA == 2) flash_branch<1>(lds, Kw, Vw, qr, qb, tl, mskp, (const LAS float*)(lds + LDSCTL_OFF), wid, lane); }
    { const bf16_t* Ks = (const bf16_t*)(ws + WS_KS) + (size_t)b * SEQ * 256 + g * 64; const bf16_t* Vs = (const bf16_t*)(ws + WS_VS) + (size_t)b * SEQ * 256 + g * 64;
      flash_branch<0>(lds, Ks, Vs, qr, qb, tl, mskp, gl + 32, wid, lane);
      if (PROBE_NSA == 3) flash_branch<0>(lds, Ks, Vs, qr, qb, tl, mskp, (const LAS float*)(lds + LDSCTL_OFF), wid, lane); }
    for (int pro = 0; pro < (PROBE_NSA == 5 ? 2 : 1); ++pro)
    {
        const LAS float* acc = (const LAS float*)(lds + L_ACC) + wid * 2048;
#pragma unroll
        for (int i = 0; i < 4; ++i) { const int row = i * 8 + (lane >> 3), ch = lane & 7; const f32x4 a0 = *(const LAS f32x4*)(acc + row * 64 + ch * 8), a1 = *(const LAS f32x4*)(acc + row * 64 + ch * 8 + 4);
            const size_t off = ((size_t)b * SEQ + qb * 64 + wid * 8 + (row >> 2)) * 1024 + g * 256 + (row & 3) * 64 + ch * 8;
            const int tk_ = row >> 2; const LAS unsigned char* zp = lds + (tk_ < 4 ? L_GS : L_LS) + wid * 2048 + (tk_ & 3) * 512 + (row & 3) * 128 + ch * 16;
            const u32x4 zz = *(const LAS u32x4*)zp; f32x4 z0, z1; epi::unpack8(zz, z0, z1);
            *(u32x4*)(ATT + off) = epi::pack8(a0 * z0, a1 * z1); }
        LDS_WAIT();
    }
    __syncthreads();
#undef NSA_DMA_K
#undef NSA_DMA_V
}
__device__ __forceinline__ void nsa_phase(Frame& F) {
    if (F.G == 256) {
        const int bg = F.vcu >> 3, s = F.vcu & 7;
        for (int i = 0; i < 8; ++i) { const int k = i >> 1; const int qb = (i & 1) ? (63 - 8 * k - s) : (8 * k + s); nsa_unit(F, bg >> 2, bg & 3, qb); }
    } else {
        for (int u = F.vcu; u < 2048; u += F.G) nsa_unit(F, u >> 8, (u >> 6) & 3, u & 63);
    }
}
}

namespace ret {
__device__ __forceinline__ int crow(int r, int hi) { return (r & 3) + 8 * (r >> 2) + 4 * hi; }
__device__ __forceinline__ void p_phase(Frame& F) {
    const int lane = lane_id(), wid = F.wave, r32 = lane & 31, hi = lane >> 5;
    const bf16_t* Qp = (const bf16_t*)(F.ws + WS_QP); const bf16_t* Kp = (const bf16_t*)(F.out);
    bf16_t* PT = (bf16_t*)(F.ws + WS_PT);
    const int ib = wid & 3, jb0 = (wid >> 2) * 2;
    for (int it = F.vcu; it < 1024; it += F.G) {
        const int bh = it >> 5, c = it & 31, b = bh >> 2, h = bh & 3;
        const float ginv = __builtin_amdgcn_exp2f(-128.0f * epi::log2_gamma(h));
#pragma unroll
        for (int jj = 0; jj < 2; ++jj) { const int jb = jb0 + jj;
            if (jb > ib) {
#pragma unroll
                for (int a = 0; a < 4; ++a) *(u32x2*)(PT + ((((size_t)it * 4 + ib) * 8 + (2 * jb + (a >> 1))) * 2 + (a & 1)) * 256 + r32 * 8 + 4 * hi) = (u32x2){0u, 0u};
            } else {
                const bf16_t* ka = Kp + epi::qt_index(b, c * 128 + jb * 32, h, 0) + lane * 8; const bf16_t* qa = Qp + epi::qt_index(b, c * 128 + ib * 32, h, 0) + lane * 8;
                bf16x8 fa[16], fb[16];
#pragma unroll
                for (int ks = 0; ks < 16; ++ks) { fa[ks] = *(const bf16x8*)(ka + ks * 512); fb[ks] = *(const bf16x8*)(qa + ks * 512); }
                f32x16 acc = {};
#pragma unroll
                for (int ks = 0; ks < 16; ++ks) acc = __builtin_amdgcn_mfma_f32_32x32x16_bf16(fa[ks], fb[ks], acc, 0, 0, 0);
#pragma unroll
                for (int a = 0; a < 4; ++a) { float v[4];
#pragma unroll
                    for (int x = 0; x < 4; ++x) { const int jl = jb * 32 + 8 * a + 4 * hi + x; v[x] = (jl <= ib * 32 + r32) ? acc[4 * a + x] * ginv : 0.f; }
                    u32x2 w; w.x = cvt_pk_bf16(v[0], v[1]); w.y = cvt_pk_bf16(v[2], v[3]);
                    *(u32x2*)(PT + ((((size_t)it * 4 + ib) * 8 + (2 * jb + (a >> 1))) * 2 + (a & 1)) * 256 + r32 * 8 + 4 * hi) = w; }
            } }
    }
}
constexpr int ST_PITCH = 264;
__device__ __forceinline__ void scan_item(Frame& F, int b, int h, int s, bool do_stats) {
    const int lane = lane_id(), wid = F.wave, r32 = lane & 31, hi = lane >> 5, ib = wid & 3; const bool heavy = wid < 4;
    const bf16_t* Qp = (const bf16_t*)(F.ws + WS_QP); const bf16_t* Ktp = (const bf16_t*)(F.ws + WS_KTP); const bf16_t* Vt = (const bf16_t*)(F.ws + WS_VT); const bf16_t* PT = (const bf16_t*)(F.ws + WS_PT);
    bf16_t* O = (bf16_t*)(F.out); float* stats = (float*)(F.ws + WS_STATS);
    LAS bf16_t* St = (LAS bf16_t*)(F.lds);
    const int bh = b * 4 + h;
    const float l2g = epi::log2_gamma(h), g128 = __builtin_amdgcn_exp2f(128.0f * l2g);
    const bf16_t* vB0 = Vt + epi::tt_index(bh, 16, s * 64, 0) + lane * 8;
    const bf16_t* vB1 = Vt + epi::tt_index(bh, 16, s * 64 + 32, 0) + lane * 8;
    const bf16_t* kA = Ktp + epi::tt_index(bh, 8, wid * 32, 0) + lane * 8;
    const bf16_t* qB = Qp + epi::qt_index(b, ib * 32, h, 0) + lane * 8;
    const bf16_t* pB = PT + (((size_t)bh * 32) * 4 + ib) * 8 * 512 + lane * 8;
    constexpr int ST_BYTES = 64 * ST_PITCH * 2, VT_OFF = 2 * ST_BYTES, OST_OFF = VT_OFF + 32768, OST_BYTES = 128 * 136;
    const bf16_t* vS = Vt + epi::tt_index(bh, 16, s * 64 + (wid >> 2) * 32, 0);
    const unsigned vdst0 = (unsigned)(uintptr_t)(F.lds + VT_OFF) + (unsigned)wid * 2048u;
#define VT_DMA(c_, buf_) do { const char* src_ = (const char*)(vS + (size_t)((c_) * 8 + 2 * (wid & 3)) * 512); \
        nsa::glds16(uni_ptr(src_), (unsigned)lane * 16u, (unsigned)__builtin_amdgcn_readfirstlane(vdst0 + (buf_) * 16384u)); \
        nsa::glds16(uni_ptr(src_ + 1024), (unsigned)lane * 16u, (unsigned)__builtin_amdgcn_readfirstlane(vdst0 + (buf_) * 16384u + 1024u)); } while (0)
    const LAS bf16_t* vl = (const LAS bf16_t*)(F.lds + VT_OFF) + lane * 8;
    f32x16 S0 = {}, S1 = {};
    bf16x8 kaf[8], ipb[8], qf[16];
#define LOAD_KA(c_) do { _Pragma("unroll") for (int ks = 0; ks < 8; ++ks) kaf[ks] = *(const bf16x8*)(kA + (size_t)((c_) * 8 + ks) * 512); } while (0)
#define LOAD_PB(c_) do { _Pragma("unroll") for (int ks = 0; ks < 8; ++ks) ipb[ks] = *(const bf16x8*)(pB + (size_t)(c_) * (4 * 8 * 512) + ks * 512); } while (0)
#define LOAD_Q(c_)  do { _Pragma("unroll") for (int ks = 0; ks < 16; ++ks) qf[ks] = *(const bf16x8*)(qB + (size_t)(c_) * (4 * 4 * 16 * 512) + ks * 512); } while (0)
#define STORE_ROWS(c_) do { _Pragma("unroll") for (int i2 = 0; i2 < 2; ++i2) { const int row = wid * 16 + i2 * 8 + (lane >> 3), q = lane & 7; const LAS unsigned char* os = F.lds + OST_OFF + ((c_) & 1) * OST_BYTES + row * 136 + q * 16; \
            const u32x2 lo = *(const LAS u32x2*)os, hi2 = *(const LAS u32x2*)(os + 8); \
            *(u32x4*)(O + ((size_t)b * SEQ + (c_) * 128 + row) * 2048 + h * 512 + s * 64 + q * 8) = (u32x4){lo.x, lo.y, hi2.x, hi2.y}; } \
        if (heavy && hi == 0 && do_stats) { float* sp = stats + ((size_t)bh * 2) * SEQ + (c_) * 128 + ib * 32 + r32; atomicAdd(sp, ps1); atomicAdd(sp + SEQ, ps2); } } while (0)
    float ps1 = 0.f, ps2 = 0.f;
    VT_DMA(0, 0);
    LOAD_KA(0); if (heavy) LOAD_PB(0);
    asm volatile("s_waitcnt vmcnt(0)\n\ts_barrier" ::: "memory");
    for (int c = 0; c < 32; ++c) {
        const LAS bf16_t* vb = vl + (c & 1) * 8192;
        const LAS bf16_t* sa = St + (c & 1) * (64 * ST_PITCH) + r32 * ST_PITCH + hi * 8;
        LAS bf16_t* Stn = St + ((c + 1) & 1) * (64 * ST_PITCH);
        if (c < 31) VT_DMA(c + 1, (c + 1) & 1);
        if (c > 0) { if (heavy) LOAD_Q(c); STORE_ROWS(c - 1); }
        if (c < 31) {
#pragma unroll
            for (int r = 0; r < 16; ++r) { S0[r] *= g128; S1[r] *= g128; }
#pragma unroll
            for (int ks = 0; ks < 8; ++ks) { S0 = __builtin_amdgcn_mfma_f32_32x32x16_bf16(kaf[ks], *(const LAS bf16x8*)(vb + ks * 512), S0, 0, 0, 0); S1 = __builtin_amdgcn_mfma_f32_32x32x16_bf16(kaf[ks], *(const LAS bf16x8*)(vb + (8 + ks) * 512), S1, 0, 0, 0); }
            if (c < 30) LOAD_KA(c + 1);
#pragma unroll
            for (int a = 0; a < 4; ++a) { u32x2 w; w.x = cvt_pk_bf16(S0[4 * a], S0[4 * a + 1]); w.y = cvt_pk_bf16(S0[4 * a + 2], S0[4 * a + 3]); *(LAS u32x2*)(Stn + r32 * ST_PITCH + wid * 32 + 8 * a + 4 * hi) = w;
                w.x = cvt_pk_bf16(S1[4 * a], S1[4 * a + 1]); w.y = cvt_pk_bf16(S1[4 * a + 2], S1[4 * a + 3]); *(LAS u32x2*)(Stn + (32 + r32) * ST_PITCH + wid * 32 + 8 * a + 4 * hi) = w; }
        }
        if (heavy) {
            f32x16 oc0 = {}, oc1 = {};
#pragma unroll
            for (int ks = 0; ks < 8; ++ks) { oc0 = __builtin_amdgcn_mfma_f32_32x32x16_bf16(*(const LAS bf16x8*)(vb + ks * 512), ipb[ks], oc0, 0, 0, 0); oc1 = __builtin_amdgcn_mfma_f32_32x32x16_bf16(*(const LAS bf16x8*)(vb + (8 + ks) * 512), ipb[ks], oc1, 0, 0, 0); }
            if (c < 31) LOAD_PB(c + 1);
            if (c > 0) {
#pragma unroll
                for (int ks = 0; ks < 16; ++ks) { oc0 = __builtin_amdgcn_mfma_f32_32x32x16_bf16(*(const LAS bf16x8*)(sa + ks * 16), qf[ks], oc0, 0, 0, 0); oc1 = __builtin_amdgcn_mfma_f32_32x32x16_bf16(*(const LAS bf16x8*)(sa + 32 * ST_PITCH + ks * 16), qf[ks], oc1, 0, 0, 0); } }
            float s1 = 0.f, s2 = 0.f;
#pragma unroll
            for (int r = 0; r < 16; ++r) { s1 += oc0[r] + oc1[r]; s2 += oc0[r] * oc0[r] + oc1[r] * oc1[r]; }
            ps1 = nsa::halfsum(s1); ps2 = nsa::halfsum(s2);
            LAS unsigned char* ow = F.lds + OST_OFF + (c & 1) * OST_BYTES + (ib * 32 + r32) * 136 + (4 * hi) * 2;
#pragma unroll
            for (int a = 0; a < 4; ++a) { u32x2 w; w.x = cvt_pk_bf16(oc0[4 * a], oc0[4 * a + 1]); w.y = cvt_pk_bf16(oc0[4 * a + 2], oc0[4 * a + 3]); *(LAS u32x2*)(ow + 16 * a) = w;
                w.x = cvt_pk_bf16(oc1[4 * a], oc1[4 * a + 1]); w.y = cvt_pk_bf16(oc1[4 * a + 2], oc1[4 * a + 3]); *(LAS u32x2*)(ow + 64 + 16 * a) = w; }
        }
        asm volatile("s_waitcnt vmcnt(0) lgkmcnt(0)\n\ts_barrier" ::: "memory");
    }
    STORE_ROWS(31);
#undef LOAD_KA
#undef LOAD_PB
#undef LOAD_Q
#undef STORE_ROWS
#undef VT_DMA
    __syncthreads();
}
__device__ __forceinline__ void scan_phase(Frame& F, bool do_stats) {
    for (int it = F.vcu; it < 256; it += F.G) scan_item(F, it >> 5, (it >> 3) & 3, it & 7, do_stats);
}
}

__global__ void __launch_bounds__(NWAVES * 64, 2) mk_fwd(Args args) {
    extern __shared__ __attribute__((aligned(16))) unsigned char lds_raw[];
    Frame F;
    F.lds = (LAS unsigned char*)lds_raw;
    F.MISC = (volatile LAS unsigned*)(F.lds + MISC_OFF);
    F.wave = __builtin_amdgcn_readfirstlane(threadIdx.x >> 6);
    F.G = gridDim.x; { const int bx = blockIdx.x; F.vcu = (F.G % 8 == 0) ? (bx % 8) * (F.G / 8) + bx / 8 : bx; }
    F.out = args.out; F.ws = args.ws; F.ctl = (unsigned*)(args.ws + WS_CTL);
    unsigned char* ws = F.ws; unsigned char* dout = F.out;
    for (int u = F.wave * 64 + lane_id(); u < (LDS_BYTES - LDSCTL_OFF) / 4; u += NWAVES * 64) ((LAS unsigned*)(F.lds + LDSCTL_OFF))[u] = 0u;
    __syncthreads();
    XcdBarrier bar = xcd_barrier_post(F.ctl + CW_BAR, F.MISC + 8, F.wave);
    cg::grid_group grid = cg::this_grid();
    const int lo = args.ph_lo, hi = args.ph_hi, bx = (int)blockIdx.x, G = F.G;
#ifndef PROBE_PH
#define PROBE_PH (-1)
#endif
#ifndef PROBE_GEMM
#define PROBE_GEMM 0
#endif
#define REPS(k, isgemm) (((PROBE_PH) == (k) || ((isgemm) && PROBE_GEMM)) ? 2 : 1)
#define IN(k) (lo <= (k) && (k) < hi)
#if defined(PROBE_BAR)
#define SEAM(k) do { if (IN(k) && IN((k) + 1)) { xcd_barrier(bar); xcd_barrier(bar); } } while (0)
#else
#define SEAM(k) do { if (IN(k) && IN((k) + 1)) xcd_barrier(bar); } while (0)
#endif
    LAS unsigned char* ring = F.lds;

    if (hi < 0) grid.sync();
    if (IN(0)) { for (int rep = 0; rep < REPS(0, 0); ++rep) p0_prologue(F, args, rep == 0); if (IN(1)) xcd_barrier(bar); }

    if (IN(1)) for (int rep = 0; rep < REPS(1, 1); ++rep) {
        pg8::Gemm g{(const char*)(ws + WS_XB), (const char*)(ws + WS_WNIN), 2048u, 2048u, 128u, 128u, 1024};
        pg8::SchedStd S; S.init(128, 14, 0, G, bx, (size_t)256 * 2048, (size_t)256 * 2048);
        epi::NsaIn E{ws, dout};
        pg8::gemm_phase<epi::NsaIn, pg8::SchedStd, false>(ring, F.wave, g, S, E);
    }
    SEAM(1);
    if (IN(2)) for (int rep = 0; rep < REPS(2, 0); ++rep) {
        const bool cmp_cu = (G == 256) ? (bx < 64) : true, other_cu = (G == 256) ? (bx >= 64) : true;
        if (cmp_cu) {
            pg8::Gemm g{(const char*)(ws + WS_KC), (const char*)(ws + WS_WC1K), 8192u, 4096u, 512u, 128u, 2048};
            pg8::SchedCmp S{G, bx, WS_VC - WS_KC, WS_WC1V - WS_WC1K};
            epi::Cmp1 E{ws};
            pg8::gemm_phase<epi::Cmp1, pg8::SchedCmp, false>(ring, F.wave, g, S, E);
            VM_WAIT(); __syncthreads();
            __builtin_amdgcn_fence(__ATOMIC_ACQUIRE, "agent"); VM_WAIT();
            for (int u = bx; u < 64; u += G) cmp2_task(F, (u >> 5) * 256 + (u & 31) * 8 + F.wave);
        }
        { const int G2 = (G == 256) ? (cmp_cu ? 64 : 192) : G, c2 = (G == 256) ? (cmp_cu ? bx : bx - 64) : bx, u0 = (G == 256 && !cmp_cu) ? 64 : 0, u1 = (G == 256 && cmp_cu) ? 64 : 512;
          { pg8::Gemm g{(const char*)(ws + WS_PB0), (const char*)(ws + WS_WP0), 512u, 512u, 128u, 128u, 256};
            pg8::SchedStd S; S.init(128, 4, 0, G2, c2, (size_t)256 * 512, (size_t)256 * 512); S.range(u0, u1);
            epi::Bf16Plain E{(bf16_t*)(ws + WS_E0), 1024, 0};
            pg8::gemm_phase<epi::Bf16Plain, pg8::SchedStd, false>(ring, F.wave, g, S, E); }
          { pg8::Gemm g{(const char*)(ws + WS_PB1), (const char*)(ws + WS_WP1), 512u, 512u, 128u, 128u, 256};
            pg8::SchedStd S; S.init(128, 4, 0, G2, c2, (size_t)256 * 512, (size_t)256 * 512); S.range(u0, u1);
            epi::Bf16Plain E{(bf16_t*)(ws + WS_E1), 1024, 0};
            pg8::gemm_phase<epi::Bf16Plain, pg8::SchedStd, false>(ring, F.wave, g, S, E); }
          if (G == 256) { if (bx >= 128) for (int task = (bx - 128) * NWAVES + F.wave; task < 1024; task += 128 * NWAVES) gates_task(F, task); }
          else for (int task = bx * NWAVES + F.wave; task < 1024; task += G * NWAVES) gates_task(F, task);
          (void)other_cu; }
    }
    SEAM(3);
    if (IN(4)) for (int rep = 0; rep < REPS(4, 0); ++rep) nsa::nsa_phase(F);
    SEAM(4);
    if (IN(5)) for (int rep = 0; rep < REPS(5, 1); ++rep) {
        pg8::Gemm g{(const char*)(ws + WS_ATT), (const char*)(ws + WS_WNOUT), 2048u, 2048u, 128u, 128u, 1024};
        pg8::SchedStd S; S.init(128, 4, 0, G, bx, (size_t)256 * 2048, (size_t)256 * 2048);
        epi::Res<0> E{args.in[0], ws};
        pg8::gemm_phase<epi::Res<0>, pg8::SchedStd, false>(ring, F.wave, g, S, E);
    }
    SEAM(5);
    if (IN(6)) {
        pg8::Gemm g{(const char*)(ws + WS_X1B), (const char*)(ws + WS_WG0), 2048u, 2048u, 128u, 128u, 1024};
        pg8::SchedStd S; S.init(128, 4, 0, G, bx, (size_t)256 * 2048, (size_t)256 * 2048);
        epi::Ple<0> E{ws, dout};
        pg8::gemm_phase<epi::Ple<0>, pg8::SchedStd, false>(ring, F.wave, g, S, E);
    }
    SEAM(6);
    if (IN(7)) for (int rep = 0; rep < REPS(7, 1); ++rep) {
        pg8::Gemm g{(const char*)(ws + WS_XB), (const char*)(ws + WS_WRIN), 2048u, 2048u, 128u, 128u, 1024};
        { pg8::SchedStd S; S.init(128, 4, 0, G, bx, (size_t)256 * 2048, (size_t)256 * 2048);
          epi::RetQ E{ws};
          pg8::gemm_phase<epi::RetQ, pg8::SchedStd, false>(ring, F.wave, g, S, E);
#if defined(PROBE_P7) && PROBE_P7 == 1
          pg8::gemm_phase<epi::RetQ, pg8::SchedStd, false>(ring, F.wave, g, S, E);
#endif
          }
        { pg8::SchedStd S; S.init(128, 12, 4, G, bx, (size_t)256 * 2048, (size_t)256 * 2048);
          epi::RetKV E{ws, dout};
          pg8::gemm_phase<epi::RetKV, pg8::SchedStd, true>(ring, F.wave, g, S, E);
#if defined(PROBE_P7) && PROBE_P7 == 2
          pg8::gemm_phase<epi::RetKV, pg8::SchedStd, true>(ring, F.wave, g, S, E);
#endif
          }
    }
    SEAM(7);
    if (IN(8)) for (int rep = 0; rep < REPS(8, 0); ++rep) ret::p_phase(F);
    SEAM(8);
    if (IN(9)) for (int rep = 0; rep < REPS(9, 0); ++rep) ret::scan_phase(F, rep == 0);
    SEAM(9);
    if (IN(10)) {
        pg8::Gemm g{(const char*)(ws + WS_XB), (const char*)(ws + WS_WRIN), 2048u, 2048u, 128u, 128u, 1024};
        pg8::SchedStd S; S.init(128, 8, 16, G, bx, (size_t)256 * 2048, (size_t)256 * 2048);
        epi::RetZ E{ws, dout};
        pg8::gemm_phase<epi::RetZ, pg8::SchedStd, false>(ring, F.wave, g, S, E);
    }
    SEAM(10);
    if (IN(11)) for (int rep = 0; rep < REPS(11, 1); ++rep) {
        { pg8::Gemm g{(const char*)dout, (const char*)(ws + WS_WROUT), 4096u, 4096u, 128u, 128u, 2048};
          pg8::SchedStd S; S.init(128, 4, 0, G, bx, (size_t)256 * 4096, (size_t)256 * 4096);
          epi::Res<1> E{nullptr, ws};
          pg8::gemm_phase<epi::Res<1>, pg8::SchedStd, false>(ring, F.wave, g, S, E); }
    }
    SEAM(11);
    if (IN(12)) for (int rep = 0; rep < REPS(12, 1); ++rep) {
        pg8::Gemm g{(const char*)(ws + WS_X3B), (const char*)(ws + WS_WG1), 2048u, 2048u, 128u, 128u, 1024};
        pg8::SchedStd S; S.init(128, 4, 0, G, bx, (size_t)256 * 2048, (size_t)256 * 2048);
        epi::Ple<1> E{ws, dout};
        pg8::gemm_phase<epi::Ple<1>, pg8::SchedStd, false>(ring, F.wave, g, S, E);
    }
#undef IN
#undef SEAM
}

extern "C" void kernel_launch(void* const* d_in, const int* in_sizes, int n_in, void* d_out, int out_size, void* d_ws, size_t ws_size, hipStream_t stream) {
    static int grid = 0;
    if (grid == 0) {
        if (n_in != 19 || out_size != T_TOK * DM || ws_size < WS_END) { fprintf(stderr, "kernel_launch: unexpected problem (n_in %d, out %d, ws %zu)\n", n_in, out_size, ws_size); grid = -1; return; }
        int dev = 0, cus = 0, per_cu = 0;
        (void)hipGetDevice(&dev); (void)hipDeviceGetAttribute(&cus, hipDeviceAttributeMultiprocessorCount, dev);
        if (hipFuncSetAttribute((const void*)mk_fwd, hipFuncAttributeMaxDynamicSharedMemorySize, LDS_BYTES) != hipSuccess) { fprintf(stderr, "kernel_launch: hipFuncSetAttribute failed\n"); grid = -1; return; }
        if (hipOccupancyMaxActiveBlocksPerMultiprocessor(&per_cu, (const void*)mk_fwd, NWAVES * 64, LDS_BYTES) != hipSuccess || per_cu < 1) { fprintf(stderr, "kernel_launch: occupancy query gave %d\n", per_cu); per_cu = 1; }
        (void)hipGetLastError();
        if (per_cu > 1) per_cu = 1;
        grid = cus * per_cu;
    }
    if (grid < 0) return;
    (void)hipMemsetAsync((char*)d_ws + WS_CTL, 0, ZERO_BYTES, stream);
    Args a{};
    for (int i = 0; i < 19; ++i) a.in[i] = (const float*)d_in[i];
    a.out = (unsigned char*)d_out; a.ws = (unsigned char*)d_ws; a.ph_lo = 0; a.ph_hi = 13;
    void* kargs[] = {&a};
    hipError_t e = hipLaunchCooperativeKernel((const void*)mk_fwd, dim3(grid), dim3(NWAVES * 64), kargs, LDS_BYTES, stream);
    if (e != hipSuccess) fprintf(stderr, "kernel_launch: cooperative launch failed: %s (grid %d)\n", hipGetErrorString(e), grid);
}
```

```cpp
#include <hip/hip_runtime.h>
#include <hip/hip_cooperative_groups.h>
#include <cstdio>
#include <cstdint>
namespace cg = cooperative_groups;

#define LAS __attribute__((address_space(3)))
#define GAS __attribute__((address_space(1)))
typedef unsigned short bf16_t;
typedef short bf16x8 __attribute__((ext_vector_type(8)));
typedef short s16x4 __attribute__((ext_vector_type(4)));
typedef float f32x2 __attribute__((ext_vector_type(2)));
typedef float f32x4 __attribute__((ext_vector_type(4)));
typedef float f32x16 __attribute__((ext_vector_type(16)));
typedef unsigned u32x2 __attribute__((ext_vector_type(2)));
typedef unsigned u32x4 __attribute__((ext_vector_type(4)));

constexpr int T_TOK = 32768, SEQ = 4096, NB = 8, DM = 1024;
constexpr float LOG2E = 1.4426950408889634f;
constexpr float RMS_EPS = 1e-6f, GN_EPS = 1e-5f;

typedef __bf16 bf16x2_t __attribute__((ext_vector_type(2)));
__device__ __forceinline__ unsigned cvt_pk_bf16(float lo, float hi) { const f32x2 v = {lo, hi}; const bf16x2_t b = __builtin_convertvector(v, bf16x2_t); return __builtin_bit_cast(unsigned, b); }
__device__ __forceinline__ float bf_lo(unsigned w) { return __uint_as_float(w << 16); }
__device__ __forceinline__ float bf_hi(unsigned w) { return __uint_as_float(w & 0xffff0000u); }
__device__ __forceinline__ int lane_id() { int l; asm volatile("v_mbcnt_lo_u32_b32 %0, -1, 0\n\tv_mbcnt_hi_u32_b32 %0, -1, %0" : "=v"(l)); return l; }
__device__ __forceinline__ const char* uni_ptr(const char* p) {
    const unsigned long long v = (unsigned long long)p; const unsigned lo = __builtin_amdgcn_readfirstlane((unsigned)v), hi = __builtin_amdgcn_readfirstlane((unsigned)(v >> 32));
    return (const char*)(((unsigned long long)hi << 32) | lo); }
__device__ __forceinline__ float fast_rcp(float x) { return __builtin_amdgcn_rcpf(x); }
__device__ __forceinline__ float sigmoidf_(float x) { return fast_rcp(1.0f + __builtin_amdgcn_exp2f(-x * LOG2E)); }
__device__ __forceinline__ float siluf_(float x) { return x * sigmoidf_(x); }

#ifndef LD_ONCE_NT
#define LD_ONCE_NT 1
#endif
#if LD_ONCE_NT
#define LD_ONCE(p) __builtin_nontemporal_load(p)
#else
#define LD_ONCE(p) (*(p))
#endif
#ifndef FAR_ST_MODE
#define FAR_ST_MODE 1
#endif
template <class T> __device__ __forceinline__ void st_nt(T* p, const T v) {
    if constexpr (FAR_ST_MODE == 0) *p = v;
    else if constexpr (FAR_ST_MODE == 1) __builtin_nontemporal_store(v, p);
    else if constexpr (sizeof(T) == 16) { if constexpr (FAR_ST_MODE == 2) asm volatile("global_store_dwordx4 %0, %1, off sc1\n\ts_nop 1" :: "v"(p), "v"(v) : "memory"); else asm volatile("global_store_dwordx4 %0, %1, off sc0 sc1\n\ts_nop 1" :: "v"(p), "v"(v) : "memory"); }
    else { static_assert(sizeof(T) == 8, "st_nt: 8- or 16-byte vectors"); if constexpr (FAR_ST_MODE == 2) asm volatile("global_store_dwordx2 %0, %1, off sc1\n\ts_nop 1" :: "v"(p), "v"(v) : "memory"); else asm volatile("global_store_dwordx2 %0, %1, off sc0 sc1\n\ts_nop 1" :: "v"(p), "v"(v) : "memory"); }
}
__device__ __forceinline__ void st_wt(u32x4* p, const u32x4 v) { asm volatile("global_store_dwordx4 %0, %1, off sc1" :: "v"(p), "v"(v) : "memory"); }
__device__ __forceinline__ void st_wt01(u32x4* p, const u32x4 v) { asm volatile("global_store_dwordx4 %0, %1, off sc0 sc1" :: "v"(p), "v"(v) : "memory"); }
namespace pg8 {
constexpr int BM = 256, BK = 64, HALF = 128, HTB = HALF * BK * 2, STAGE_BYTES = 8 * HTB, NXCD = 8, WGM = 8;
__host__ __device__ __forceinline__ int lds_byte(int r, int c) { const int st = (r >> 4) * 2 + (c >> 5), rr = r & 15, cc = c & 31, ob = rr * 64 + cc * 2; return st * 1024 + (ob ^ (((ob >> 9) & 1) << 5)); }
__host__ __device__ __forceinline__ void stage_rc(int b, int& R, int& C) { const int st = b / 1024, sb = b % 1024, swz = sb ^ (((sb >> 9) & 1) << 5); R = (st >> 1) * 16 + swz / 64; C = (st & 1) * 32 + (swz % 64) / 2; }
__host__ __device__ __forceinline__ int perm32(int rho) { const int n = rho >> 4, i = rho & 15; return 8 * (i >> 2) + 4 * n + (i & 3); }

struct Unit { int pm, pn; };
struct Gemm { const char* A; const char* Bt; unsigned lda, ldb; unsigned ksA, ksB; int K; };

struct SchedStd {
    int nM, nN, nwg, G, c, pn0, first, last; size_t a_ts, b_ts;
    __device__ __forceinline__ void init(int nM_, int nN_, int pn0_, int G_, int c_, size_t a_ts_, size_t b_ts_) { nM = nM_; nN = nN_; nwg = nM * nN; G = G_; c = c_; pn0 = pn0_; a_ts = a_ts_; b_ts = b_ts_; first = 0; last = nwg; }
    __device__ __forceinline__ void range(int first_, int last_) { first = first_; last = last_; }
    __device__ __forceinline__ bool next(int i, Unit& u) const {
        const long L = (long)first + (long)i * G + c; if (L >= last) return false;
        int wgid = (int)L; { const int q = nwg / NXCD, r = nwg % NXCD, xcd = wgid % NXCD, off = wgid / NXCD; wgid = (xcd < r ? xcd * (q + 1) : r * (q + 1) + (xcd - r) * q) + off; }
#if defined(SCHED_PNMAJOR)
        u.pm = (int)(L % nM); u.pn = pn0 + (int)(L / nM); return true;
#else
        const int nig = WGM * nN, gid = wgid / nig, fm = gid * WGM, gsz = (nM - fm) < WGM ? (nM - fm) : WGM;
        u.pm = fm + ((wgid % nig) % gsz); u.pn = pn0 + (wgid % nig) / gsz; return true;
#endif
    }
    __device__ __forceinline__ unsigned a_off(const Unit& u) const { return (unsigned)u.pm * (unsigned)a_ts; }
    __device__ __forceinline__ unsigned b_off(const Unit& u) const { return (unsigned)u.pn * (unsigned)b_ts; }
};
struct SchedCmp {
    int G, c; size_t kv_stride_a, kv_stride_b;
    __device__ __forceinline__ bool next(int i, Unit& u) const { const int L = i * G + c; if (L >= 64) return false; u.pm = L; u.pn = 0; return true; }
    __device__ __forceinline__ unsigned a_off(const Unit& u) const { return (unsigned)(u.pm >> 5) * (unsigned)kv_stride_a + (unsigned)((u.pm >> 2) & 7) * (unsigned)(SEQ * 512) + (unsigned)(u.pm & 3) * 128u; }
    __device__ __forceinline__ unsigned b_off(const Unit& u) const { return (unsigned)(u.pm >> 5) * (unsigned)kv_stride_b; }
};

template <class Epi, class Sched, bool SWAP>
__device__ __forceinline__ void gemm_phase(LAS unsigned char* lds, const int wid, const Gemm g, const Sched& S, const Epi& E) {
    const int lane = lane_id(), tid = wid * 64 + lane, wr = wid >> 2, wc = wid & 3, fr = lane & 15, fq = lane >> 4;
    const int nt = g.K / BK;
    unsigned voffA[2], voffB[2];
#pragma unroll
    for (int i = 0; i < 2; ++i) { int R, C; stage_rc(tid * 16 + i * 8192, R, C); const int Rb = (!SWAP) ? ((R & ~31) + perm32(R & 31)) : R;
        voffA[i] = (unsigned)R * g.lda + (unsigned)C * 2u; voffB[i] = (unsigned)Rb * g.ldb + (unsigned)C * 2u; }
    const unsigned ksA = g.ksA, ksB = g.ksB;
    const unsigned hsA = (unsigned)HALF * g.lda, hsB = (unsigned)HALF * g.ldb;
    const unsigned ldsw = (unsigned)wid * 1024u;
    const int aoff = lds_byte(wr * 64 + fr, fq * 8), boff = lds_byte(wc * 32 + fr, fq * 8);
    const __amdgpu_buffer_rsrc_t rsA = __builtin_amdgcn_make_buffer_rsrc((void*)g.A, (short)0, 0x7fffffff, 0x00020000);
    const __amdgpu_buffer_rsrc_t rsB = __builtin_amdgcn_make_buffer_rsrc((void*)g.Bt, (short)0, 0x7fffffff, 0x00020000);
#define PG8_SA(b, h) (((b) * 2 + (h)) * HTB)
#define PG8_SB(b, h) ((4 + (b) * 2 + (h)) * HTB)
#define PG8_STAGE(bufoff, rs, soff, voff) do { _Pragma("unroll") for (int _i = 0; _i < 2; ++_i) \
        __builtin_amdgcn_raw_ptr_buffer_load_lds((rs), (LAS unsigned*)(lds + (bufoff) + ldsw + _i * 8192), 16, (int)(voff)[_i], (int)(soff), 0, 0); } while (0)
#define PG8_LDA(dst, b, h) do { _Pragma("unroll") for (int m = 0; m < 4; ++m) _Pragma("unroll") for (int k = 0; k < 2; ++k) dst[m][k] = *(const LAS bf16x8*)(lds + PG8_SA(b, h) + aoff + m * 2048 + k * 1024); } while (0)
#define PG8_LDB(dst, b, h) do { _Pragma("unroll") for (int n = 0; n < 2; ++n) _Pragma("unroll") for (int k = 0; k < 2; ++k) dst[n][k] = *(const LAS bf16x8*)(lds + PG8_SB(b, h) + boff + n * 2048 + k * 1024); } while (0)
#define PG8_MMA(ai, bj, At, Bt) do { __builtin_amdgcn_s_setprio(1); _Pragma("unroll") for (int m = 0; m < 4; ++m) _Pragma("unroll") for (int n = 0; n < 2; ++n) _Pragma("unroll") for (int k = 0; k < 2; ++k) \
        acc[ai][bj][m][n] = SWAP ? __builtin_amdgcn_mfma_f32_16x16x32_bf16(At[m][k], Bt[n][k], acc[ai][bj][m][n], 0, 0, 0) : __builtin_amdgcn_mfma_f32_16x16x32_bf16(Bt[n][k], At[m][k], acc[ai][bj][m][n], 0, 0, 0); __builtin_amdgcn_s_setprio(0); } while (0)
#define PG8_WAIT_V(n) asm volatile("s_waitcnt vmcnt(" #n ")" ::: "memory")
#define PG8_WAIT_L(n) asm volatile("s_waitcnt lgkmcnt(" #n ")" ::: "memory")
#define PG8_BAR __builtin_amdgcn_s_barrier()
#define PG8_SCHED __builtin_amdgcn_sched_barrier(0)
    Unit cur, nxt; int ui = 0;
    if (!S.next(0, cur)) return;
    f32x4 acc[2][2][4][2];
#pragma unroll
    for (int a = 0; a < 2; ++a)
#pragma unroll
        for (int b = 0; b < 2; ++b)
#pragma unroll
            for (int m = 0; m < 4; ++m)
#pragma unroll
                for (int n = 0; n < 2; ++n) acc[a][b][m][n] = (f32x4){0.f, 0.f, 0.f, 0.f};
    bf16x8 At[4][2], B0[2][2], B1[2][2];
    unsigned cA = S.a_off(cur), cB = S.b_off(cur);
    PG8_STAGE(PG8_SB(0, 0), rsB, cB, voffB); PG8_STAGE(PG8_SB(0, 1), rsB, cB + hsB, voffB); PG8_STAGE(PG8_SA(0, 0), rsA, cA, voffA); PG8_STAGE(PG8_SA(0, 1), rsA, cA + hsA, voffA);
    if (wr == 1) PG8_BAR;
    PG8_WAIT_V(2); PG8_BAR;
    PG8_STAGE(PG8_SB(1, 0), rsB, cB + ksB, voffB); PG8_STAGE(PG8_SA(1, 0), rsA, cA + ksA, voffA); PG8_STAGE(PG8_SB(1, 1), rsB, cB + hsB + ksB, voffB);
    PG8_WAIT_V(6); PG8_BAR;
    for (;;) {
        const bool has_next = S.next(ui + 1, nxt);
        const unsigned nA = has_next ? S.a_off(nxt) : cA, nB = has_next ? S.b_off(nxt) : cB;
        for (int t = 0; t < nt; t += 2) {
            const bool last = (t == nt - 2);
            const unsigned a1 = cA + (unsigned)(t + 1) * ksA;
            const unsigned a2 = last ? nA : cA + (unsigned)(t + 2) * ksA, b2 = last ? nB : cB + (unsigned)(t + 2) * ksB;
            const unsigned a3 = a2 + ksA, b3 = b2 + ksB;
            PG8_LDB(B0, 0, 0); PG8_LDB(B1, 0, 1); PG8_SCHED; PG8_LDA(At, 0, 0); PG8_STAGE(PG8_SA(1, 1), rsA, a1 + hsA, voffA);
            PG8_WAIT_V(8); PG8_WAIT_L(0); PG8_BAR; PG8_MMA(0, 0, At, B0); PG8_MMA(0, 1, At, B1); PG8_BAR; PG8_SCHED;
            PG8_LDA(At, 0, 1); PG8_STAGE(PG8_SB(0, 0), rsB, b2, voffB); PG8_STAGE(PG8_SB(0, 1), rsB, b2 + hsB, voffB); PG8_STAGE(PG8_SA(0, 0), rsA, a2, voffA);
            PG8_WAIT_V(8); PG8_WAIT_L(0); PG8_BAR; PG8_MMA(1, 0, At, B0); PG8_MMA(1, 1, At, B1); PG8_BAR; PG8_SCHED;
            PG8_LDB(B0, 1, 0); PG8_LDB(B1, 1, 1); PG8_SCHED; PG8_LDA(At, 1, 0); PG8_STAGE(PG8_SA(0, 1), rsA, a2 + hsA, voffA);
            PG8_WAIT_V(8); PG8_WAIT_L(0); PG8_BAR; PG8_MMA(0, 0, At, B0); PG8_MMA(0, 1, At, B1); PG8_BAR; PG8_SCHED;
            PG8_LDA(At, 1, 1); PG8_STAGE(PG8_SB(1, 0), rsB, b3, voffB); PG8_STAGE(PG8_SB(1, 1), rsB, b3 + hsB, voffB); PG8_STAGE(PG8_SA(1, 0), rsA, a3, voffA);
            PG8_WAIT_V(8); PG8_WAIT_L(0); PG8_BAR; PG8_MMA(1, 0, At, B0); PG8_MMA(1, 1, At, B1); PG8_BAR; PG8_SCHED;
        }
        if (wr == 0) PG8_BAR;
        E(acc, cur, wr, wc, fr, fq);
#if defined(PROBE_EPI)
        if (Epi::ID == PROBE_EPI) { asm volatile("" ::: "memory"); E(acc, cur, wr, wc, fr, fq); }
#endif
#if defined(PROBE_ST)
        if constexpr (Epi::ID == 30) { if (PROBE_ST != 4 || (blockIdx.x & 8)) { asm volatile("" ::: "memory"); E.probe(acc, cur, wr, wc, fr, fq); } }
#endif
        if (!has_next) break;
#pragma unroll
        for (int a = 0; a < 2; ++a)
#pragma unroll
            for (int b = 0; b < 2; ++b)
#pragma unroll
                for (int m = 0; m < 4; ++m)
#pragma unroll
                    for (int n = 0; n < 2; ++n) acc[a][b][m][n] = (f32x4){0.f, 0.f, 0.f, 0.f};
        cur = nxt; cA = nA; cB = nB; ++ui;
        if (wr == 1) PG8_BAR;
    }
    PG8_WAIT_V(0);
    PG8_BAR;
#undef PG8_SA
#undef PG8_SB
#undef PG8_STAGE
#undef PG8_LDA
#undef PG8_LDB
#undef PG8_MMA
#undef PG8_WAIT_V
#undef PG8_WAIT_L
#undef PG8_BAR
#undef PG8_SCHED
}
typedef f32x4 Acc[2][2][4][2];
}

constexpr size_t MiB = 1u << 20;
constexpr size_t WS_CTL = 0, WS_ROWSC0 = 1 * MiB, WS_ROWSS1 = 1 * MiB + 128 * 1024, WS_CBIAS = 1 * MiB + 256 * 1024, WS_GAINS = 1 * MiB + 264 * 1024, WS_STATS = 2 * MiB, ZERO_BYTES = 3 * MiB;
constexpr size_t WS_WRIN = 3 * MiB, WS_WROUT = 15 * MiB, WS_WG1 = 19 * MiB, WS_WP1 = 21 * MiB;
constexpr size_t WS_X2 = 22 * MiB;
constexpr size_t WS_XB = 150 * MiB;
constexpr size_t WS_PB0 = 214 * MiB;
constexpr size_t WS_KC = 230 * MiB, WS_VC = 246 * MiB, WS_KS = 262 * MiB, WS_VS = 278 * MiB, WS_KW = 294 * MiB, WS_VW = 310 * MiB;
constexpr size_t WS_G = 326 * MiB, WS_E0 = 332 * MiB, WS_ATT = 396 * MiB;
constexpr size_t WS_COS = 470 * MiB, WS_SIN = 472 * MiB, WS_COST = 102 * MiB, WS_SINT = 104 * MiB;
constexpr size_t WS_WNIN = 474 * MiB, WS_WNOUT = 482 * MiB, WS_WG0 = 484 * MiB, WS_WP0 = 486 * MiB, WS_WC1K = 487 * MiB, WS_WC1V = 488 * MiB, WS_WC2K = 489 * MiB, WS_WC2V = 489 * MiB + 65536, WS_WGT = 490 * MiB;
constexpr size_t WS_HID = 492 * MiB, WS_KCC = 500 * MiB, WS_VCC = 501 * MiB;
constexpr size_t WS_X1B = 230 * MiB;
constexpr size_t WS_QP = 214 * MiB, WS_KTP = 278 * MiB, WS_VT = 342 * MiB, WS_PT = 470 * MiB, WS_PB1 = 22 * MiB;
constexpr size_t WS_X3B = 342 * MiB, WS_E1 = 38 * MiB;
constexpr size_t WS_END = 512 * MiB;
constexpr size_t DO_Q = 0, DO_Z = 64 * MiB;
constexpr int CW_BAR = 4096;
constexpr int RING_BYTES = 131072, LDSCTL_OFF = 150016, MISC_OFF = LDSCTL_OFF + 320, LDS_GATE = 151552, LDS_BYTES = 154624;
constexpr int NWAVES = 8;


namespace epi {
using pg8::Unit; using pg8::Acc;
__device__ __forceinline__ u32x4 pack8(const f32x4& a, const f32x4& b) { u32x4 w; w.x = cvt_pk_bf16(a[0], a[1]); w.y = cvt_pk_bf16(a[2], a[3]); w.z = cvt_pk_bf16(b[0], b[1]); w.w = cvt_pk_bf16(b[2], b[3]); return w; }
__device__ __forceinline__ void unpack8(const u32x4& w, f32x4& a, f32x4& b) { a[0] = bf_lo(w.x); a[1] = bf_hi(w.x); a[2] = bf_lo(w.y); a[3] = bf_hi(w.y); b[0] = bf_lo(w.z); b[1] = bf_hi(w.z); b[2] = bf_lo(w.w); b[3] = bf_hi(w.w); }
__device__ __forceinline__ float dot4(const f32x4& a) { return (a[0] * a[0] + a[1] * a[1]) + (a[2] * a[2] + a[3] * a[3]); }

struct Bf16Plain {
    static constexpr int ID = 10;
    static constexpr bool PERM = true;
    bf16_t* O; int ldc; int col0;
    __device__ __forceinline__ void operator()(const Acc& acc, const Unit& u, int wr, int wc, int fr, int fq) const {
#pragma unroll
        for (int ai = 0; ai < 2; ++ai)
#pragma unroll
            for (int m = 0; m < 4; ++m) { const int row = u.pm * 256 + ai * 128 + wr * 64 + m * 16 + fr; bf16_t* rp = O + (size_t)row * ldc + (u.pn * 256 - col0 + wc * 32 + fq * 8);
#pragma unroll
                for (int bj = 0; bj < 2; ++bj) st_nt((u32x4*)(rp + bj * 128), (u32x4)(pack8(acc[ai][bj][m][0], acc[ai][bj][m][1]))); }
    }
};
struct Cmp1 {
    static constexpr int ID = 20;
    static constexpr bool PERM = true;
    unsigned char* ws;
    __device__ __forceinline__ void operator()(const Acc& acc, const Unit& u, int wr, int wc, int fr, int fq) const {
        bf16_t* H = (bf16_t*)(ws + WS_HID);
        const float* bb = (const float*)(ws + WS_CBIAS) + (u.pm >> 5) * 256;
        f32x4 bv[2][2];
#pragma unroll
        for (int bj = 0; bj < 2; ++bj)
#pragma unroll
            for (int n = 0; n < 2; ++n) bv[bj][n] = *(const f32x4*)(bb + bj * 128 + wc * 32 + fq * 8 + n * 4);
#pragma unroll
        for (int ai = 0; ai < 2; ++ai)
#pragma unroll
            for (int m = 0; m < 4; ++m) { const int row = u.pm * 256 + ai * 128 + wr * 64 + m * 16 + fr; bf16_t* rp = H + (size_t)row * 256 + (wc * 32 + fq * 8);
#pragma unroll
                for (int bj = 0; bj < 2; ++bj) { f32x4 v0 = acc[ai][bj][m][0] + bv[bj][0], v1 = acc[ai][bj][m][1] + bv[bj][1];
#pragma unroll
                    for (int x = 0; x < 4; ++x) { v0[x] = siluf_(v0[x]); v1[x] = siluf_(v1[x]); }
                    *(u32x4*)(rp + bj * 128) = pack8(v0, v1); } }
    }
};
struct NsaIn {
    static constexpr int ID = 30;
    static constexpr bool PERM = true;
    unsigned char* ws; unsigned char* dout;
    __device__ __forceinline__ void operator()(const Acc& acc, const Unit& u, int wr, int wc, int fr, int fq) const {
        const int pn = u.pn;
        const float* rowscale = (const float*)(ws + WS_ROWSC0); const float* gains = (const float*)(ws + WS_GAINS);
        const float *q_g = gains, *ks_g = gains + 128, *kw_g = gains + 192;
        bf16_t* Q = (bf16_t*)(dout + DO_Q); bf16_t* Z = (bf16_t*)(dout + DO_Z);
        const bool normed = (pn < 4) || pn == 6 || pn == 8;
        f32x4 gq[2][2];
        if (normed) { const float* gp = (pn < 4) ? q_g : (pn == 6 ? ks_g : kw_g); const float sc = (pn < 4) ? 0.125f * LOG2E : 1.0f;
#pragma unroll
            for (int bj = 0; bj < 2; ++bj)
#pragma unroll
                for (int n = 0; n < 2; ++n) gq[bj][n] = *(const f32x4*)(gp + bj * 32 + fq * 8 + n * 4) * sc; }
        bf16_t* dst; int ldc, cbase;
        if (pn < 4) { dst = Q; ldc = 1024; cbase = pn * 256; }
        else if (pn < 10) { dst = (bf16_t*)(ws + WS_KC + (size_t)(pn - 4) * (16 * MiB)); ldc = 256; cbase = 0; }
        else { dst = Z; ldc = 1024; cbase = (pn - 10) * 256; }
        float rsc[8];
#pragma unroll
        for (int i = 0; i < 8; ++i) rsc[i] = rowscale[u.pm * 256 + (i >> 2) * 128 + wr * 64 + (i & 3) * 16 + fr];
#pragma unroll
        for (int ai = 0; ai < 2; ++ai)
#pragma unroll
            for (int m = 0; m < 4; ++m) {
                const int row = u.pm * 256 + ai * 128 + wr * 64 + m * 16 + fr; const float s = rsc[ai * 4 + m];
                f32x4 v[2][2];
#pragma unroll
                for (int bj = 0; bj < 2; ++bj)
#pragma unroll
                    for (int n = 0; n < 2; ++n) v[bj][n] = acc[ai][bj][m][n] * s;
                if (normed) { float ss = (dot4(v[0][0]) + dot4(v[0][1])) + (dot4(v[1][0]) + dot4(v[1][1]));
                    ss += __shfl_xor(ss, 16); ss += __shfl_xor(ss, 32);
                    const float rn = __builtin_amdgcn_rsqf(ss * (1.0f / 64.0f) + RMS_EPS);
#pragma unroll
                    for (int bj = 0; bj < 2; ++bj)
#pragma unroll
                        for (int n = 0; n < 2; ++n) v[bj][n] = v[bj][n] * rn * gq[bj][n]; }
                else if (pn >= 10) {
#pragma unroll
                    for (int bj = 0; bj < 2; ++bj)
#pragma unroll
                        for (int n = 0; n < 2; ++n)
#pragma unroll
                            for (int x = 0; x < 4; ++x) v[bj][n][x] = siluf_(v[bj][n][x]); }
                bf16_t* rp = dst + (size_t)row * ldc + cbase + wc * 64 + fq * 8;
#pragma unroll
                for (int bj = 0; bj < 2; ++bj) st_nt((u32x4*)(rp + bj * 32), (u32x4)(pack8(v[bj][0], v[bj][1])));
            }
    }
#if defined(PROBE_ST)
    __device__ __forceinline__ void probe(const Acc& acc, const Unit& u, int wr, int wc, int fr, int fq) const {
#ifndef PROBE_STX
#define PROBE_STX 1
#endif
        for (int rg = 0; rg < PROBE_STX; ++rg) {
        bf16_t* base = (bf16_t*)(ws + (rg == 0 ? WS_E1 : rg == 1 ? WS_E0 : WS_ATT));
        asm volatile("" ::: "memory");
#pragma unroll
        for (int ai = 0; ai < 2; ++ai)
#pragma unroll
            for (int m = 0; m < 4; ++m) {
                const int row = (PROBE_ST == 1) ? (int)blockIdx.x * 16 + fr : u.pm * 256 + ai * 128 + wr * 64 + m * 16 + fr;
                bf16_t* rp = (PROBE_ST >= 5) ? base + ((size_t)(u.pm * 4 + (u.pn & 3)) * 65536) + (size_t)((((wr * 4 + wc) * 2 + ai) * 4 + m) * 2) * 512 + (fq * 16 + fr) * 8
                                             : base + (size_t)row * 1024 + (u.pn & 3) * 256 + wc * 64 + fq * 8;
#pragma unroll
                for (int bj = 0; bj < 2; ++bj) { u32x4* dp = (u32x4*)(rp + bj * (PROBE_ST >= 5 ? 512 : 32));
                    if (PROBE_ST == 3 || PROBE_ST == 6) __builtin_nontemporal_store(pack8(acc[ai][bj][m][0], acc[ai][bj][m][1]), dp);
                    else if (PROBE_ST == 7) st_wt(dp, pack8(acc[ai][bj][m][0], acc[ai][bj][m][1]));
                    else if (PROBE_ST == 8) st_wt01(dp, pack8(acc[ai][bj][m][0], acc[ai][bj][m][1]));
                    else *dp = pack8(acc[ai][bj][m][0], acc[ai][bj][m][1]); }
            }
        }
    }
#endif
};
template <int LAYER> struct Res {
    static constexpr int ID = 40 + LAYER;
    static constexpr bool PERM = true;
    const float* x; unsigned char* ws;
    __device__ __forceinline__ void operator()(const Acc& acc, const Unit& u, int wr, int wc, int fr, int fq) const {
        const bf16_t* xinb = (const bf16_t*)(ws + WS_XB); bf16_t* xb = (bf16_t*)(ws + (LAYER == 0 ? WS_X1B : WS_X3B));
        const unsigned base = (unsigned)(u.pm * 256 + wr * 64 + fr) * 1024u + (unsigned)(u.pn * 256 + wc * 32 + fq * 8);
        f32x4 ra[2][4], rc[2][4]; u32x4 rb[2][4];
#define RES_ISSUE(k) { _Pragma("unroll") for (int mm = 0; mm < 2; ++mm) _Pragma("unroll") for (int bj = 0; bj < 2; ++bj) { \
            const unsigned off = base + (unsigned)((((k) >> 1) * 128 + (((k) & 1) * 2 + mm) * 16) * 1024 + bj * 128); \
            if (LAYER == 0) { ra[(k) & 1][mm * 2 + bj] = LD_ONCE((const f32x4*)(x + off)); rc[(k) & 1][mm * 2 + bj] = LD_ONCE((const f32x4*)(x + off + 4)); } \
            else rb[(k) & 1][mm * 2 + bj] = *(const u32x4*)(xinb + off); } }
        RES_ISSUE(0)
#pragma unroll
        for (int k = 0; k < 4; ++k) {
            if (k < 3) RES_ISSUE(k + 1)
            const int ai = k >> 1;
#pragma unroll
            for (int mm = 0; mm < 2; ++mm) { const int m = (k & 1) * 2 + mm;
#pragma unroll
                for (int bj = 0; bj < 2; ++bj) { const unsigned off = base + (unsigned)((ai * 128 + m * 16) * 1024 + bj * 128);
                    f32x4 r0, r1;
                    if (LAYER == 0) { r0 = ra[k & 1][mm * 2 + bj]; r1 = rc[k & 1][mm * 2 + bj]; } else unpack8(rb[k & 1][mm * 2 + bj], r0, r1);
                    *(u32x4*)(xb + off) = pack8(r0 + acc[ai][bj][m][0], r1 + acc[ai][bj][m][1]); } }
        }
#undef RES_ISSUE
    }
};
template <int LAYER> struct Ple {
    static constexpr int ID = 50 + LAYER;
    static constexpr bool PERM = true; static constexpr bool NEXT = (LAYER == 0);
    unsigned char* ws; unsigned char* dout;
    __device__ __forceinline__ void operator()(const Acc& acc, const Unit& u, int wr, int wc, int fr, int fq) const {
        const bf16_t* xinb = (const bf16_t*)(ws + (LAYER == 0 ? WS_X1B : WS_X3B)); const bf16_t* E = (const bf16_t*)(ws + (LAYER == 0 ? WS_E0 : WS_E1));
        float* xout = (float*)dout; bf16_t* xb = (bf16_t*)(ws + WS_XB); float* rowss = (float*)(ws + WS_ROWSS1);
        const unsigned base = (unsigned)(u.pm * 256 + wr * 64 + fr) * 1024u + (unsigned)(u.pn * 256 + wc * 32 + fq * 8);
        u32x4 eb[2][4], rb[2][4];
#define PLE_ISSUE(k) { _Pragma("unroll") for (int mm = 0; mm < 2; ++mm) _Pragma("unroll") for (int bj = 0; bj < 2; ++bj) { \
            const unsigned off = base + (unsigned)((((k) >> 1) * 128 + (((k) & 1) * 2 + mm) * 16) * 1024 + bj * 128); \
            eb[(k) & 1][mm * 2 + bj] = LD_ONCE((const u32x4*)(E + off)); rb[(k) & 1][mm * 2 + bj] = *(const u32x4*)(xinb + off); } }
        PLE_ISSUE(0)
#pragma unroll
        for (int k = 0; k < 4; ++k) {
            if (k < 3) PLE_ISSUE(k + 1)
            const int ai = k >> 1;
#pragma unroll
            for (int mm = 0; mm < 2; ++mm) { const int m = (k & 1) * 2 + mm; float ss = 0.f;
#pragma unroll
                for (int bj = 0; bj < 2; ++bj) { const unsigned off = base + (unsigned)((ai * 128 + m * 16) * 1024 + bj * 128);
                    f32x4 e0, e1, r0, r1; unpack8(eb[k & 1][mm * 2 + bj], e0, e1); unpack8(rb[k & 1][mm * 2 + bj], r0, r1);
                    f32x4 g0 = acc[ai][bj][m][0], g1 = acc[ai][bj][m][1];
#pragma unroll
                    for (int x = 0; x < 4; ++x) { g0[x] = sigmoidf_(g0[x]); g1[x] = sigmoidf_(g1[x]); }
                    const f32x4 o0 = r0 + g0 * e0, o1 = r1 + g1 * e1;
                    if (NEXT) { *(u32x4*)(xb + off) = pack8(o0, o1); ss += dot4(o0) + dot4(o1); }
                    else { st_nt((f32x4*)(xout + off), (f32x4)(o0)); st_nt((f32x4*)(xout + off + 4), (f32x4)(o1)); } }
                if (NEXT) { ss += __shfl_xor(ss, 16); ss += __shfl_xor(ss, 32); if (fq == 0) atomicAdd(rowss + (u.pm * 256 + ai * 128 + wr * 64 + m * 16 + fr), ss); } }
        }
#undef PLE_ISSUE
    }
};

__device__ __forceinline__ size_t qt_index(int b, int tok, int h, int d) { return ((((size_t)(b * 128 + (tok >> 5)) * 4 + h) * 16 + (d >> 4)) * 2 + ((d >> 3) & 1)) * 256 + (tok & 31) * 8 + (d & 7); }
__device__ __forceinline__ size_t tt_index(int bh, int nblk, int row, int tok) { return ((((size_t)bh * nblk + (row >> 5)) * 256 + (tok >> 4)) * 2 + ((tok >> 3) & 1)) * 256 + (row & 31) * 8 + (tok & 7); }
__device__ __forceinline__ float log2_gamma(int h) { return __log2f(1.0f - __builtin_amdgcn_exp2f(-5.0f - (float)h)); }
struct RetQ {
    static constexpr int ID = 60;
    static constexpr bool PERM = true;
    unsigned char* ws;
    __device__ __forceinline__ void operator()(const Acc& acc, const Unit& u, int wr, int wc, int fr, int fq) const {
        const float* rowss = (const float*)(ws + WS_ROWSS1); const float* cosT = (const float*)(ws + WS_COS); const float* sinT = (const float*)(ws + WS_SIN); bf16_t* Qp = (bf16_t*)(ws + WS_QP);
        const int h = u.pn; const float l2g = log2_gamma(h);
        const int rbase = u.pm * 256 + wr * 64 + fr; const int d0 = wc * 32 + fq * 8;
        f32x4 cb[2][4], sb[2][4]; float rs[2][2];
#define RQ_ISSUE(k) { _Pragma("unroll") for (int mm = 0; mm < 2; ++mm) { const int row = rbase + ((k) >> 1) * 128 + (((k) & 1) * 2 + mm) * 16; const int pos = row & (SEQ - 1); \
            rs[(k) & 1][mm] = rowss[row]; \
            _Pragma("unroll") for (int n = 0; n < 2; ++n) { cb[(k) & 1][mm * 2 + n] = *(const f32x4*)(cosT + (size_t)pos * 128 + d0 + n * 4); sb[(k) & 1][mm * 2 + n] = *(const f32x4*)(sinT + (size_t)pos * 128 + d0 + n * 4); } } }
        RQ_ISSUE(0)
#pragma unroll
        for (int k = 0; k < 4; ++k) {
            if (k < 3) RQ_ISSUE(k + 1)
            const int ai = k >> 1;
#pragma unroll
            for (int mm = 0; mm < 2; ++mm) { const int m = (k & 1) * 2 + mm; const int row = rbase + ai * 128 + m * 16;
                const float s = __builtin_amdgcn_rsqf(rs[k & 1][mm] * (1.0f / 1024.0f) + RMS_EPS);
                const int pos = row & (SEQ - 1), il = row & 127; const float dec = __builtin_amdgcn_exp2f((float)(il + 1) * l2g) * s;
                f32x4 y1[2], y2[2];
#pragma unroll
                for (int n = 0; n < 2; ++n) { const f32x4 c4 = cb[k & 1][mm * 2 + n], s4 = sb[k & 1][mm * 2 + n];
                    const f32x4 x1 = acc[ai][0][m][n], x2 = acc[ai][1][m][n]; y1[n] = (x1 * c4 - x2 * s4) * dec; y2[n] = (x1 * s4 + x2 * c4) * dec; }
                bf16_t* rp = Qp + qt_index(row >> 12, pos, h, d0);
                st_nt((u32x4*)rp, (u32x4)(pack8(y1[0], y1[1]))); st_nt((u32x4*)(rp + 8 * 512), (u32x4)(pack8(y2[0], y2[1]))); }
        }
#undef RQ_ISSUE
    }
};
struct RetKV {
    static constexpr int ID = 70;
    static constexpr bool PERM = false;
    unsigned char* ws; unsigned char* dout;
    __device__ __forceinline__ void operator()(const Acc& acc, const Unit& u, int wr, int wc, int fr, int fq) const {
        const float* rowss = (const float*)(ws + WS_ROWSS1); const float* cosT = (const float*)(ws + WS_COST); const float* sinT = (const float*)(ws + WS_SINT);
        bf16_t* Kp = (bf16_t*)dout; bf16_t* Ktp = (bf16_t*)(ws + WS_KTP); bf16_t* Vt = (bf16_t*)(ws + WS_VT);
        const int pn = u.pn; const bool isk = pn < 8; const int h = isk ? pn - 4 : (pn - 8) >> 1; const int ebase = isk ? 0 : ((pn - 8) & 1) * 256;
        const float l2g = log2_gamma(h);
#pragma unroll
        for (int ai = 0; ai < 2; ++ai)
#pragma unroll
            for (int m = 0; m < 4; ++m) { const int row0 = u.pm * 256 + ai * 128 + wr * 64 + m * 16 + fq * 4; const int b = row0 >> 12, t0 = row0 & (SEQ - 1);
                f32x4 s4 = *(const f32x4*)(rowss + row0);
#pragma unroll
                for (int x = 0; x < 4; ++x) s4[x] = __builtin_amdgcn_rsqf(s4[x] * (1.0f / 1024.0f) + RMS_EPS);
                if (isk) {
                    f32x4 kd;
#pragma unroll
                    for (int x = 0; x < 4; ++x) kd[x] = __builtin_amdgcn_exp2f((float)(127 - ((t0 + x) & 127)) * l2g) * 0.0625f * s4[x];
#pragma unroll
                    for (int n = 0; n < 2; ++n) { const int d = wc * 32 + n * 16 + fr;
                        const f32x4 c4 = *(const f32x4*)(cosT + (size_t)d * SEQ + t0), s4r = *(const f32x4*)(sinT + (size_t)d * SEQ + t0);
                        const f32x4 x1 = acc[ai][0][m][n], x2 = acc[ai][1][m][n];
                        const f32x4 y1 = (x1 * c4 - x2 * s4r) * kd, y2 = (x1 * s4r + x2 * c4) * kd;
                        u32x2 w1, w2; w1.x = cvt_pk_bf16(y1[0], y1[1]); w1.y = cvt_pk_bf16(y1[2], y1[3]); w2.x = cvt_pk_bf16(y2[0], y2[1]); w2.y = cvt_pk_bf16(y2[2], y2[3]);
                        bf16_t* tp = Ktp + tt_index(b * 4 + h, 8, d, t0); st_nt((u32x2*)tp, (u32x2)(w1)); st_nt((u32x2*)(tp + (size_t)4 * 256 * 512), (u32x2)(w2));
                        bf16_t* rp = Kp + qt_index(b, t0, h, d);
                        rp[0] = (bf16_t)(w1.x & 0xffffu); rp[8] = (bf16_t)(w1.x >> 16); rp[16] = (bf16_t)(w1.y & 0xffffu); rp[24] = (bf16_t)(w1.y >> 16);
                        rp[8 * 512] = (bf16_t)(w2.x & 0xffffu); rp[8 * 512 + 8] = (bf16_t)(w2.x >> 16); rp[8 * 512 + 16] = (bf16_t)(w2.y & 0xffffu); rp[8 * 512 + 24] = (bf16_t)(w2.y >> 16); }
                } else {
#pragma unroll
                    for (int bj = 0; bj < 2; ++bj)
#pragma unroll
                        for (int n = 0; n < 2; ++n) { const int e = ebase + bj * 128 + wc * 32 + n * 16 + fr; const f32x4 v = acc[ai][bj][m][n] * s4;
                            u32x2 w; w.x = cvt_pk_bf16(v[0], v[1]); w.y = cvt_pk_bf16(v[2], v[3]);
                            st_nt((u32x2*)(Vt + tt_index(b * 4 + h, 16, e, t0)), (u32x2)(w)); }
                }
                if (m & 1) asm volatile("" ::: "memory"); }
    }
};
struct RetZ {
    static constexpr int ID = 80;
    static constexpr bool PERM = true;
    unsigned char* ws; unsigned char* dout;
    __device__ __forceinline__ void operator()(const Acc& acc, const Unit& u, int wr, int wc, int fr, int fq) const {
        const float* rowss = (const float*)(ws + WS_ROWSS1); const float* stats = (const float*)(ws + WS_STATS); bf16_t* O = (bf16_t*)dout;
        const int zt = u.pn - 16, h = zt >> 1;
        const int rbase = u.pm * 256 + wr * 64 + fr;
        const unsigned obase = (unsigned)rbase * 2048u + (unsigned)(zt * 256 + wc * 32 + fq * 8);
        const float* sp0 = stats + ((size_t)((rbase >> 12) * 4 + h) * 2) * SEQ + (rbase & (SEQ - 1));
        u32x4 ob[2][4]; float rs[2][2], s0[2][2], s1[2][2];
#define RZ_ISSUE(k) { _Pragma("unroll") for (int mm = 0; mm < 2; ++mm) { const int ro = ((k) >> 1) * 128 + (((k) & 1) * 2 + mm) * 16; \
            rs[(k) & 1][mm] = rowss[rbase + ro]; s0[(k) & 1][mm] = sp0[ro]; s1[(k) & 1][mm] = sp0[SEQ + ro]; \
            _Pragma("unroll") for (int bj = 0; bj < 2; ++bj) ob[(k) & 1][mm * 2 + bj] = *(const u32x4*)(O + obase + (unsigned)(ro * 2048 + bj * 128)); } }
        RZ_ISSUE(0)
#pragma unroll
        for (int k = 0; k < 4; ++k) {
            if (k < 3) RZ_ISSUE(k + 1)
            const int ai = k >> 1;
#pragma unroll
            for (int mm = 0; mm < 2; ++mm) { const int m = (k & 1) * 2 + mm; const int ro = ai * 128 + m * 16;
                const float s = __builtin_amdgcn_rsqf(rs[k & 1][mm] * (1.0f / 1024.0f) + RMS_EPS);
                const float mu = s0[k & 1][mm] * (1.0f / 512.0f); float var = s1[k & 1][mm] * (1.0f / 512.0f) - mu * mu; var = var > 0.f ? var : 0.f; const float rstd = __builtin_amdgcn_rsqf(var + GN_EPS);
#pragma unroll
                for (int bj = 0; bj < 2; ++bj) { bf16_t* p = O + obase + (unsigned)(ro * 2048 + bj * 128);
                    f32x4 o0, o1; unpack8(ob[k & 1][mm * 2 + bj], o0, o1); f32x4 z0 = acc[ai][bj][m][0] * s, z1 = acc[ai][bj][m][1] * s;
#pragma unroll
                    for (int x = 0; x < 4; ++x) { z0[x] = siluf_(z0[x]); z1[x] = siluf_(z1[x]); }
                    o0 = (o0 - mu) * rstd * z0; o1 = (o1 - mu) * rstd * z1; *(u32x4*)p = pack8(o0, o1); } }
        }
#undef RZ_ISSUE
    }
};
}
#define RLX_AGENT __ATOMIC_RELAXED, __HIP_MEMORY_SCOPE_AGENT
#define LDS_WAIT() asm volatile("s_waitcnt lgkmcnt(0)" ::: "memory")
#define VM_WAIT() asm volatile("s_waitcnt vmcnt(0)" ::: "memory")

#define XB_TMO      128
#define XB_XCNT(j)  (256  + 64 * (j))
#define XB_XSUB(j)  (1280 + 64 * (j))
#define XB_XGEN(j)  (2304 + 64 * (j))
#define XB_TOP      3328
#define XB_TOPGEN   3392
#define XCD_BAR_WORDS 3456
#define XB_SPIN_CAP (1u << 23)
__device__ __forceinline__ unsigned xb_ld(unsigned* p)              { return __hip_atomic_load(p, __ATOMIC_RELAXED, __HIP_MEMORY_SCOPE_AGENT); }
__device__ __forceinline__ unsigned xb_add(unsigned* p, unsigned v) { return __hip_atomic_fetch_add(p, v, __ATOMIC_RELAXED, __HIP_MEMORY_SCOPE_AGENT); }
__device__ __forceinline__ unsigned xb_xcc_id() { return (unsigned)__builtin_amdgcn_s_getreg((3 << 11) | 20) & 0xFu; }
#define XB_SPIN(cond, bar) do { unsigned _sp = 0; while (cond) { __builtin_amdgcn_s_sleep(1); \
    if ((++_sp & 255u) == 0u) { if (xb_ld(&(bar)[XB_TMO])) break; if (_sp > XB_SPIN_CAP) { atomicAdd(&(bar)[XB_TMO], 1u); break; } } } } while (0)
struct XcdBarrier { unsigned* bar; unsigned x; volatile LAS unsigned* st; int wave; };
__device__ __forceinline__ XcdBarrier xcd_barrier_post(unsigned* bar, volatile LAS unsigned* st, int wave) {
    XcdBarrier b; b.bar = bar; b.x = xb_xcc_id(); b.st = st; b.wave = wave;
    if (wave == 0 && lane_id() == 0) (void)xb_add(&bar[XB_XCNT(b.x)], 1u);
    return b;
}
__device__ __forceinline__ void xcd_barrier_complete(unsigned* bar, unsigned x, unsigned& nloc, unsigned& nx) {
    const unsigned G = gridDim.x * gridDim.y * gridDim.z;
    unsigned sum, cnt, mine, sp = 0u;
    for (;;) {
        sum = 0u; cnt = 0u; mine = 0u;
#pragma unroll
        for (unsigned j = 0; j < 16; ++j) { const unsigned c = xb_ld(&bar[XB_XCNT(j)]); sum += c; cnt += (c > 0u) ? 1u : 0u; mine = (j == x) ? c : mine; }
        if (sum == G) break;
        __builtin_amdgcn_s_sleep(1);
        if ((++sp & 255u) == 0u) { if (xb_ld(&bar[XB_TMO])) break; if (sp > XB_SPIN_CAP) { atomicAdd(&bar[XB_TMO], 1u); break; } }
    }
    nloc = mine > 0u ? mine : 1u; nx = cnt > 0u ? cnt : 1u;
}
__device__ __forceinline__ void xcd_barrier(const XcdBarrier& b) {
    asm volatile("s_waitcnt vmcnt(0)" ::: "memory");
    __syncthreads();
    if (b.wave == 0 && lane_id() == 0) {
        unsigned* bar = b.bar;
        __builtin_amdgcn_s_waitcnt(0);
        unsigned nloc = b.st[0], nx = b.st[1];
        if (nloc == 0u) { xcd_barrier_complete(bar, b.x, nloc, nx); b.st[0] = nloc; b.st[1] = nx; }
        const unsigned old = xb_add(&bar[XB_XSUB(b.x)], 1u);
        const unsigned gen = old / nloc;
        if (old + 1u == (gen + 1u) * nloc) {
            __builtin_amdgcn_fence(__ATOMIC_RELEASE, "agent");
            asm volatile("s_waitcnt vmcnt(0)" ::: "memory");
            const unsigned og = xb_add(&bar[XB_TOP], 1u);
            const unsigned tg = og / nx;
            if (og + 1u == (tg + 1u) * nx) xb_add(&bar[XB_TOPGEN], 1u);
            else XB_SPIN(xb_ld(&bar[XB_TOPGEN]) == tg, bar);
            __builtin_amdgcn_fence(__ATOMIC_ACQUIRE, "agent");
            xb_add(&bar[XB_XGEN(b.x)], 1u);
            asm volatile("s_waitcnt vmcnt(0)" ::: "memory");
        } else {
            XB_SPIN(xb_ld(&bar[XB_XGEN(b.x)]) == gen, bar);
            __builtin_amdgcn_fence(__ATOMIC_ACQUIRE, "agent");
            asm volatile("s_waitcnt vmcnt(0)" ::: "memory");
        }
    }
    __syncthreads();
}

struct Frame {
    LAS unsigned char* lds;
    volatile LAS unsigned* MISC;
    unsigned* ctl;
    int wave, vcu, G;
    unsigned char* out; unsigned char* ws;
};
struct Args { const float* in[19]; unsigned char* out; unsigned char* ws; int ph_lo, ph_hi; };
__device__ __forceinline__ float wave_sum(float v) {
#pragma unroll
    for (int o = 1; o < 64; o <<= 1) v += __shfl_xor(v, o);
    return v;
}
__device__ __forceinline__ void tr_item(const float* W, int ldw, int K, int k0, int srcc, bf16_t* WT, int drow, const float* gain, LAS float* scr, int lane) {
    float wv[32];
#pragma unroll
    for (int i = 0; i < 32; ++i) { const int kk = 2 * i + (lane >> 5); wv[i] = W[(size_t)(k0 + kk) * ldw + srcc + (lane & 31)]; }
#pragma unroll
    for (int i = 0; i < 32; ++i) { const int kk = 2 * i + (lane >> 5); float w = wv[i]; if (gain) w *= gain[k0 + kk]; scr[kk * 33 + (lane & 31)] = w; }
    LDS_WAIT(); asm volatile("" ::: "memory");
    const int c = lane & 7;
#pragma unroll
    for (int j = 0; j < 4; ++j) { const int n = (lane >> 3) + 8 * j; const LAS float* s = scr + (8 * c) * 33 + n;
        u32x4 o; o.x = cvt_pk_bf16(s[0 * 33], s[1 * 33]); o.y = cvt_pk_bf16(s[2 * 33], s[3 * 33]); o.z = cvt_pk_bf16(s[4 * 33], s[5 * 33]); o.w = cvt_pk_bf16(s[6 * 33], s[7 * 33]);
        *(u32x4*)(WT + (size_t)(drow + n) * K + k0 + 8 * c) = o; }
    LDS_WAIT(); asm volatile("" ::: "memory");
}
__device__ __forceinline__ void cvt_rows(Frame& F, const float* src, bf16_t* dst, size_t n8) {
    const size_t nthr = (size_t)F.G * 512;
    for (size_t i = (size_t)F.vcu * 512 + F.wave * 64 + lane_id(); i < n8; i += 8 * nthr) { f32x4 a[8], b[8];
#pragma unroll
        for (int j = 0; j < 8; ++j) if (i + j * nthr < n8) { a[j] = *(const f32x4*)(src + (i + j * nthr) * 8); b[j] = *(const f32x4*)(src + (i + j * nthr) * 8 + 4); }
#pragma unroll
        for (int j = 0; j < 8; ++j) if (i + j * nthr < n8) *(u32x4*)(dst + (i + j * nthr) * 8) = epi::pack8(a[j], b[j]); }
}
__device__ __forceinline__ void p0_prologue(Frame& F, const Args& A, bool first = true) {
    LAS float* scr = (LAS float*)(F.lds + F.wave * 16384);
    const int gw = F.vcu * NWAVES + F.wave, NGW = F.G * NWAVES, lane = lane_id();
    unsigned char* ws = F.ws;
    constexpr int I0 = 16 * 112, I1 = 512, I2 = 512, I3 = 512, I4 = 128, I5 = 128, I6 = 16 * 192, I7 = 32 * 32, I8 = 32 * 8, I9 = 32 * 8, I10 = 8, I11 = 8, I12 = 16 * 2;
    constexpr int NITEMS = I0 + I1 + I2 + I3 + I4 + I5 + I6 + I7 + I8 + I9 + I10 + I11 + I12;
    for (int it = gw; it < NITEMS; it += NGW) {
        int r = it;
        if (r < I0) { const int kb = r / 112, gi = r % 112, pn = gi >> 3, gg = gi & 7, bj = gg >> 2, wc = gg & 3; int srcc;
            if (pn < 4) srcc = pn * 256 + wc * 64 + bj * 32; else if (pn < 10) srcc = 1024 + (pn - 4) * 256 + wc * 64 + bj * 32; else srcc = 2608 + (pn - 10) * 256 + wc * 64 + bj * 32;
            tr_item(A.in[3], 3632, 1024, 64 * kb, srcc, (bf16_t*)(ws + WS_WNIN), 32 * gi, A.in[2], scr, lane); continue; } r -= I0;
        if (r < I1) { tr_item(A.in[14], 1024, 1024, 64 * (r / 32), 32 * (r % 32), (bf16_t*)(ws + WS_WNOUT), 32 * (r % 32), nullptr, scr, lane); continue; } r -= I1;
        if (r < I2) { tr_item(A.in[18], 1024, 1024, 64 * (r / 32), 32 * (r % 32), (bf16_t*)(ws + WS_WG0), 32 * (r % 32), nullptr, scr, lane); continue; } r -= I2;
        if (r < I3) { tr_item(A.in[18] + (size_t)1024 * 1024, 1024, 1024, 64 * (r / 32), 32 * (r % 32), (bf16_t*)(ws + WS_WG1), 32 * (r % 32), nullptr, scr, lane); continue; } r -= I3;
        if (r < I4) { tr_item(A.in[17], 1024, 256, 64 * (r / 32), 32 * (r % 32), (bf16_t*)(ws + WS_WP0), 32 * (r % 32), nullptr, scr, lane); continue; } r -= I4;
        if (r < I5) { tr_item(A.in[17] + (size_t)256 * 1024, 1024, 256, 64 * (r / 32), 32 * (r % 32), (bf16_t*)(ws + WS_WP1), 32 * (r % 32), nullptr, scr, lane); continue; } r -= I5;
        if (r < I6) { tr_item(A.in[15], 6144, 1024, 64 * (r / 192), 32 * (r % 192), (bf16_t*)(ws + WS_WRIN), 32 * (r % 192), A.in[2] + 1024, scr, lane); continue; } r -= I6;
        if (r < I7) { tr_item(A.in[16], 1024, 2048, 64 * (r / 32), 32 * (r % 32), (bf16_t*)(ws + WS_WROUT), 32 * (r % 32), nullptr, scr, lane); continue; } r -= I7;
        if (r < I8) { tr_item(A.in[10], 256, 2048, 64 * (r / 8), 32 * (r % 8), (bf16_t*)(ws + WS_WC1K), 32 * (r % 8), nullptr, scr, lane); continue; } r -= I8;
        if (r < I9) { tr_item(A.in[12], 256, 2048, 64 * (r / 8), 32 * (r % 8), (bf16_t*)(ws + WS_WC1V), 32 * (r % 8), nullptr, scr, lane); continue; } r -= I9;
        if (r < I10) { tr_item(A.in[11], 64, 256, 64 * (r / 2), 32 * (r % 2), (bf16_t*)(ws + WS_WC2K), 32 * (r % 2), nullptr, scr, lane); continue; } r -= I10;
        if (r < I11) { tr_item(A.in[13], 64, 256, 64 * (r / 2), 32 * (r % 2), (bf16_t*)(ws + WS_WC2V), 32 * (r % 2), nullptr, scr, lane); continue; } r -= I11;
        tr_item(A.in[3], 3632, 1024, 64 * (r / 2), 2560 + 32 * (r % 2), (bf16_t*)(ws + WS_WGT), 32 * (r % 2), A.in[2], scr, lane);
    }
    { const float* x = A.in[0]; bf16_t* xb = (bf16_t*)(ws + WS_XB); float* rs = (float*)(ws + WS_ROWSC0);
      for (int m = gw; m < T_TOK; m += 4 * NGW) { f32x4 v[4][4]; float s[4];
#pragma unroll
          for (int q = 0; q < 4; ++q) { const int mq = (m + q * NGW < T_TOK) ? m + q * NGW : m; const f32x4* xr = (const f32x4*)(x + (size_t)mq * DM) + lane;
#pragma unroll
              for (int j = 0; j < 4; ++j) v[q][j] = xr[64 * j]; }
#pragma unroll
          for (int q = 0; q < 4; ++q) { float a = 0.f;
#pragma unroll
              for (int j = 0; j < 4; ++j) a += epi::dot4(v[q][j]);
              s[q] = wave_sum(a); }
#pragma unroll
          for (int q = 0; q < 4; ++q) if (m + q * NGW < T_TOK) { const int mq = m + q * NGW; u32x2* o8 = (u32x2*)(xb + (size_t)mq * DM) + lane;
#pragma unroll
              for (int j = 0; j < 4; ++j) { u32x2 w; w.x = cvt_pk_bf16(v[q][j][0], v[q][j][1]); w.y = cvt_pk_bf16(v[q][j][2], v[q][j][3]); o8[64 * j] = w; }
              if (lane == 0) rs[mq] = __builtin_amdgcn_rsqf(s[q] * (1.0f / DM) + RMS_EPS); } } }
    cvt_rows(F, A.in[1], (bf16_t*)(ws + WS_PB0), (size_t)T_TOK * 256 / 8);
    cvt_rows(F, A.in[1] + (size_t)T_TOK * 256, (bf16_t*)(ws + WS_PB1), (size_t)T_TOK * 256 / 8);
    { float* ct = (float*)(ws + WS_COS); float* st = (float*)(ws + WS_SIN); float* ctt = (float*)(ws + WS_COST); float* stt = (float*)(ws + WS_SINT);
      for (int i = F.vcu * 512 + F.wave * 64 + lane_id(); i < 2 * SEQ * 128; i += F.G * 512) { const bool tr = i >= SEQ * 128; const int ii = tr ? i - SEQ * 128 : i; const int pos = tr ? (ii & (SEQ - 1)) : (ii >> 7), j = tr ? (ii >> 12) : (ii & 127);
          const float inv = (float)exp2(-((double)j / 127.0) * 13.287712379549449);
          const float ang = (float)pos * inv;
          double t = (double)ang * 0.15915494309189535; t -= floor(t);
          const float cv = __builtin_amdgcn_cosf((float)t), sv = __builtin_amdgcn_sinf((float)t);
          if (tr) { ctt[ii] = cv; stt[ii] = sv; } else { ct[ii] = cv; st[ii] = sv; } } }
    if (first) for (int task = gw; task < 512; task += NGW) { const int kv = task >> 8, cb = (task >> 6) & 3, kc = task & 63, col = cb * 64 + lane; const float* pos = kv ? A.in[9] : A.in[8]; const float* w1 = kv ? A.in[12] : A.in[10]; float a = 0.f;
#pragma unroll 8
        for (int k = kc * 32; k < kc * 32 + 32; ++k) a += pos[k] * w1[(size_t)k * 256 + col];
        atomicAdd((float*)(ws + WS_CBIAS) + kv * 256 + col, a); }
    if (gw == NGW - 1) { float* gd = (float*)(ws + WS_GAINS); gd[lane] = A.in[4][lane]; gd[64 + lane] = A.in[5][lane]; gd[128 + lane] = A.in[6][lane]; gd[192 + lane] = A.in[7][lane]; }
}
__device__ __forceinline__ void cmp2_task(Frame& F, int task) {
    const float* kcg = (const float*)(F.ws + WS_GAINS) + 64;
    const int lane = lane_id(), r32 = lane & 31, hi = lane >> 5;
    unsigned char* ws = F.ws;
    {
        const int kv = task >> 8, rb = task & 255;
        const bf16_t* H = (const bf16_t*)(ws + WS_HID) + ((size_t)kv * 8192 + rb * 32) * 256;
        const bf16_t* W2 = (const bf16_t*)(ws + (kv ? WS_WC2V : WS_WC2K));
        f32x16 o0 = {}, o1 = {};
#pragma unroll 4
        for (int ks = 0; ks < 16; ++ks) {
            const bf16x8 hb = *(const bf16x8*)(H + (size_t)r32 * 256 + ks * 16 + hi * 8);
            const bf16x8 w0 = *(const bf16x8*)(W2 + (size_t)r32 * 256 + ks * 16 + hi * 8), w1 = *(const bf16x8*)(W2 + (size_t)(32 + r32) * 256 + ks * 16 + hi * 8);
            o0 = __builtin_amdgcn_mfma_f32_32x32x16_bf16(w0, hb, o0, 0, 0, 0); o1 = __builtin_amdgcn_mfma_f32_32x32x16_bf16(w1, hb, o1, 0, 0, 0);
        }
        if (kv == 0) { float ss = 0.f;
#pragma unroll
            for (int r = 0; r < 16; ++r) ss += o0[r] * o0[r] + o1[r] * o1[r];
            ss += __shfl_xor(ss, 32);
            const float rn = __builtin_amdgcn_rsqf(ss * (1.0f / 64.0f) + RMS_EPS); const float* gp = kcg;
#pragma unroll
            for (int r = 0; r < 16; ++r) { const int c = (r & 3) + 8 * (r >> 2) + 4 * hi; o0[r] *= rn * gp[c]; o1[r] *= rn * gp[32 + c]; } }
        const int rowg = rb * 32 + r32;
        if ((rowg & 255) == 255) { o0 = f32x16{}; o1 = f32x16{}; }
        bf16_t* dst = (bf16_t*)(ws + (kv ? WS_VCC : WS_KCC)) + (size_t)rowg * 64;
#pragma unroll
        for (int a = 0; a < 4; ++a) { u32x2 w; w.x = cvt_pk_bf16(o0[4 * a], o0[4 * a + 1]); w.y = cvt_pk_bf16(o0[4 * a + 2], o0[4 * a + 3]); *(u32x2*)(dst + 8 * a + 4 * hi) = w;
            w.x = cvt_pk_bf16(o1[4 * a], o1[4 * a + 1]); w.y = cvt_pk_bf16(o1[4 * a + 2], o1[4 * a + 3]); *(u32x2*)(dst + 32 + 8 * a + 4 * hi) = w; }
    }
}
__device__ __forceinline__ void gates_task(Frame& F, int task) {
    const int lane = lane_id(), r32 = lane & 31, hi = lane >> 5;
    unsigned char* ws = F.ws;
    const bf16_t* X = (const bf16_t*)(ws + WS_XB) + ((size_t)task * 32 + r32) * 1024 + hi * 32;
    const bf16_t* W = (const bf16_t*)(ws + WS_WGT) + (size_t)r32 * 1024 + hi * 32;
    f32x16 o0 = {}, o1 = {};
#pragma unroll 2
    for (int j = 0; j < 16; ++j) { bf16x8 xf[4], w0[4], w1[4];
#pragma unroll
        for (int s_ = 0; s_ < 4; ++s_) { xf[s_] = *(const bf16x8*)(X + j * 64 + s_ * 8); w0[s_] = *(const bf16x8*)(W + j * 64 + s_ * 8); w1[s_] = *(const bf16x8*)(W + (size_t)32 * 1024 + j * 64 + s_ * 8); }
#pragma unroll
        for (int s_ = 0; s_ < 4; ++s_) { o0 = __builtin_amdgcn_mfma_f32_32x32x16_bf16(w0[s_], xf[s_], o0, 0, 0, 0); o1 = __builtin_amdgcn_mfma_f32_32x32x16_bf16(w1[s_], xf[s_], o1, 0, 0, 0); } }
    const int row = task * 32 + r32; const float s = ((const float*)(ws + WS_ROWSC0))[row];
    float* gp = (float*)(ws + WS_G) + (size_t)row * 48;
#pragma unroll
    for (int a = 0; a < 4; ++a) { f32x4 v;
#pragma unroll
        for (int x = 0; x < 4; ++x) v[x] = sigmoidf_(o0[4 * a + x] * s);
        *(f32x4*)(gp + 8 * a + 4 * hi) = v;
        if (a < 2) {
#pragma unroll
            for (int x = 0; x < 4; ++x) v[x] = sigmoidf_(o1[4 * a + x] * s);
            *(f32x4*)(gp + 32 + 8 * a + 4 * hi) = v; } }
}

namespace nsa {
constexpr int L_KV = 0, L_K = 0, L_V = 24576, L_WSF = 49152, L_ACC = 51200, L_GS = 116736, L_LS = 133120, L_MSK = 149504, L_END = 150016;
constexpr int NSLOT = 3, SLOTB = 8192;
#define NSA_NEG (-INFINITY)
#ifndef FB_OFF_REGS
#define FB_OFF_REGS 0
#endif
#ifndef ODD_NT
#define ODD_NT 1
#endif
#ifndef WIN_PREFETCH
#define WIN_PREFETCH 0
#endif
__device__ __forceinline__ int crow(int r, int hi) { return (r & 3) + 8 * (r >> 2) + 4 * hi; }
__device__ __forceinline__ void qkt(f32x16& p0, f32x16& p1, const LAS unsigned char* Kslot, const bf16x8* qr, int r32, int hi) {
    const LAS unsigned char* kb = Kslot + hi * 1024 + r32 * 16;
    const f32x16 z = {};
#pragma unroll
    for (int d0 = 0; d0 < 4; ++d0) {
        const bf16x8 b0 = *(const LAS bf16x8*)(kb + d0 * 2048), b1 = *(const LAS bf16x8*)(kb + d0 * 2048 + 512);
        if (d0 == 0) { p0 = __builtin_amdgcn_mfma_f32_32x32x16_bf16(b0, qr[0], z, 0, 0, 0); p1 = __builtin_amdgcn_mfma_f32_32x32x16_bf16(b1, qr[0], z, 0, 0, 0); }
        else { p0 = __builtin_amdgcn_mfma_f32_32x32x16_bf16(b0, qr[d0], p0, 0, 0, 0); p1 = __builtin_amdgcn_mfma_f32_32x32x16_bf16(b1, qr[d0], p1, 0, 0, 0); }
    }
}
__device__ __forceinline__ void pv(f32x16* o, int vb, bf16x8 pa0, bf16x8 pa1, bf16x8 pa2, bf16x8 pa3) {
#pragma unroll
    for (int d0 = 0; d0 < 2; ++d0) { s16x4 lo[4], hi[4];
#pragma unroll
        for (int ks = 0; ks < 4; ++ks) {
            asm volatile("ds_read_b64_tr_b16 %0,%1 offset:%c2" : "=&v"(lo[ks]) : "v"(vb), "i"(d0 * 4096 + ks * 1024) : "memory");
            asm volatile("ds_read_b64_tr_b16 %0,%1 offset:%c2" : "=&v"(hi[ks]) : "v"(vb), "i"(d0 * 4096 + ks * 1024 + 512) : "memory"); }
        asm volatile("s_waitcnt lgkmcnt(0)" ::: "memory"); __builtin_amdgcn_sched_barrier(0);
#define NSA_PK(k) (bf16x8){lo[k][0], lo[k][1], lo[k][2], lo[k][3], hi[k][0], hi[k][1], hi[k][2], hi[k][3]}
        o[d0] = __builtin_amdgcn_mfma_f32_32x32x16_bf16(pa0, NSA_PK(0), o[d0], 0, 0, 0);
        o[d0] = __builtin_amdgcn_mfma_f32_32x32x16_bf16(pa1, NSA_PK(1), o[d0], 0, 0, 0);
        o[d0] = __builtin_amdgcn_mfma_f32_32x32x16_bf16(pa2, NSA_PK(2), o[d0], 0, 0, 0);
        o[d0] = __builtin_amdgcn_mfma_f32_32x32x16_bf16(pa3, NSA_PK(3), o[d0], 0, 0, 0);
#undef NSA_PK
    }
}
__device__ __forceinline__ float rowmax(const f32x16& p0, const f32x16& p1) {
    float a = fmaxf(fmaxf(p0[0], p0[1]), p1[0]), b = fmaxf(fmaxf(p0[2], p0[3]), p1[1]); a = fmaxf(fmaxf(a, p1[2]), p1[3]);
#pragma unroll
    for (int r = 4; r < 16; r += 4) { a = fmaxf(fmaxf(a, p0[r]), p0[r + 1]); b = fmaxf(fmaxf(b, p0[r + 2]), p0[r + 3]); a = fmaxf(fmaxf(a, p1[r]), p1[r + 1]); b = fmaxf(fmaxf(b, p1[r + 2]), p1[r + 3]); }
    const float m = fmaxf(a, b);
    auto rr = __builtin_amdgcn_permlane32_swap(__float_as_uint(m), __float_as_uint(m), false, false);
    return fmaxf(__uint_as_float(rr[0]), __uint_as_float(rr[1]));
}
__device__ __forceinline__ float halfsum(float v) {
    auto rr = __builtin_amdgcn_permlane32_swap(__float_as_uint(v), __float_as_uint(v), false, false);
    return __uint_as_float(rr[0]) + __uint_as_float(rr[1]);
}
__device__ __forceinline__ void row_scale(f32x16 (&o)[2], float f, LAS float* wsf, int r32, int hi) {
    if (hi == 0) wsf[r32] = f;
#pragma unroll
    for (int a = 0; a < 4; ++a) { const f32x4 f4 = *(const LAS f32x4*)(wsf + 8 * a + 4 * hi);
#pragma unroll
        for (int x = 0; x < 4; ++x) { o[0][4 * a + x] *= f4[x]; o[1][4 * a + x] *= f4[x]; } }
}
__device__ __forceinline__ void row_fma(f32x16 (&acc)[2], const f32x16 (&o)[2], float f, LAS float* wsf, int r32, int hi) {
    if (hi == 0) wsf[r32] = f;
#pragma unroll
    for (int a = 0; a < 4; ++a) { const f32x4 f4 = *(const LAS f32x4*)(wsf + 8 * a + 4 * hi);
#pragma unroll
        for (int x = 0; x < 4; ++x) { acc[0][4 * a + x] += o[0][4 * a + x] * f4[x]; acc[1][4 * a + x] += o[1][4 * a + x] * f4[x]; } }
}
__device__ __forceinline__ void softmax_step(f32x16& p0, f32x16& p1, float& m, float& l, f32x16 (&o)[2], LAS float* wsf, int r32, int hi) {
    const float rm = rowmax(p0, p1);
    if (__any(rm > m)) {
        const float mn = fmaxf(m, rm), mu = (mn == NSA_NEG) ? 0.f : mn;
        const float alpha = __builtin_amdgcn_exp2f(m - mu);
        l *= alpha; m = mn;
        row_scale(o, alpha, wsf, r32, hi);
    }
    const float mu = (m == NSA_NEG) ? 0.f : m; float s = 0.f;
#pragma unroll
    for (int r = 0; r < 16; ++r) { p0[r] = __builtin_amdgcn_exp2f(p0[r] - mu); p1[r] = __builtin_amdgcn_exp2f(p1[r] - mu); s += p0[r] + p1[r]; }
    l += s;
}

__device__ __forceinline__ void glds16(const void* sbase, unsigned voff, unsigned lds_dst) { unsigned keep;
    asm volatile("s_mov_b32 %0, m0\n\ts_mov_b32 m0, %3\n\ts_nop 0\n\tglobal_load_lds_dwordx4 %1, %2\n\ts_mov_b32 m0, %0" : "=&s"(keep) : "v"(voff), "s"(sbase), "s"(lds_dst) : "memory"); }
__device__ __forceinline__ float max3f(float a, float b, float c) { float r; asm("v_max3_f32 %0, %1, %2, %3" : "=v"(r) : "v"(a), "v"(b), "v"(c)); return r; }
__device__ __forceinline__ float max2f(float a, float b) { float r; asm("v_max_f32_e32 %0, %1, %2" : "=v"(r) : "v"(a), "v"(b)); return r; }
__device__ __forceinline__ float fadd_s(float a, float b) { float r; asm("v_add_f32_e32 %0, %1, %2" : "=v"(r) : "v"(a), "v"(b)); return r; }
__device__ __forceinline__ float fsub_s(float a, float b) { float r; asm("v_sub_f32_e32 %0, %1, %2" : "=v"(r) : "v"(a), "v"(b)); return r; }
typedef LAS const char* lds_cptr;
typedef short v4i16_t __attribute__((ext_vector_type(4)));
__device__ __forceinline__ void kload8(bf16x8* kf, lds_cptr kp) {
    kf[0] = *(const LAS bf16x8*)(kp);        kf[1] = *(const LAS bf16x8*)(kp + 512);
    kf[2] = *(const LAS bf16x8*)(kp + 2048); kf[3] = *(const LAS bf16x8*)(kp + 2560);
    kf[4] = *(const LAS bf16x8*)(kp + 4096); kf[5] = *(const LAS bf16x8*)(kp + 4608);
    kf[6] = *(const LAS bf16x8*)(kp + 6144); kf[7] = *(const LAS bf16x8*)(kp + 6656); }
__device__ __forceinline__ void kload2(bf16x8* kf, lds_cptr kp, int j) { kf[2 * j] = *(const LAS bf16x8*)(kp + j * 2048); kf[2 * j + 1] = *(const LAS bf16x8*)(kp + j * 2048 + 512); }
__device__ __forceinline__ s16x4 vtr(lds_cptr p) { return __builtin_bit_cast(s16x4, __builtin_amdgcn_ds_read_tr16_b64_v4i16((LAS v4i16_t*)p)); }
__device__ __forceinline__ float rowmax_a(const f32x16& p0, const f32x16& p1) {
    float a = max3f(p0[0], p0[1], p1[0]), b = max3f(p0[2], p0[3], p1[1]); a = max3f(a, p1[2], p1[3]);
#pragma unroll
    for (int r = 4; r < 16; r += 4) { a = max3f(a, p0[r], p0[r + 1]); b = max3f(b, p0[r + 2], p0[r + 3]); a = max3f(a, p1[r], p1[r + 1]); b = max3f(b, p1[r + 2], p1[r + 3]); }
    const float m = max2f(a, b);
    auto rr = __builtin_amdgcn_permlane32_swap(__float_as_uint(m), __float_as_uint(m), false, false);
    return max2f(__uint_as_float(rr[0]), __uint_as_float(rr[1]));
}
#define FB_SBAR() __builtin_amdgcn_sched_barrier(0)
#define FB_WAIT_BAR(N) asm volatile("s_waitcnt vmcnt(" #N ") lgkmcnt(0)\n\ts_barrier" ::: "memory")
template <int MODE> __device__ __forceinline__ void mask_tile(f32x16& p0, f32x16& p1, int t, int qb, int nreal, int tl_base, const LAS unsigned long long* mskp) {
    const float NEG = -INFINITY;
    if (t >= nreal) {
#pragma unroll
        for (int r = 0; r < 16; ++r) { p0[r] = NEG; p1[r] = NEG; }
        return; }
    if ((MODE == 0) ? (t == qb) : (t == 0)) { const int l_ = lane_id(); const int lim = tl_base + ((l_ & 31) >> 2) - 4 * (l_ >> 5);
#pragma unroll
        for (int r = 0; r < 16; ++r) { const int cr = (r & 3) + 8 * (r >> 2); if (cr > lim) p0[r] = NEG; if (cr + 32 > lim) p1[r] = NEG; } }
    if (MODE == 1 && t == 8) { const int l_ = lane_id(); const int lim = tl_base + ((l_ & 31) >> 2) - 4 * (l_ >> 5);
#pragma unroll
        for (int r = 0; r < 16; ++r) { const int cr = (r & 3) + 8 * (r >> 2); if (cr <= lim) p0[r] = NEG; if (cr + 32 <= lim) p1[r] = NEG; } }
    if (MODE == 0) { const bool dead = !((*mskp >> t) & 1ull);
        if (__any(dead)) {
#pragma unroll
            for (int r = 0; r < 16; ++r) { p0[r] = dead ? NEG : p0[r]; p1[r] = dead ? NEG : p1[r]; } } }
}
template <int MODE> __device__ __forceinline__ void mask_pos(f32x16& p0, f32x16& p1, int t, int qb, int tl_base) {
    const float NEG = -INFINITY;
    if ((MODE == 0) ? (t == qb) : (t == 0)) { const int l_ = lane_id(); const int lim = tl_base + ((l_ & 31) >> 2) - 4 * (l_ >> 5);
#pragma unroll
        for (int r = 0; r < 16; ++r) { const int cr = (r & 3) + 8 * (r >> 2); if (cr > lim) p0[r] = NEG; if (cr + 32 > lim) p1[r] = NEG; } }
    if (MODE == 1 && t == 8) { const int l_ = lane_id(); const int lim = tl_base + ((l_ & 31) >> 2) - 4 * (l_ >> 5);
#pragma unroll
        for (int r = 0; r < 16; ++r) { const int cr = (r & 3) + 8 * (r >> 2); if (cr <= lim) p0[r] = NEG; if (cr + 32 <= lim) p1[r] = NEG; } }
}
template <int MODE> __device__ __forceinline__ void flash_prefetch(LAS unsigned char* lds, const bf16_t* Kg, const bf16_t* Vg, int qb, int wid) {
    constexpr long PITCH = 256;
    const int nreal = (MODE == 0) ? qb + 1 : (qb >= 8 ? 9 : qb + 1);
    const unsigned lds0 = (unsigned)(uintptr_t)lds; const unsigned kdst = lds0 + L_K + wid * 1024, vdst = lds0 + L_V + wid * 1024;
#define PF_TILE(t) ((MODE == 0) ? (((t) < nreal) ? (t) : nreal - 1) : (qb - (((t) < nreal) ? (t) : nreal - 1)))
    const int l_ = lane_id();
    const unsigned koff = (unsigned)(l_ * (int)PITCH + wid * 8) * 2u, voff = (unsigned)((16 * (wid & 3) + (l_ >> 2)) * (int)PITCH + (wid >> 2) * 32 + (l_ & 3) * 8) * 2u;
    glds16(uni_ptr((const char*)(Kg + (long)PF_TILE(0) * 64 * PITCH)), koff, (unsigned)__builtin_amdgcn_readfirstlane(kdst));
    glds16(uni_ptr((const char*)(Vg + (long)PF_TILE(0) * 64 * PITCH)), voff, (unsigned)__builtin_amdgcn_readfirstlane(vdst));
    glds16(uni_ptr((const char*)(Kg + (long)PF_TILE(1) * 64 * PITCH)), koff, (unsigned)__builtin_amdgcn_readfirstlane(kdst + SLOTB));
    glds16(uni_ptr((const char*)(Kg + (long)PF_TILE(2) * 64 * PITCH)), koff, (unsigned)__builtin_amdgcn_readfirstlane(kdst + 2 * SLOTB));
#undef PF_TILE
}
template <int MODE, bool PRE = false> __device__ __forceinline__ void flash_branch(LAS unsigned char* lds, const bf16_t* Kg, const bf16_t* Vg, const bf16x8 (&qr)[4], int qb, int tl, const LAS unsigned long long* mskp, const LAS float* gatep, int wid, int lane) {
    const int r32 = lane & 31, hi = lane >> 5;
    constexpr long PITCH = 256;
    const int nreal = (MODE == 0) ? qb + 1 : (qb >= 8 ? 9 : qb + 1);
    const int NT = nreal < 4 ? 4 : (ODD_NT ? nreal : ((nreal + 1) & ~1));
#define FB_TILE(t) ((MODE == 0) ? (((t) < nreal) ? (t) : nreal - 1) : (qb - (((t) < nreal) ? (t) : nreal - 1)))
    const unsigned lds0 = (unsigned)(uintptr_t)lds;
    LAS float* wsf = (LAS float*)(lds + L_WSF) + wid * 64;
#define FB_KOFF() ((unsigned)(lane_id() * (int)PITCH + wid * 8) * 2u)
#define FB_VOFF() ({ const int l_ = lane_id(); (unsigned)((16 * (wid & 3) + (l_ >> 2)) * (int)PITCH + (wid >> 2) * 32 + (l_ & 3) * 8) * 2u; })
    const unsigned kdst = lds0 + L_K + wid * 1024, vdst = lds0 + L_V + wid * 1024;
#if FB_OFF_REGS
    const unsigned koff_r = FB_KOFF(), voff_r = FB_VOFF();
#define DMA_K(t, slot) glds16(uni_ptr((const char*)(Kg + (long)FB_TILE(t) * 64 * PITCH)), koff_r, (unsigned)__builtin_amdgcn_readfirstlane(kdst + (slot)))
#define DMA_V(t, slot) glds16(uni_ptr((const char*)(Vg + (long)FB_TILE(t) * 64 * PITCH)), voff_r, (unsigned)__builtin_amdgcn_readfirstlane(vdst + (slot)))
#else
#define DMA_K(t, slot) glds16(uni_ptr((const char*)(Kg + (long)FB_TILE(t) * 64 * PITCH)), FB_KOFF(), (unsigned)__builtin_amdgcn_readfirstlane(kdst + (slot)))
#define DMA_V(t, slot) glds16(uni_ptr((const char*)(Vg + (long)FB_TILE(t) * 64 * PITCH)), FB_VOFF(), (unsigned)__builtin_amdgcn_readfirstlane(vdst + (slot)))
#endif
    bf16x8 kf[8];
    const lds_cptr shm3 = (lds_cptr)lds; const lds_cptr kp0 = shm3 + L_K + hi * 1024 + r32 * 16; const lds_cptr vp0 = shm3 + L_V + ((lane >> 4) & 1) * 32 + (lane & 3) * 8 + (4 * hi + ((lane & 15) >> 2)) * 64;
    if (!PRE) { DMA_K(0, 0); DMA_V(0, 0); DMA_K(1, SLOTB); }
    float mhat = 0.f, l_reg = 0.f; f32x16 o[2]; o[0] = f32x16{}; o[1] = f32x16{}; const f32x16 zero16 = f32x16{};
#define CMASK(P0, P1, t) mask_tile<MODE>(P0, P1, (t), qb, nreal, wid * 8, mskp)
    bool resc = false;
#define START(P0, P1) do { const float rm = rowmax_a(P0, P1); resc = false; \
    { const float dl = rm; mhat = fadd_s(mhat, dl); \
      _Pragma("unroll") for (int r = 0; r < 16; ++r) { P0[r] = fsub_s(P0[r], dl); P1[r] = fsub_s(P1[r], dl); } } \
    _Pragma("unroll") for (int r = 0; r < 16; ++r) P0[r] = __builtin_amdgcn_exp2f(P0[r]); } while (0)
#define RESC() do { if (resc) { asm volatile("s_waitcnt lgkmcnt(0)" ::: "memory"); \
      _Pragma("unroll") for (int d_ = 0; d_ < 2; ++d_) _Pragma("unroll") for (int r = 0; r < 16; ++r) o[d_][r] *= wsf[crow(r, hi)]; } } while (0)
    f32x16 pA0, pA1, pB0, pB1;
    int sl_prev = 0, sl_cur = 0, sl_next = SLOTB;
#define ROT() do { sl_prev = sl_cur; sl_cur = sl_next; sl_next = (sl_next == (NSLOT - 1) * SLOTB) ? 0 : sl_next + SLOTB; } while (0)
    if (!PRE) { DMA_K(2, 2 * SLOTB); }
    if (PRE) { FB_WAIT_BAR(7); } else { FB_WAIT_BAR(3); }
    { const lds_cptr kb = kp0;
      const f32x16 z = zero16;
#pragma unroll
      for (int d0 = 0; d0 < 4; ++d0) { const bf16x8 b0 = *(const LAS bf16x8*)(kb + d0 * 2048), b1 = *(const LAS bf16x8*)(kb + d0 * 2048 + 512);
          if (d0 == 0) { pA0 = __builtin_amdgcn_mfma_f32_32x32x16_bf16(b0, qr[0], z, 0, 0, 0); pA1 = __builtin_amdgcn_mfma_f32_32x32x16_bf16(b1, qr[0], z, 0, 0, 0); }
          else { pA0 = __builtin_amdgcn_mfma_f32_32x32x16_bf16(b0, qr[d0], pA0, 0, 0, 0); pA1 = __builtin_amdgcn_mfma_f32_32x32x16_bf16(b1, qr[d0], pA1, 0, 0, 0); } } }
    asm volatile("s_nop 15\n\ts_nop 7" : "+v"(pA0), "+v"(pA1)); CMASK(pA0, pA1, 0);
    START(pA0, pA1);
#pragma unroll
    for (int r = 0; r < 16; ++r) pA1[r] = __builtin_amdgcn_exp2f(pA1[r]);
    FB_WAIT_BAR(0);
    DMA_K(3, 0); DMA_V(1, SLOTB);
    ROT();
    kload8(kf, kp0 + sl_cur);
    FB_WAIT_BAR(2);
    s16x4 vlo[8], vhi[8]; u32x4 pw0, pw1, pw2, pw3;
#define PKW(P, B) cvt_pk_bf16(P[B], P[B + 1])
#define PAF(k) __builtin_bit_cast(bf16x8, pw##k)
#define VFR(i) (bf16x8){vlo[i][0], vlo[i][1], vlo[i][2], vlo[i][3], vhi[i][0], vhi[i][1], vhi[i][2], vhi[i][3]}
#define PIN(x) asm volatile("" : "+v"(x))
#define MX3(a, b, c) __builtin_fmaxf(__builtin_fmaxf((a), (b)), (c))
#define GAPA(MF, A0, A1, A2, A3, W0, W1, PW) do { MF; sacc += A0; sacc += A1; sacc += A2; sacc += A3; PIN(sacc); W0; W1; PIN(PW); FB_SBAR(); } while (0)
#define EX(v) __builtin_amdgcn_exp2f(v)
#define GAPB(MF, X, B) do { MF; X[B] = EX(X[B]); X[B + 1] = EX(X[B + 1]); X[B + 2] = EX(X[B + 2]); X[B + 3] = EX(X[B + 3]); PIN(X); FB_SBAR(); } while (0)
#define VRD(i) do { vlo[i] = vtr(vp_ + (((i) >> 2) * 4096 + ((i) & 3) * 1024)); vhi[i] = vtr(vp_ + (((i) >> 2) * 4096 + ((i) & 3) * 1024 + 512)); } while (0)
#define KRD(G, j) do { if (G) { kload2(kf, kp0 + sl_next, j); FB_SBAR(); } } while (0)
#define STEP(C0, C1, P0, P1, t, GK, GV, GL) do { FB_SBAR(); \
    const lds_cptr vp_ = vp0 + sl_prev; \
    VRD(0); FB_SBAR(); float sacc = (P0[0] + P0[1]); \
    GAPA(C0 = __builtin_amdgcn_mfma_f32_32x32x16_bf16(kf[0], qr[0], zero16, 0, 0, 0), P0[2], P0[3], P0[4], P0[5],     pw0[0] = PKW(P0, 0), pw0[1] = PKW(P0, 2), pw0); \
    VRD(4); FB_SBAR(); GAPA(C1 = __builtin_amdgcn_mfma_f32_32x32x16_bf16(kf[1], qr[0], zero16, 0, 0, 0), P0[6], P0[7], P0[8], P0[9],     pw0[2] = PKW(P0, 4), pw0[3] = PKW(P0, 6), pw0); \
    VRD(1); FB_SBAR(); GAPA(C0 = __builtin_amdgcn_mfma_f32_32x32x16_bf16(kf[2], qr[1], C0, 0, 0, 0),   P0[10], P0[11], P0[12], P0[13], pw1[0] = PKW(P0, 8), pw1[1] = PKW(P0, 10), pw1); \
    VRD(5); FB_SBAR(); GAPA(C1 = __builtin_amdgcn_mfma_f32_32x32x16_bf16(kf[3], qr[1], C1, 0, 0, 0),   P0[14], P0[15], P1[0], P1[1],   pw1[2] = PKW(P0, 12), pw1[3] = PKW(P0, 14), pw1); \
    VRD(2); FB_SBAR(); GAPA(C0 = __builtin_amdgcn_mfma_f32_32x32x16_bf16(kf[4], qr[2], C0, 0, 0, 0),   P1[2], P1[3], P1[4], P1[5],     pw2[0] = PKW(P1, 0), pw2[1] = PKW(P1, 2), pw2); \
    VRD(6); FB_SBAR(); GAPA(C1 = __builtin_amdgcn_mfma_f32_32x32x16_bf16(kf[5], qr[2], C1, 0, 0, 0),   P1[6], P1[7], P1[8], P1[9],     pw2[2] = PKW(P1, 4), pw2[3] = PKW(P1, 6), pw2); \
    VRD(3); FB_SBAR(); GAPA(C0 = __builtin_amdgcn_mfma_f32_32x32x16_bf16(kf[6], qr[3], C0, 0, 0, 0),   P1[10], P1[11], P1[12], P1[13], pw3[0] = PKW(P1, 8), pw3[1] = PKW(P1, 10), pw3); \
    VRD(7); FB_SBAR(); GAPA(C1 = __builtin_amdgcn_mfma_f32_32x32x16_bf16(kf[7], qr[3], C1, 0, 0, 0),   P1[14], P1[15], 0.f, 0.f,       pw3[2] = PKW(P1, 12), pw3[3] = PKW(P1, 14), pw3); \
    l_reg += sacc; \
    if (GK) { DMA_K((t) + 3, sl_cur); } if (GV) { DMA_V((t) + 1, sl_next); } \
    { const bool dead_ = ((t) >= nreal) || (MODE == 0 && !((*mskp >> (t)) & 1ull)); const float mh_ = dead_ ? INFINITY : mhat;       \
      _Pragma("unroll") for (int r = 0; r < 16; ++r) { C0[r] -= mh_; C1[r] -= mh_; } } \
    mask_pos<MODE>(C0, C1, (t), qb, wid * 8); \
    { float a = MX3(C0[0], C0[1], C1[0]), b = MX3(C0[2], C0[3], C1[1]); a = MX3(a, C1[2], C1[3]); \
      _Pragma("unroll") for (int r = 4; r < 16; r += 4) { a = MX3(a, C0[r], C0[r + 1]); b = MX3(b, C0[r + 2], C0[r + 3]); a = MX3(a, C1[r], C1[r + 1]); b = MX3(b, C1[r + 2], C1[r + 3]); } \
      float rm = __builtin_fmaxf(a, b); { auto rr = __builtin_amdgcn_permlane32_swap(__float_as_uint(rm), __float_as_uint(rm), false, false); rm = __builtin_fmaxf(__uint_as_float(rr[0]), __uint_as_float(rr[1])); } \
      resc = false; \
      if (__builtin_expect(__any(rm > 8.0f), 0)) { const float dl = __builtin_fmaxf(rm, 0.f); mhat += dl; \
        _Pragma("unroll") for (int r = 0; r < 16; ++r) { C0[r] -= dl; C1[r] -= dl; } \
        const float f = __builtin_amdgcn_exp2f(-dl); l_reg *= f; if (hi == 0) wsf[r32] = f; resc = true; } } \
    FB_SBAR(); \
    GAPB(o[0] = __builtin_amdgcn_mfma_f32_32x32x16_bf16(PAF(0), VFR(0), o[0], 0, 0, 0), C0, 0); \
    GAPB(o[1] = __builtin_amdgcn_mfma_f32_32x32x16_bf16(PAF(0), VFR(4), o[1], 0, 0, 0), C0, 4); \
    KRD(GL, 0); GAPB(o[0] = __builtin_amdgcn_mfma_f32_32x32x16_bf16(PAF(1), VFR(1), o[0], 0, 0, 0), C0, 8); \
    KRD(GL, 1); GAPB(o[1] = __builtin_amdgcn_mfma_f32_32x32x16_bf16(PAF(1), VFR(5), o[1], 0, 0, 0), C0, 12); \
    KRD(GL, 2); GAPB(o[0] = __builtin_amdgcn_mfma_f32_32x32x16_bf16(PAF(2), VFR(2), o[0], 0, 0, 0), C1, 0); \
    KRD(GL, 3); GAPB(o[1] = __builtin_amdgcn_mfma_f32_32x32x16_bf16(PAF(2), VFR(6), o[1], 0, 0, 0), C1, 4); \
    GAPB(o[0] = __builtin_amdgcn_mfma_f32_32x32x16_bf16(PAF(3), VFR(3), o[0], 0, 0, 0), C1, 8); \
    GAPB(o[1] = __builtin_amdgcn_mfma_f32_32x32x16_bf16(PAF(3), VFR(7), o[1], 0, 0, 0), C1, 12); \
    } while (0)
    int t = 1;
    for (; t + 5 < NT; t += 2) {
        STEP(pB0, pB1, pA0, pA1, t, true, true, true);     FB_WAIT_BAR(2); RESC(); ROT();
        STEP(pA0, pA1, pB0, pB1, t + 1, true, true, true); FB_WAIT_BAR(2); RESC(); ROT();
    }
#define ENDW(tt) do { if ((tt) + 3 < NT) { FB_WAIT_BAR(2); } else if ((tt) + 2 < NT) { FB_WAIT_BAR(1); } else { FB_WAIT_BAR(0); } } while (0)
    for (; t + 1 < NT; t += 2) {
        STEP(pB0, pB1, pA0, pA1, t, (t + 3 < NT), (t + 1 < NT), (t + 1 < NT));         ENDW(t);     RESC(); ROT();
        STEP(pA0, pA1, pB0, pB1, t + 1, (t + 4 < NT), (t + 2 < NT), (t + 2 < NT));     ENDW(t + 1); RESC(); ROT();
    }
#define DRAIN(P0, P1, SL) do { float sacc = P0[0] + P0[1]; \
      _Pragma("unroll") for (int r = 2; r < 16; ++r) sacc += P0[r]; \
      _Pragma("unroll") for (int r = 0; r < 16; ++r) sacc += P1[r]; \
      l_reg += sacc; \
      pw0 = (u32x4){PKW(P0, 0), PKW(P0, 2), PKW(P0, 4), PKW(P0, 6)}; pw1 = (u32x4){PKW(P0, 8), PKW(P0, 10), PKW(P0, 12), PKW(P0, 14)}; \
      pw2 = (u32x4){PKW(P1, 0), PKW(P1, 2), PKW(P1, 4), PKW(P1, 6)}; pw3 = (u32x4){PKW(P1, 8), PKW(P1, 10), PKW(P1, 12), PKW(P1, 14)}; \
      FB_SBAR(); pv(o, (int)(lds0 + L_V) + ((lane >> 4) & 1) * 32 + (lane & 3) * 8 + (4 * hi + ((lane & 15) >> 2)) * 64 + (SL), PAF(0), PAF(1), PAF(2), PAF(3)); } while (0)
    if (t < NT) { STEP(pB0, pB1, pA0, pA1, NT - 1, false, false, false); RESC(); DRAIN(pB0, pB1, sl_cur); }
    else { DRAIN(pA0, pA1, sl_prev); }
#undef DRAIN
    l_reg = halfsum(l_reg);
    if (hi == 0) { const float gate = *gatep; wsf[32 + r32] = (l_reg > 0.f) ? gate / l_reg : 0.f; }
    asm volatile("s_waitcnt lgkmcnt(0)" ::: "memory");
    { LAS float* acc = (LAS float*)(lds + L_ACC) + wid * 2048;
#pragma unroll
      for (int r = 0; r < 16; ++r) { const int orow = crow(r, hi); const float f = wsf[32 + orow];
#pragma unroll
          for (int d0 = 0; d0 < 2; ++d0) acc[orow * 64 + d0 * 32 + r32] += o[d0][r] * f; } }
    asm volatile("s_waitcnt lgkmcnt(0)\n\ts_barrier" ::: "memory");
#undef DMA_K
#undef DMA_V
#undef CMASK
#undef START
#undef RESC
#undef ROT
#undef PKW
#undef PAF
#undef VFR
#undef PIN
#undef MX3
#undef GAPA
#undef GAPB
#undef EX
#undef VRD
#undef KRD
#undef STEP
#undef ENDW
#undef FB_TILE
#undef FB_KOFF
#undef FB_VOFF
}
#define NSA_PACK(P, B) cvt_pk_bf16(P[B], P[B + 1])
#define NSA_PA(P, B) __builtin_bit_cast(bf16x8, (u32x4){NSA_PACK(P, B), NSA_PACK(P, B + 2), NSA_PACK(P, B + 4), NSA_PACK(P, B + 6)})

__device__ __forceinline__ void nsa_unit(Frame& F, int b, int g, int qb) {
    const int lane = lane_id(), wid = F.wave, r32 = lane & 31, hi = lane >> 5;
    LAS unsigned char* lds = F.lds; unsigned char* ws = F.ws;
    const bf16_t* Q = (const bf16_t*)(F.out + DO_Q); const bf16_t* Z = (const bf16_t*)(F.out + DO_Z);
    const float* G = (const float*)(ws + WS_G); bf16_t* ATT = (bf16_t*)(ws + WS_ATT);
    const int tl = wid * 8 + (r32 >> 2), hh = r32 & 3, t = qb * 64 + tl;
    const size_t tokrow = (size_t)b * SEQ + t;
    bf16x8 qr[4];
#pragma unroll
    for (int d0 = 0; d0 < 4; ++d0) qr[d0] = *(const bf16x8*)(Q + tokrow * 1024 + g * 256 + hh * 64 + d0 * 16 + hi * 8);
    LAS float* gl = (LAS float*)(lds + LDS_GATE) + wid * 96 + r32;
    { const float* gp = G + tokrow * 48 + g * 12 + hh * 3; const float g0_ = gp[0], g1_ = gp[1], g2_ = gp[2]; if (hi == 0) { gl[0] = g0_; gl[32] = g1_; gl[64] = g2_; } }
    LAS float* wsf = (LAS float*)(lds + L_WSF) + wid * 64;
    LAS float* GS = (LAS float*)(lds + L_GS) + wid * 512; LAS float* LS = (LAS float*)(lds + L_LS) + wid * 512;
    LAS unsigned long long* MSK = (LAS unsigned long long*)(lds + L_MSK) + wid * 8;
    const int vbl = (int)(unsigned)(uintptr_t)(lds + L_KV + 8192) + ((lane >> 4) & 1) * 32 + (lane & 3) * 8 + (4 * hi + ((lane & 15) >> 2)) * 64;
    f32x16 oacc[2], o[2], p0, p1; oacc[0] = f32x16{}; oacc[1] = f32x16{};
#define NSA_DMA_K(st, base) __builtin_amdgcn_global_load_lds((const unsigned*)(uni_ptr(base) + koff), (LAS unsigned*)(lds + L_KV + (st) * 16384 + wid * 1024), 16, 0, 0)
#define NSA_DMA_V(st, base) __builtin_amdgcn_global_load_lds((const unsigned*)(uni_ptr(base) + voff), (LAS unsigned*)(lds + L_KV + (st) * 16384 + 8192 + wid * 1024), 16, 0, 0)
#ifndef PROBE_NSA
#define PROBE_NSA 0
#endif
    for (int prep = 0; prep < (PROBE_NSA == 1 ? 2 : 1); ++prep) { oacc[0] = f32x16{}; oacc[1] = f32x16{};
    {
        const int nvalid = (4 * qb + 3 < 255) ? 4 * qb + 3 : 255, ntc = (nvalid + 63) >> 6;
        const char* Kc = (const char*)(ws + WS_KCC) + (size_t)(b * 4 + g) * 256 * 128; const char* Vc = (const char*)(ws + WS_VCC) + (size_t)(b * 4 + g) * 256 * 128;
        const unsigned koff = (unsigned)lane * 128u + wid * 16, voff = (unsigned)(16 * (wid & 3) + (lane >> 2)) * 128u + (wid >> 2) * 64 + (lane & 3) * 16;
        for (int i = 0; i < ntc; ++i) {
            __builtin_amdgcn_global_load_lds((const unsigned*)(uni_ptr(Kc + (size_t)i * 8192) + koff), (LAS unsigned*)(lds + i * 8192 + wid * 1024), 16, 0, 0);
            __builtin_amdgcn_global_load_lds((const unsigned*)(uni_ptr(Vc + (size_t)i * 8192) + voff), (LAS unsigned*)(lds + L_ACC + i * 8192 + wid * 1024), 16, 0, 0); }
        const int nrow = (t >= 31) ? ((t - 31) >> 4) : -1;
        VM_WAIT(); __syncthreads();
        if (PROBE_NSA == 4) {
#pragma unroll
            for (int d0 = 0; d0 < 4; ++d0) { qr[d0] = *(const bf16x8*)(Q + tokrow * 1024 + g * 256 + hh * 64 + d0 * 16 + hi * 8); asm volatile("" : "+v"(qr[d0])); }
            for (int i = 0; i < ntc; ++i) {
                __builtin_amdgcn_global_load_lds((const unsigned*)(uni_ptr(Kc + (size_t)i * 8192) + koff), (LAS unsigned*)(lds + i * 8192 + wid * 1024), 16, 0, 0);
                __builtin_amdgcn_global_load_lds((const unsigned*)(uni_ptr(Vc + (size_t)i * 8192) + voff), (LAS unsigned*)(lds + L_ACC + i * 8192 + wid * 1024), 16, 0, 0); }
            VM_WAIT(); __syncthreads(); }
        f32x16 s0[4], s1[4];
        float m = NSA_NEG;
#pragma unroll
        for (int i = 0; i < 4; ++i) if (i < ntc) {
            qkt(s0[i], s1[i], lds + i * 8192, qr, r32, hi);
            const int lim = nrow - 64 * i - 4 * hi;
            if (__any(64 * i + 63 > nrow)) {
#pragma unroll
                for (int r = 0; r < 16; ++r) { const int cr = (r & 3) + 8 * (r >> 2); if (cr > lim) s0[i][r] = NSA_NEG; if (cr + 32 > lim) s1[i][r] = NSA_NEG; } }
#pragma unroll
            for (int r = 0; r < 16; r += 2) m = fmaxf(m, fmaxf(fmaxf(s0[i][r], s0[i][r + 1]), fmaxf(s1[i][r], s1[i][r + 1]))); }
        { auto rr = __builtin_amdgcn_permlane32_swap(__float_as_uint(m), __float_as_uint(m), false, false); m = fmaxf(__uint_as_float(rr[0]), __uint_as_float(rr[1])); }
        const float mu = (m == NSA_NEG) ? 0.f : m; float l = 0.f;
#pragma unroll
        for (int i = 0; i < 4; ++i) if (i < ntc) {
#pragma unroll
            for (int r = 0; r < 16; ++r) { s0[i][r] = __builtin_amdgcn_exp2f(s0[i][r] - mu); s1[i][r] = __builtin_amdgcn_exp2f(s1[i][r] - mu); l += s0[i][r] + s1[i][r]; } }
        l = halfsum(l);
        const float inv_l = l > 0.f ? 1.0f / l : 0.f;
        o[0] = f32x16{}; o[1] = f32x16{};
        const int vbc = (int)(unsigned)(uintptr_t)(lds + L_ACC) + ((lane >> 4) & 1) * 32 + (lane & 3) * 8 + (4 * hi + ((lane & 15) >> 2)) * 64;
#define QSUM(v) do { v += __int_as_float(__builtin_amdgcn_update_dpp(0, __float_as_int(v), 0xB1, 0xf, 0xf, true)); v += __int_as_float(__builtin_amdgcn_update_dpp(0, __float_as_int(v), 0x4E, 0xf, 0xf, true)); } while (0)
#pragma unroll
        for (int i = 0; i < 4; ++i) if (i < ntc) {
#if defined(PROBE_CMP) && PROBE_CMP == 1
            for (int prc = 0; prc < 2; ++prc)
#endif
#pragma unroll
            for (int a = 0; a < 4; ++a) {
                float g0 = ((s0[i][4 * a] + s0[i][4 * a + 1]) + (s0[i][4 * a + 2] + s0[i][4 * a + 3])) * inv_l, l0 = s0[i][4 * a + 3] * inv_l;
                float g1 = ((s1[i][4 * a] + s1[i][4 * a + 1]) + (s1[i][4 * a + 2] + s1[i][4 * a + 3])) * inv_l, l1 = s1[i][4 * a + 3] * inv_l;
                QSUM(g0); QSUM(l0); QSUM(g1); QSUM(l1);
                if (hh == 0) { const int j = 16 * i + 2 * a + hi, tk = r32 >> 2;
                    GS[tk * 64 + j] = g0; GS[tk * 64 + j + 8] = g1; LS[tk * 64 + j + 1] = l0; if (j + 9 < 64) LS[tk * 64 + j + 9] = l1; }
            }
            const bf16x8 pa0 = NSA_PA(s0[i], 0), pa1 = NSA_PA(s0[i], 8), pa2 = NSA_PA(s1[i], 0), pa3 = NSA_PA(s1[i], 8);
            pv(o, vbc + i * 8192, pa0, pa1, pa2, pa3);
#if defined(PROBE_CMP) && PROBE_CMP == 2
            { f32x16 o2[2]; o2[0] = o[0]; o2[1] = o[1]; pv(o2, vbc + i * 8192, pa0, pa1, pa2, pa3); asm volatile("" :: "v"(o2[0]), "v"(o2[1])); }
#endif
        }
#undef QSUM
        { const float gate_c = gl[0] * inv_l; oacc[0] = f32x16{}; oacc[1] = f32x16{}; row_fma(oacc, o, gate_c, wsf, r32, hi); }
        __syncthreads();
    }
#if WIN_PREFETCH
    flash_prefetch<1>(lds, (const bf16_t*)(ws + WS_KW) + (size_t)b * SEQ * 256 + g * 64, (const bf16_t*)(ws + WS_VW) + (size_t)b * SEQ * 256 + g * 64, qb, wid);
#endif
    LDS_WAIT();
    {
        const int tkq = lane >> 3, c8 = lane & 7;
        const LAS float* gsp = GS + tkq * 64 + c8 * 8; const LAS float* lsp = LS + tkq * 64 + c8 * 8;
        const f32x4 ga = *(const LAS f32x4*)gsp, gb = *(const LAS f32x4*)(gsp + 4), la = *(const LAS f32x4*)lsp, lb = *(const LAS f32x4*)(lsp + 4);
        unsigned key[8];
#pragma unroll
        for (int i = 0; i < 8; ++i) { const int j = c8 * 8 + i; const float gv = (i < 4) ? ga[i & 3] : gb[i & 3], lv = (i < 4) ? la[i & 3] : lb[i & 3];
            const float imp = gv + (j > 0 ? lv : 0.f);
            const bool valid = j <= qb, forced = (j == 0) || (j == qb) || (j == qb - 1);
#if defined(PROBE_SELINV)
            const float sc = forced ? 1e4f : (1e3f - imp);
#else
            const float sc = imp + (forced ? 1e4f : 0.f);
#endif
            key[i] = valid ? __float_as_uint(sc) + 1u : 0u; }
#define G8SUM(v) do { v += __builtin_amdgcn_update_dpp(0, v, 0xB1, 0xf, 0xf, true); v += __builtin_amdgcn_update_dpp(0, v, 0x4E, 0xf, 0xf, true); v += __builtin_amdgcn_update_dpp(0, v, 0x141, 0xf, 0xf, true); } while (0)
        unsigned T = 0u;
#if defined(PROBE_TOPK)
        for (int prt = 0; prt < 2; ++prt) { T = 0u;
#pragma unroll
        for (int i = 0; i < 8; ++i) asm volatile("" : "+v"(key[i]));
#endif
        if (qb >= 16) {
#pragma unroll
            for (int bit = 31; bit >= 0; --bit) { const unsigned cand = T | (1u << bit); int cnt = 0;
#pragma unroll
                for (int i = 0; i < 8; ++i) cnt += (key[i] >= cand) ? 1 : 0;
                G8SUM(cnt);
                T = (cnt >= 16) ? cand : T; } }
#if defined(PROBE_TOPK)
        }
#endif
        int gcnt = 0, ecnt = 0;
#pragma unroll
        for (int i = 0; i < 8; ++i) { gcnt += (key[i] > T) ? 1 : 0; ecnt += (key[i] == T) ? 1 : 0; }
        G8SUM(gcnt); const int need = 16 - gcnt;
        int pre = ecnt;
        { const int t1 = __builtin_amdgcn_update_dpp(0, pre, 0x111, 0xf, 0xf, true); pre += (c8 >= 1) ? t1 : 0;
          const int t2 = __builtin_amdgcn_update_dpp(0, pre, 0x112, 0xf, 0xf, true); pre += (c8 >= 2) ? t2 : 0;
          const int t4 = __builtin_amdgcn_update_dpp(0, pre, 0x114, 0xf, 0xf, true); pre += (c8 >= 4) ? t4 : 0; }
        int below = pre - ecnt; unsigned bits = 0u;
#pragma unroll
        for (int i = 0; i < 8; ++i) { const bool eq = key[i] == T; const bool sel = (key[i] != 0u) && ((key[i] > T) || (eq && below < need)); below += eq ? 1 : 0; bits |= sel ? (1u << i) : 0u; }
        ((LAS unsigned char*)MSK)[tkq * 8 + c8] = (unsigned char)bits;
#undef G8SUM
    }
    }
    LDS_WAIT();
    { const char* zsrc = (const char*)Z + ((size_t)b * SEQ + qb * 64 + wid * 8) * 2048 + g * 512 + (lane >> 5) * 2048 + (lane & 31) * 16;
      const unsigned zg = (unsigned)(uintptr_t)(lds + L_GS) + wid * 2048u, zl = (unsigned)(uintptr_t)(lds + L_LS) + wid * 2048u;
      glds16(uni_ptr((const char*)Z + ((size_t)b * SEQ + qb * 64 + wid * 8) * 2048 + g * 512), (unsigned)((lane >> 5) * 2048 + (lane & 31) * 16), (unsigned)__builtin_amdgcn_readfirstlane(zg));
      glds16(uni_ptr((const char*)Z + ((size_t)b * SEQ + qb * 64 + wid * 8 + 2) * 2048 + g * 512), (unsigned)((lane >> 5) * 2048 + (lane & 31) * 16), (unsigned)__builtin_amdgcn_readfirstlane(zg + 1024u));
      glds16(uni_ptr((const char*)Z + ((size_t)b * SEQ + qb * 64 + wid * 8 + 4) * 2048 + g * 512), (unsigned)((lane >> 5) * 2048 + (lane & 31) * 16), (unsigned)__builtin_amdgcn_readfirstlane(zl));
      glds16(uni_ptr((const char*)Z + ((size_t)b * SEQ + qb * 64 + wid * 8 + 6) * 2048 + g * 512), (unsigned)((lane >> 5) * 2048 + (lane & 31) * 16), (unsigned)__builtin_amdgcn_readfirstlane(zl + 1024u));
      (void)zsrc; }
    const LAS unsigned long long* mskp = MSK + (r32 >> 2);
    { LAS float* acc = (LAS float*)(lds + L_ACC) + wid * 2048;
#pragma unroll
      for (int r = 0; r < 16; ++r) { const int orow = crow(r, hi);
#pragma unroll
          for (int d0 = 0; d0 < 2; ++d0) acc[orow * 64 + d0 * 32 + r32] = oacc[d0][r]; } }
    { const bf16_t* Kw = (const bf16_t*)(ws + WS_KW) + (size_t)b * SEQ * 256 + g * 64; const bf16_t* Vw = (const bf16_t*)(ws + WS_VW) + (size_t)b * SEQ * 256 + g * 64;
      flash_branch<1, WIN_PREFETCH != 0>(lds, Kw, Vw, qr, qb, tl, mskp, gl + 64, wid, lane);
      if (PROBE_NSA == 2) flash_branch<1>(lds, Kw, Vw, qr, qb, tl, mskp, (const LAS float*)(lds + LDSCTL_OFF), wid, lane); }
    { const bf16_t* Ks = (const bf16_t*)(ws + WS_KS) + (size_t)b * SEQ * 256 + g * 64; const bf16_t* Vs = (const bf16_t*)(ws + WS_VS) + (size_t)b * SEQ * 256 + g * 64;
      flash_branch<0>(lds, Ks, Vs, qr, qb, tl, mskp, gl + 32, wid, lane);
      if (PROBE_NSA == 3) flash_branch<0>(lds, Ks, Vs, qr, qb, tl, mskp, (const LAS float*)(lds + LDSCTL_OFF), wid, lane); }
    for (int pro = 0; pro < (PROBE_NSA == 5 ? 2 : 1); ++pro)
    {
        const LAS float* acc = (const LAS float*)(lds + L_ACC) + wid * 2048;
#pragma unroll
        for (int i = 0; i < 4; ++i) { const int row = i * 8 + (lane >> 3), ch = lane & 7; const f32x4 a0 = *(const LAS f32x4*)(acc + row * 64 + ch * 8), a1 = *(const LAS f32x4*)(acc + row * 64 + ch * 8 + 4);
            const size_t off = ((size_t)b * SEQ + qb * 64 + wid * 8 + (row >> 2)) * 1024 + g * 256 + (row & 3) * 64 + ch * 8;
            const int tk_ = row >> 2; const LAS unsigned char* zp = lds + (tk_ < 4 ? L_GS : L_LS) + wid * 2048 + (tk_ & 3) * 512 + (row & 3) * 128 + ch * 16;
            const u32x4 zz = *(const LAS u32x4*)zp; f32x4 z0, z1; epi::unpack8(zz, z0, z1);
            *(u32x4*)(ATT + off) = epi::pack8(a0 * z0, a1 * z1); }
        LDS_WAIT();
    }
    __syncthreads();
#undef NSA_DMA_K
#undef NSA_DMA_V
}
__device__ __forceinline__ void nsa_phase(Frame& F) {
    if (F.G == 256) {
        const int bg = F.vcu >> 3, s = F.vcu & 7;
        for (int i = 0; i < 8; ++i) { const int k = i >> 1; const int qb = (i & 1) ? (63 - 8 * k - s) : (8 * k + s); nsa_unit(F, bg >> 2, bg & 3, qb); }
    } else {
        for (int u = F.vcu; u < 2048; u += F.G) nsa_unit(F, u >> 8, (u >> 6) & 3, u & 63);
    }
}
}

namespace ret {
__device__ __forceinline__ int crow(int r, int hi) { return (r & 3) + 8 * (r >> 2) + 4 * hi; }
__device__ __forceinline__ void p_phase(Frame& F) {
    const int lane = lane_id(), wid = F.wave, r32 = lane & 31, hi = lane >> 5;
    const bf16_t* Qp = (const bf16_t*)(F.ws + WS_QP); const bf16_t* Kp = (const bf16_t*)(F.out);
    bf16_t* PT = (bf16_t*)(F.ws + WS_PT);
    const int ib = wid & 3, jb0 = (wid >> 2) * 2;
    for (int it = F.vcu; it < 1024; it += F.G) {
        const int bh = it >> 5, c = it & 31, b = bh >> 2, h = bh & 3;
        const float ginv = __builtin_amdgcn_exp2f(-128.0f * epi::log2_gamma(h));
#pragma unroll
        for (int jj = 0; jj < 2; ++jj) { const int jb = jb0 + jj;
            if (jb > ib) {
#pragma unroll
                for (int a = 0; a < 4; ++a) *(u32x2*)(PT + ((((size_t)it * 4 + ib) * 8 + (2 * jb + (a >> 1))) * 2 + (a & 1)) * 256 + r32 * 8 + 4 * hi) = (u32x2){0u, 0u};
            } else {
                const bf16_t* ka = Kp + epi::qt_index(b, c * 128 + jb * 32, h, 0) + lane * 8; const bf16_t* qa = Qp + epi::qt_index(b, c * 128 + ib * 32, h, 0) + lane * 8;
                bf16x8 fa[16], fb[16];
#pragma unroll
                for (int ks = 0; ks < 16; ++ks) { fa[ks] = *(const bf16x8*)(ka + ks * 512); fb[ks] = *(const bf16x8*)(qa + ks * 512); }
                f32x16 acc = {};
#pragma unroll
                for (int ks = 0; ks < 16; ++ks) acc = __builtin_amdgcn_mfma_f32_32x32x16_bf16(fa[ks], fb[ks], acc, 0, 0, 0);
#pragma unroll
                for (int a = 0; a < 4; ++a) { float v[4];
#pragma unroll
                    for (int x = 0; x < 4; ++x) { const int jl = jb * 32 + 8 * a + 4 * hi + x; v[x] = (jl <= ib * 32 + r32) ? acc[4 * a + x] * ginv : 0.f; }
                    u32x2 w; w.x = cvt_pk_bf16(v[0], v[1]); w.y = cvt_pk_bf16(v[2], v[3]);
                    *(u32x2*)(PT + ((((size_t)it * 4 + ib) * 8 + (2 * jb + (a >> 1))) * 2 + (a & 1)) * 256 + r32 * 8 + 4 * hi) = w; }
            } }
    }
}
constexpr int ST_PITCH = 264;
__device__ __forceinline__ void scan_item(Frame& F, int b, int h, int s, bool do_stats) {
    const int lane = lane_id(), wid = F.wave, r32 = lane & 31, hi = lane >> 5, ib = wid & 3; const bool heavy = wid < 4;
    const bf16_t* Qp = (const bf16_t*)(F.ws + WS_QP); const bf16_t* Ktp = (const bf16_t*)(F.ws + WS_KTP); const bf16_t* Vt = (const bf16_t*)(F.ws + WS_VT); const bf16_t* PT = (const bf16_t*)(F.ws + WS_PT);
    bf16_t* O = (bf16_t*)(F.out); float* stats = (float*)(F.ws + WS_STATS);
    LAS bf16_t* St = (LAS bf16_t*)(F.lds);
    const int bh = b * 4 + h;
    const float l2g = epi::log2_gamma(h), g128 = __builtin_amdgcn_exp2f(128.0f * l2g);
    const bf16_t* vB0 = Vt + epi::tt_index(bh, 16, s * 64, 0) + lane * 8;
    const bf16_t* vB1 = Vt + epi::tt_index(bh, 16, s * 64 + 32, 0) + lane * 8;
    const bf16_t* kA = Ktp + epi::tt_index(bh, 8, wid * 32, 0) + lane * 8;
    const bf16_t* qB = Qp + epi::qt_index(b, ib * 32, h, 0) + lane * 8;
    const bf16_t* pB = PT + (((size_t)bh * 32) * 4 + ib) * 8 * 512 + lane * 8;
    constexpr int ST_BYTES = 64 * ST_PITCH * 2, VT_OFF = 2 * ST_BYTES, OST_OFF = VT_OFF + 32768, OST_BYTES = 128 * 136;
    const bf16_t* vS = Vt + epi::tt_index(bh, 16, s * 64 + (wid >> 2) * 32, 0);
    const unsigned vdst0 = (unsigned)(uintptr_t)(F.lds + VT_OFF) + (unsigned)wid * 2048u;
#define VT_DMA(c_, buf_) do { const char* src_ = (const char*)(vS + (size_t)((c_) * 8 + 2 * (wid & 3)) * 512); \
        nsa::glds16(uni_ptr(src_), (unsigned)lane * 16u, (unsigned)__builtin_amdgcn_readfirstlane(vdst0 + (buf_) * 16384u)); \
        nsa::glds16(uni_ptr(src_ + 1024), (unsigned)lane * 16u, (unsigned)__builtin_amdgcn_readfirstlane(vdst0 + (buf_) * 16384u + 1024u)); } while (0)
    const LAS bf16_t* vl = (const LAS bf16_t*)(F.lds + VT_OFF) + lane * 8;
    f32x16 S0 = {}, S1 = {};
    bf16x8 kaf[8], ipb[8], qf[16];
#define LOAD_KA(c_) do { _Pragma("unroll") for (int ks = 0; ks < 8; ++ks) kaf[ks] = *(const bf16x8*)(kA + (size_t)((c_) * 8 + ks) * 512); } while (0)
#define LOAD_PB(c_) do { _Pragma("unroll") for (int ks = 0; ks < 8; ++ks) ipb[ks] = *(const bf16x8*)(pB + (size_t)(c_) * (4 * 8 * 512) + ks * 512); } while (0)
#define LOAD_Q(c_)  do { _Pragma("unroll") for (int ks = 0; ks < 16; ++ks) qf[ks] = *(const bf16x8*)(qB + (size_t)(c_) * (4 * 4 * 16 * 512) + ks * 512); } while (0)
#define STORE_ROWS(c_) do { _Pragma("unroll") for (int i2 = 0; i2 < 2; ++i2) { const int row = wid * 16 + i2 * 8 + (lane >> 3), q = lane & 7; const LAS unsigned char* os = F.lds + OST_OFF + ((c_) & 1) * OST_BYTES + row * 136 + q * 16; \
            const u32x2 lo = *(const LAS u32x2*)os, hi2 = *(const LAS u32x2*)(os + 8); \
            *(u32x4*)(O + ((size_t)b * SEQ + (c_) * 128 + row) * 2048 + h * 512 + s * 64 + q * 8) = (u32x4){lo.x, lo.y, hi2.x, hi2.y}; } \
        if (heavy && hi == 0 && do_stats) { float* sp = stats + ((size_t)bh * 2) * SEQ + (c_) * 128 + ib * 32 + r32; atomicAdd(sp, ps1); atomicAdd(sp + SEQ, ps2); } } while (0)
    float ps1 = 0.f, ps2 = 0.f;
    VT_DMA(0, 0);
    LOAD_KA(0); if (heavy) LOAD_PB(0);
    asm volatile("s_waitcnt vmcnt(0)\n\ts_barrier" ::: "memory");
    for (int c = 0; c < 32; ++c) {
        const LAS bf16_t* vb = vl + (c & 1) * 8192;
        const LAS bf16_t* sa = St + (c & 1) * (64 * ST_PITCH) + r32 * ST_PITCH + hi * 8;
        LAS bf16_t* Stn = St + ((c + 1) & 1) * (64 * ST_PITCH);
        if (c < 31) VT_DMA(c + 1, (c + 1) & 1);
        if (c > 0) { if (heavy) LOAD_Q(c); STORE_ROWS(c - 1); }
        if (c < 31) {
#pragma unroll
            for (int r = 0; r < 16; ++r) { S0[r] *= g128; S1[r] *= g128; }
#pragma unroll
            for (int ks = 0; ks < 8; ++ks) { S0 = __builtin_amdgcn_mfma_f32_32x32x16_bf16(kaf[ks], *(const LAS bf16x8*)(vb + ks * 512), S0, 0, 0, 0); S1 = __builtin_amdgcn_mfma_f32_32x32x16_bf16(kaf[ks], *(const LAS bf16x8*)(vb + (8 + ks) * 512), S1, 0, 0, 0); }
            if (c < 30) LOAD_KA(c + 1);
#pragma unroll
            for (int a = 0; a < 4; ++a) { u32x2 w; w.x = cvt_pk_bf16(S0[4 * a], S0[4 * a + 1]); w.y = cvt_pk_bf16(S0[4 * a + 2], S0[4 * a + 3]); *(LAS u32x2*)(Stn + r32 * ST_PITCH + wid * 32 + 8 * a + 4 * hi) = w;
                w.x = cvt_pk_bf16(S1[4 * a], S1[4 * a + 1]); w.y = cvt_pk_bf16(S1[4 * a + 2], S1[4 * a + 3]); *(LAS u32x2*)(Stn + (32 + r32) * ST_PITCH + wid * 32 + 8 * a + 4 * hi) = w; }
        }
        if (heavy) {
            f32x16 oc0 = {}, oc1 = {};
#pragma unroll
            for (int ks = 0; ks < 8; ++ks) { oc0 = __builtin_amdgcn_mfma_f32_32x32x16_bf16(*(const LAS bf16x8*)(vb + ks * 512), ipb[ks], oc0, 0, 0, 0); oc1 = __builtin_amdgcn_mfma_f32_32x32x16_bf16(*(const LAS bf16x8*)(vb + (8 + ks) * 512), ipb[ks], oc1, 0, 0, 0); }
            if (c < 31) LOAD_PB(c + 1);
            if (c > 0) {
#pragma unroll
                for (int ks = 0; ks < 16; ++ks) { oc0 = __builtin_amdgcn_mfma_f32_32x32x16_bf16(*(const LAS bf16x8*)(sa + ks * 16), qf[ks], oc0, 0, 0, 0); oc1 = __builtin_amdgcn_mfma_f32_32x32x16_bf16(*(const LAS bf16x8*)(sa + 32 * ST_PITCH + ks * 16), qf[ks], oc1, 0, 0, 0); } }
            float s1 = 0.f, s2 = 0.f;
#pragma unroll
            for (int r = 0; r < 16; ++r) { s1 += oc0[r] + oc1[r]; s2 += oc0[r] * oc0[r] + oc1[r] * oc1[r]; }
            ps1 = nsa::halfsum(s1); ps2 = nsa::halfsum(s2);
            LAS unsigned char* ow = F.lds + OST_OFF + (c & 1) * OST_BYTES + (ib * 32 + r32) * 136 + (4 * hi) * 2;
#pragma unroll
            for (int a = 0; a < 4; ++a) { u32x2 w; w.x = cvt_pk_bf16(oc0[4 * a], oc0[4 * a + 1]); w.y = cvt_pk_bf16(oc0[4 * a + 2], oc0[4 * a + 3]); *(LAS u32x2*)(ow + 16 * a) = w;
                w.x = cvt_pk_bf16(oc1[4 * a], oc1[4 * a + 1]); w.y = cvt_pk_bf16(oc1[4 * a + 2], oc1[4 * a + 3]); *(LAS u32x2*)(ow + 64 + 16 * a) = w; }
        }
        asm volatile("s_waitcnt vmcnt(0) lgkmcnt(0)\n\ts_barrier" ::: "memory");
    }
    STORE_ROWS(31);
#undef LOAD_KA
#undef LOAD_PB
#undef LOAD_Q
#undef STORE_ROWS
#undef VT_DMA
    __syncthreads();
}
__device__ __forceinline__ void scan_phase(Frame& F, bool do_stats) {
    for (int it = F.vcu; it < 256; it += F.G) scan_item(F, it >> 5, (it >> 3) & 3, it & 7, do_stats);
}
}

__global__ void __launch_bounds__(NWAVES * 64, 2) mk_fwd(Args args) {
    extern __shared__ __attribute__((aligned(16))) unsigned char lds_raw[];
    Frame F;
    F.lds = (LAS unsigned char*)lds_raw;
    F.MISC = (volatile LAS unsigned*)(F.lds + MISC_OFF);
    F.wave = __builtin_amdgcn_readfirstlane(threadIdx.x >> 6);
    F.G = gridDim.x; { const int bx = blockIdx.x; F.vcu = (F.G % 8 == 0) ? (bx % 8) * (F.G / 8) + bx / 8 : bx; }
    F.out = args.out; F.ws = args.ws; F.ctl = (unsigned*)(args.ws + WS_CTL);
    unsigned char* ws = F.ws; unsigned char* dout = F.out;
    for (int u = F.wave * 64 + lane_id(); u < (LDS_BYTES - LDSCTL_OFF) / 4; u += NWAVES * 64) ((LAS unsigned*)(F.lds + LDSCTL_OFF))[u] = 0u;
    __syncthreads();
    XcdBarrier bar = xcd_barrier_post(F.ctl + CW_BAR, F.MISC + 8, F.wave);
    cg::grid_group grid = cg::this_grid();
    const int lo = args.ph_lo, hi = args.ph_hi, bx = (int)blockIdx.x, G = F.G;
#ifndef PROBE_PH
#define PROBE_PH (-1)
#endif
#ifndef PROBE_GEMM
#define PROBE_GEMM 0
#endif
#define REPS(k, isgemm) (((PROBE_PH) == (k) || ((isgemm) && PROBE_GEMM)) ? 2 : 1)
#define IN(k) (lo <= (k) && (k) < hi)
#if defined(PROBE_BAR)
#define SEAM(k) do { if (IN(k) && IN((k) + 1)) { xcd_barrier(bar); xcd_barrier(bar); } } while (0)
#else
#define SEAM(k) do { if (IN(k) && IN((k) + 1)) xcd_barrier(bar); } while (0)
#endif
    LAS unsigned char* ring = F.lds;

    if (hi < 0) grid.sync();
    if (IN(0)) { for (int rep = 0; rep < REPS(0, 0); ++rep) p0_prologue(F, args, rep == 0); if (IN(1)) xcd_barrier(bar); }

    if (IN(1)) for (int rep = 0; rep < REPS(1, 1); ++rep) {
        pg8::Gemm g{(const char*)(ws + WS_XB), (const char*)(ws + WS_WNIN), 2048u, 2048u, 128u, 128u, 1024};
        pg8::SchedStd S; S.init(128, 14, 0, G, bx, (size_t)256 * 2048, (size_t)256 * 2048);
        epi::NsaIn E{ws, dout};
        pg8::gemm_phase<epi::NsaIn, pg8::SchedStd, false>(ring, F.wave, g, S, E);
    }
    SEAM(1);
    if (IN(2)) for (int rep = 0; rep < REPS(2, 0); ++rep) {
        const bool cmp_cu = (G == 256) ? (bx < 64) : true, other_cu = (G == 256) ? (bx >= 64) : true;
        if (cmp_cu) {
            pg8::Gemm g{(const char*)(ws + WS_KC), (const char*)(ws + WS_WC1K), 8192u, 4096u, 512u, 128u, 2048};
            pg8::SchedCmp S{G, bx, WS_VC - WS_KC, WS_WC1V - WS_WC1K};
            epi::Cmp1 E{ws};
            pg8::gemm_phase<epi::Cmp1, pg8::SchedCmp, false>(ring, F.wave, g, S, E);
            VM_WAIT(); __syncthreads();
            __builtin_amdgcn_fence(__ATOMIC_ACQUIRE, "agent"); VM_WAIT();
            for (int u = bx; u < 64; u += G) cmp2_task(F, (u >> 5) * 256 + (u & 31) * 8 + F.wave);
        }
        { const int G2 = (G == 256) ? (cmp_cu ? 64 : 192) : G, c2 = (G == 256) ? (cmp_cu ? bx : bx - 64) : bx, u0 = (G == 256 && !cmp_cu) ? 64 : 0, u1 = (G == 256 && cmp_cu) ? 64 : 512;
          { pg8::Gemm g{(const char*)(ws + WS_PB0), (const char*)(ws + WS_WP0), 512u, 512u, 128u, 128u, 256};
            pg8::SchedStd S; S.init(128, 4, 0, G2, c2, (size_t)256 * 512, (size_t)256 * 512); S.range(u0, u1);
            epi::Bf16Plain E{(bf16_t*)(ws + WS_E0), 1024, 0};
            pg8::gemm_phase<epi::Bf16Plain, pg8::SchedStd, false>(ring, F.wave, g, S, E); }
          { pg8::Gemm g{(const char*)(ws + WS_PB1), (const char*)(ws + WS_WP1), 512u, 512u, 128u, 128u, 256};
            pg8::SchedStd S; S.init(128, 4, 0, G2, c2, (size_t)256 * 512, (size_t)256 * 512); S.range(u0, u1);
            epi::Bf16Plain E{(bf16_t*)(ws + WS_E1), 1024, 0};
            pg8::gemm_phase<epi::Bf16Plain, pg8::SchedStd, false>(ring, F.wave, g, S, E); }
          if (G == 256) { if (bx >= 128) for (int task = (bx - 128) * NWAVES + F.wave; task < 1024; task += 128 * NWAVES) gates_task(F, task); }
          else for (int task = bx * NWAVES + F.wave; task < 1024; task += G * NWAVES) gates_task(F, task);
          (void)other_cu; }
    }
    SEAM(3);
    if (IN(4)) for (int rep = 0; rep < REPS(4, 0); ++rep) nsa::nsa_phase(F);
    SEAM(4);
    if (IN(5)) for (int rep = 0; rep < REPS(5, 1); ++rep) {
        pg8::Gemm g{(const char*)(ws + WS_ATT), (const char*)(ws + WS_WNOUT), 2048u, 2048u, 128u, 128u, 1024};
        pg8::SchedStd S; S.init(128, 4, 0, G, bx, (size_t)256 * 2048, (size_t)256 * 2048);
        epi::Res<0> E{args.in[0], ws};
        pg8::gemm_phase<epi::Res<0>, pg8::SchedStd, false>(ring, F.wave, g, S, E);
    }
    SEAM(5);
    if (IN(6)) {
        pg8::Gemm g{(const char*)(ws + WS_X1B), (const char*)(ws + WS_WG0), 2048u, 2048u, 128u, 128u, 1024};
        pg8::SchedStd S; S.init(128, 4, 0, G, bx, (size_t)256 * 2048, (size_t)256 * 2048);
        epi::Ple<0> E{ws, dout};
        pg8::gemm_phase<epi::Ple<0>, pg8::SchedStd, false>(ring, F.wave, g, S, E);
    }
    SEAM(6);
    if (IN(7)) for (int rep = 0; rep < REPS(7, 1); ++rep) {
        pg8::Gemm g{(const char*)(ws + WS_XB), (const char*)(ws + WS_WRIN), 2048u, 2048u, 128u, 128u, 1024};
        { pg8::SchedStd S; S.init(128, 4, 0, G, bx, (size_t)256 * 2048, (size_t)256 * 2048);
          epi::RetQ E{ws};
          pg8::gemm_phase<epi::RetQ, pg8::SchedStd, false>(ring, F.wave, g, S, E);
#if defined(PROBE_P7) && PROBE_P7 == 1
          pg8::gemm_phase<epi::RetQ, pg8::SchedStd, false>(ring, F.wave, g, S, E);
#endif
          }
        { pg8::SchedStd S; S.init(128, 12, 4, G, bx, (size_t)256 * 2048, (size_t)256 * 2048);
          epi::RetKV E{ws, dout};
          pg8::gemm_phase<epi::RetKV, pg8::SchedStd, true>(ring, F.wave, g, S, E);
#if defined(PROBE_P7) && PROBE_P7 == 2
          pg8::gemm_phase<epi::RetKV, pg8::SchedStd, true>(ring, F.wave, g, S, E);
#endif
          }
    }
    SEAM(7);
    if (IN(8)) for (int rep = 0; rep < REPS(8, 0); ++rep) ret::p_phase(F);
    SEAM(8);
    if (IN(9)) for (int rep = 0; rep < REPS(9, 0); ++rep) ret::scan_phase(F, rep == 0);
    SEAM(9);
    if (IN(10)) {
        pg8::Gemm g{(const char*)(ws + WS_XB), (const char*)(ws + WS_WRIN), 2048u, 2048u, 128u, 128u, 1024};
        pg8::SchedStd S; S.init(128, 8, 16, G, bx, (size_t)256 * 2048, (size_t)256 * 2048);
        epi::RetZ E{ws, dout};
        pg8::gemm_phase<epi::RetZ, pg8::SchedStd, false>(ring, F.wave, g, S, E);
    }
    SEAM(10);
    if (IN(11)) for (int rep = 0; rep < REPS(11, 1); ++rep) {
        { pg8::Gemm g{(const char*)dout, (const char*)(ws + WS_WROUT), 4096u, 4096u, 128u, 128u, 2048};
          pg8::SchedStd S; S.init(128, 4, 0, G, bx, (size_t)256 * 4096, (size_t)256 * 4096);
          epi::Res<1> E{nullptr, ws};
          pg8::gemm_phase<epi::Res<1>, pg8::SchedStd, false>(ring, F.wave, g, S, E); }
    }
    SEAM(11);
    if (IN(12)) for (int rep = 0; rep < REPS(12, 1); ++rep) {
        pg8::Gemm g{(const char*)(ws + WS_X3B), (const char*)(ws + WS_WG1), 2048u, 2048u, 128u, 128u, 1024};
        pg8::SchedStd S; S.init(128, 4, 0, G, bx, (size_t)256 * 2048, (size_t)256 * 2048);
        epi::Ple<1> E{ws, dout};
        pg8::gemm_phase<epi::Ple<1>, pg8::SchedStd, false>(ring, F.wave, g, S, E);
    }
#undef IN
#undef SEAM
}

extern "C" void kernel_launch(void* const* d_in, const int* in_sizes, int n_in, void* d_out, int out_size, void* d_ws, size_t ws_size, hipStream_t stream) {
    static int grid = 0;
    if (grid == 0) {
        if (n_in != 19 || out_size != T_TOK * DM || ws_size < WS_END) { fprintf(stderr, "kernel_launch: unexpected problem (n_in %d, out %d, ws %zu)\n", n_in, out_size, ws_size); grid = -1; return; }
        int dev = 0, cus = 0, per_cu = 0;
        (void)hipGetDevice(&dev); (void)hipDeviceGetAttribute(&cus, hipDeviceAttributeMultiprocessorCount, dev);
        if (hipFuncSetAttribute((const void*)mk_fwd, hipFuncAttributeMaxDynamicSharedMemorySize, LDS_BYTES) != hipSuccess) { fprintf(stderr, "kernel_launch: hipFuncSetAttribute failed\n"); grid = -1; return; }
        if (hipOccupancyMaxActiveBlocksPerMultiprocessor(&per_cu, (const void*)mk_fwd, NWAVES * 64, LDS_BYTES) != hipSuccess || per_cu < 1) { fprintf(stderr, "kernel_launch: occupancy query gave %d\n", per_cu); per_cu = 1; }
        (void)hipGetLastError();
        if (per_cu > 1) per_cu = 1;
        grid = cus * per_cu;
    }
    if (grid < 0) return;
    (void)hipMemsetAsync((char*)d_ws + WS_CTL, 0, ZERO_BYTES, stream);
    Args a{};
    for (int i = 0; i < 19; ++i) a.in[i] = (const float*)d_in[i];
    a.out = (unsigned char*)d_out; a.ws = (unsigned char*)d_ws; a.ph_lo = 0; a.ph_hi = 13;
    void* kargs[] = {&a};
    hipError_t e = hipLaunchCooperativeKernel((const void*)mk_fwd, dim3(grid), dim3(NWAVES * 64), kargs, LDS_BYTES, stream);
    if (e != hipSuccess) fprintf(stderr, "kernel_launch: cooperative launch failed: %s (grid %d)\n", hipGetErrorString(e), grid);
}
```

```cpp
#include <hip/hip_runtime.h>
#include <hip/hip_cooperative_groups.h>
#include <cstdio>
#include <cstdint>
namespace cg = cooperative_groups;

#define LAS __attribute__((address_space(3)))
#define GAS __attribute__((address_space(1)))
typedef unsigned short bf16_t;
typedef short bf16x8 __attribute__((ext_vector_type(8)));
typedef short s16x4 __attribute__((ext_vector_type(4)));
typedef float f32x2 __attribute__((ext_vector_type(2)));
typedef float f32x4 __attribute__((ext_vector_type(4)));
typedef float f32x16 __attribute__((ext_vector_type(16)));
typedef unsigned u32x2 __attribute__((ext_vector_type(2)));
typedef unsigned u32x4 __attribute__((ext_vector_type(4)));

constexpr int T_TOK = 32768, SEQ = 4096, NB = 8, DM = 1024;
constexpr float LOG2E = 1.4426950408889634f;
constexpr float RMS_EPS = 1e-6f, GN_EPS = 1e-5f;

typedef __bf16 bf16x2_t __attribute__((ext_vector_type(2)));
__device__ __forceinline__ unsigned cvt_pk_bf16(float lo, float hi) { const f32x2 v = {lo, hi}; const bf16x2_t b = __builtin_convertvector(v, bf16x2_t); return __builtin_bit_cast(unsigned, b); }
__device__ __forceinline__ float bf_lo(unsigned w) { return __uint_as_float(w << 16); }
__device__ __forceinline__ float bf_hi(unsigned w) { return __uint_as_float(w & 0xffff0000u); }
__device__ __forceinline__ int lane_id() { int l; asm volatile("v_mbcnt_lo_u32_b32 %0, -1, 0\n\tv_mbcnt_hi_u32_b32 %0, -1, %0" : "=v"(l)); return l; }
__device__ __forceinline__ const char* uni_ptr(const char* p) {
    const unsigned long long v = (unsigned long long)p; const unsigned lo = __builtin_amdgcn_readfirstlane((unsigned)v), hi = __builtin_amdgcn_readfirstlane((unsigned)(v >> 32));
    return (const char*)(((unsigned long long)hi << 32) | lo); }
__device__ __forceinline__ float fast_rcp(float x) { return __builtin_amdgcn_rcpf(x); }
__device__ __forceinline__ float sigmoidf_(float x) { return fast_rcp(1.0f + __builtin_amdgcn_exp2f(-x * LOG2E)); }
__device__ __forceinline__ float siluf_(float x) { return x * sigmoidf_(x); }

#ifndef LD_ONCE_NT
#define LD_ONCE_NT 1
#endif
#if LD_ONCE_NT
#define LD_ONCE(p) __builtin_nontemporal_load(p)
#else
#define LD_ONCE(p) (*(p))
#endif
#ifndef FAR_ST_MODE
#define FAR_ST_MODE 1
#endif
template <class T> __device__ __forceinline__ void st_nt(T* p, const T v) {
    if constexpr (FAR_ST_MODE == 0) *p = v;
    else if constexpr (FAR_ST_MODE == 1) __builtin_nontemporal_store(v, p);
    else if constexpr (sizeof(T) == 16) { if constexpr (FAR_ST_MODE == 2) asm volatile("global_store_dwordx4 %0, %1, off sc1\n\ts_nop 1" :: "v"(p), "v"(v) : "memory"); else asm volatile("global_store_dwordx4 %0, %1, off sc0 sc1\n\ts_nop 1" :: "v"(p), "v"(v) : "memory"); }
    else { static_assert(sizeof(T) == 8, "st_nt: 8- or 16-byte vectors"); if constexpr (FAR_ST_MODE == 2) asm volatile("global_store_dwordx2 %0, %1, off sc1\n\ts_nop 1" :: "v"(p), "v"(v) : "memory"); else asm volatile("global_store_dwordx2 %0, %1, off sc0 sc1\n\ts_nop 1" :: "v"(p), "v"(v) : "memory"); }
}
__device__ __forceinline__ void st_wt(u32x4* p, const u32x4 v) { asm volatile("global_store_dwordx4 %0, %1, off sc1" :: "v"(p), "v"(v) : "memory"); }
__device__ __forceinline__ void st_wt01(u32x4* p, const u32x4 v) { asm volatile("global_store_dwordx4 %0, %1, off sc0 sc1" :: "v"(p), "v"(v) : "memory"); }
#ifndef NEAR_ST_MODE
#define NEAR_ST_MODE 0
#endif
template <class T> __device__ __forceinline__ void st_near(T* p, const T v) {
    if constexpr (NEAR_ST_MODE == 0) *p = v;
    else if constexpr (NEAR_ST_MODE == 1) __builtin_nontemporal_store(v, p);
    else { static_assert(sizeof(T) == 16, "st_near: 16-byte vectors");
        if constexpr (NEAR_ST_MODE == 2) asm volatile("global_store_dwordx4 %0, %1, off sc1\n\ts_nop 1" :: "v"(p), "v"(v) : "memory"); else asm volatile("global_store_dwordx4 %0, %1, off sc0 sc1\n\ts_nop 1" :: "v"(p), "v"(v) : "memory"); }
}
namespace pg8 {
constexpr int BM = 256, BK = 64, HALF = 128, HTB = HALF * BK * 2, STAGE_BYTES = 8 * HTB, NXCD = 8, WGM = 8;
__host__ __device__ __forceinline__ int lds_byte(int r, int c) { const int st = (r >> 4) * 2 + (c >> 5), rr = r & 15, cc = c & 31, ob = rr * 64 + cc * 2; return st * 1024 + (ob ^ (((ob >> 9) & 1) << 5)); }
__host__ __device__ __forceinline__ void stage_rc(int b, int& R, int& C) { const int st = b / 1024, sb = b % 1024, swz = sb ^ (((sb >> 9) & 1) << 5); R = (st >> 1) * 16 + swz / 64; C = (st & 1) * 32 + (swz % 64) / 2; }
__host__ __device__ __forceinline__ int perm32(int rho) { const int n = rho >> 4, i = rho & 15; return 8 * (i >> 2) + 4 * n + (i & 3); }

struct Unit { int pm, pn; };
struct Gemm { const char* A; const char* Bt; unsigned lda, ldb; unsigned ksA, ksB; int K; };

struct SchedStd {
    int nM, nN, nwg, G, c, pn0, first, last, rev; size_t a_ts, b_ts;
    __device__ __forceinline__ void init(int nM_, int nN_, int pn0_, int G_, int c_, size_t a_ts_, size_t b_ts_) { nM = nM_; nN = nN_; nwg = nM * nN; G = G_; c = c_; pn0 = pn0_; a_ts = a_ts_; b_ts = b_ts_; first = 0; last = nwg; rev = 0; }
    __device__ __forceinline__ void range(int first_, int last_) { first = first_; last = last_; }
    __device__ __forceinline__ bool next(int i, Unit& u) const {
        long L = (long)first + (long)i * G + c; if (L >= last) return false;
        if (rev) L = (long)last - 1 - ((long)i * G + c);
        int wgid = (int)L; { const int q = nwg / NXCD, r = nwg % NXCD, xcd = wgid % NXCD, off = wgid / NXCD; wgid = (xcd < r ? xcd * (q + 1) : r * (q + 1) + (xcd - r) * q) + off; }
#if defined(SCHED_PNMAJOR)
        u.pm = (int)(L % nM); u.pn = pn0 + (int)(L / nM); return true;
#else
        const int nig = WGM * nN, gid = wgid / nig, fm = gid * WGM, gsz = (nM - fm) < WGM ? (nM - fm) : WGM;
        u.pm = fm + ((wgid % nig) % gsz); u.pn = pn0 + (wgid % nig) / gsz; return true;
#endif
    }
    __device__ __forceinline__ unsigned a_off(const Unit& u) const { return (unsigned)u.pm * (unsigned)a_ts; }
    __device__ __forceinline__ unsigned b_off(const Unit& u) const { return (unsigned)u.pn * (unsigned)b_ts; }
};
struct SchedCmp {
    int G, c; size_t kv_stride_a, kv_stride_b;
    __device__ __forceinline__ bool next(int i, Unit& u) const { const int L = i * G + c; if (L >= 64) return false; u.pm = L; u.pn = 0; return true; }
    __device__ __forceinline__ unsigned a_off(const Unit& u) const { return (unsigned)(u.pm >> 5) * (unsigned)kv_stride_a + (unsigned)((u.pm >> 2) & 7) * (unsigned)(SEQ * 512) + (unsigned)(u.pm & 3) * 128u; }
    __device__ __forceinline__ unsigned b_off(const Unit& u) const { return (unsigned)(u.pm >> 5) * (unsigned)kv_stride_b; }
};

template <class Epi, class Sched, bool SWAP>
__device__ __forceinline__ void gemm_phase(LAS unsigned char* lds, const int wid, const Gemm g, const Sched& S, const Epi& E) {
    const int lane = lane_id(), tid = wid * 64 + lane, wr = wid >> 2, wc = wid & 3, fr = lane & 15, fq = lane >> 4;
    const int nt = g.K / BK;
    unsigned voffA[2], voffB[2];
#pragma unroll
    for (int i = 0; i < 2; ++i) { int R, C; stage_rc(tid * 16 + i * 8192, R, C); const int Rb = (!SWAP) ? ((R & ~31) + perm32(R & 31)) : R;
        voffA[i] = (unsigned)R * g.lda + (unsigned)C * 2u; voffB[i] = (unsigned)Rb * g.ldb + (unsigned)C * 2u; }
    const unsigned ksA = g.ksA, ksB = g.ksB;
    const unsigned hsA = (unsigned)HALF * g.lda, hsB = (unsigned)HALF * g.ldb;
    const unsigned ldsw = (unsigned)wid * 1024u;
    const int aoff = lds_byte(wr * 64 + fr, fq * 8), boff = lds_byte(wc * 32 + fr, fq * 8);
    const __amdgpu_buffer_rsrc_t rsA = __builtin_amdgcn_make_buffer_rsrc((void*)g.A, (short)0, 0x7fffffff, 0x00020000);
    const __amdgpu_buffer_rsrc_t rsB = __builtin_amdgcn_make_buffer_rsrc((void*)g.Bt, (short)0, 0x7fffffff, 0x00020000);
#define PG8_SA(b, h) (((b) * 2 + (h)) * HTB)
#define PG8_SB(b, h) ((4 + (b) * 2 + (h)) * HTB)
#define PG8_STAGE(bufoff, rs, soff, voff) do { _Pragma("unroll") for (int _i = 0; _i < 2; ++_i) \
        __builtin_amdgcn_raw_ptr_buffer_load_lds((rs), (LAS unsigned*)(lds + (bufoff) + ldsw + _i * 8192), 16, (int)(voff)[_i], (int)(soff), 0, 0); } while (0)
#define PG8_LDA(dst, b, h) do { _Pragma("unroll") for (int m = 0; m < 4; ++m) _Pragma("unroll") for (int k = 0; k < 2; ++k) dst[m][k] = *(const LAS bf16x8*)(lds + PG8_SA(b, h) + aoff + m * 2048 + k * 1024); } while (0)
#define PG8_LDB(dst, b, h) do { _Pragma("unroll") for (int n = 0; n < 2; ++n) _Pragma("unroll") for (int k = 0; k < 2; ++k) dst[n][k] = *(const LAS bf16x8*)(lds + PG8_SB(b, h) + boff + n * 2048 + k * 1024); } while (0)
#define PG8_MMA(ai, bj, At, Bt) do { __builtin_amdgcn_s_setprio(1); _Pragma("unroll") for (int m = 0; m < 4; ++m) _Pragma("unroll") for (int n = 0; n < 2; ++n) _Pragma("unroll") for (int k = 0; k < 2; ++k) \
        acc[ai][bj][m][n] = SWAP ? __builtin_amdgcn_mfma_f32_16x16x32_bf16(At[m][k], Bt[n][k], acc[ai][bj][m][n], 0, 0, 0) : __builtin_amdgcn_mfma_f32_16x16x32_bf16(Bt[n][k], At[m][k], acc[ai][bj][m][n], 0, 0, 0); __builtin_amdgcn_s_setprio(0); } while (0)
#define PG8_WAIT_V(n) asm volatile("s_waitcnt vmcnt(" #n ")" ::: "memory")
#define PG8_WAIT_L(n) asm volatile("s_waitcnt lgkmcnt(" #n ")" ::: "memory")
#define PG8_BAR __builtin_amdgcn_s_barrier()
#define PG8_SCHED __builtin_amdgcn_sched_barrier(0)
    Unit cur, nxt; int ui = 0;
    if (!S.next(0, cur)) return;
    f32x4 acc[2][2][4][2];
#pragma unroll
    for (int a = 0; a < 2; ++a)
#pragma unroll
        for (int b = 0; b < 2; ++b)
#pragma unroll
            for (int m = 0; m < 4; ++m)
#pragma unroll
                for (int n = 0; n < 2; ++n) acc[a][b][m][n] = (f32x4){0.f, 0.f, 0.f, 0.f};
    bf16x8 At[4][2], B0[2][2], B1[2][2];
    unsigned cA = S.a_off(cur), cB = S.b_off(cur);
    PG8_STAGE(PG8_SB(0, 0), rsB, cB, voffB); PG8_STAGE(PG8_SB(0, 1), rsB, cB + hsB, voffB); PG8_STAGE(PG8_SA(0, 0), rsA, cA, voffA); PG8_STAGE(PG8_SA(0, 1), rsA, cA + hsA, voffA);
    if (wr == 1) PG8_BAR;
    PG8_WAIT_V(2); PG8_BAR;
    PG8_STAGE(PG8_SB(1, 0), rsB, cB + ksB, voffB); PG8_STAGE(PG8_SA(1, 0), rsA, cA + ksA, voffA); PG8_STAGE(PG8_SB(1, 1), rsB, cB + hsB + ksB, voffB);
    PG8_WAIT_V(6); PG8_BAR;
    for (;;) {
        const bool has_next = S.next(ui + 1, nxt);
        const unsigned nA = has_next ? S.a_off(nxt) : cA, nB = has_next ? S.b_off(nxt) : cB;
        for (int t = 0; t < nt; t += 2) {
            const bool last = (t == nt - 2);
            const unsigned a1 = cA + (unsigned)(t + 1) * ksA;
            const unsigned a2 = last ? nA : cA + (unsigned)(t + 2) * ksA, b2 = last ? nB : cB + (unsigned)(t + 2) * ksB;
            const unsigned a3 = a2 + ksA, b3 = b2 + ksB;
            PG8_LDB(B0, 0, 0); PG8_LDB(B1, 0, 1); PG8_SCHED; PG8_LDA(At, 0, 0); PG8_STAGE(PG8_SA(1, 1), rsA, a1 + hsA, voffA);
            PG8_WAIT_V(8); PG8_WAIT_L(0); PG8_BAR; PG8_MMA(0, 0, At, B0); PG8_MMA(0, 1, At, B1); PG8_BAR; PG8_SCHED;
            PG8_LDA(At, 0, 1); PG8_STAGE(PG8_SB(0, 0), rsB, b2, voffB); PG8_STAGE(PG8_SB(0, 1), rsB, b2 + hsB, voffB); PG8_STAGE(PG8_SA(0, 0), rsA, a2, voffA);
            PG8_WAIT_V(8); PG8_WAIT_L(0); PG8_BAR; PG8_MMA(1, 0, At, B0); PG8_MMA(1, 1, At, B1); PG8_BAR; PG8_SCHED;
            PG8_LDB(B0, 1, 0); PG8_LDB(B1, 1, 1); PG8_SCHED; PG8_LDA(At, 1, 0); PG8_STAGE(PG8_SA(0, 1), rsA, a2 + hsA, voffA);
            PG8_WAIT_V(8); PG8_WAIT_L(0); PG8_BAR; PG8_MMA(0, 0, At, B0); PG8_MMA(0, 1, At, B1); PG8_BAR; PG8_SCHED;
            PG8_LDA(At, 1, 1); PG8_STAGE(PG8_SB(1, 0), rsB, b3, voffB); PG8_STAGE(PG8_SB(1, 1), rsB, b3 + hsB, voffB); PG8_STAGE(PG8_SA(1, 0), rsA, a3, voffA);
            PG8_WAIT_V(8); PG8_WAIT_L(0); PG8_BAR; PG8_MMA(1, 0, At, B0); PG8_MMA(1, 1, At, B1); PG8_BAR; PG8_SCHED;
        }
        if (wr == 0) PG8_BAR;
        E(acc, cur, wr, wc, fr, fq);
#if defined(PROBE_EPI)
        if (Epi::ID == PROBE_EPI) { asm volatile("" ::: "memory"); E(acc, cur, wr, wc, fr, fq); }
#endif
#if defined(PROBE_ST)
        if constexpr (Epi::ID == 30) { if (PROBE_ST != 4 || (blockIdx.x & 8)) { asm volatile("" ::: "memory"); E.probe(acc, cur, wr, wc, fr, fq); } }
#endif
        if (!has_next) break;
#pragma unroll
        for (int a = 0; a < 2; ++a)
#pragma unroll
            for (int b = 0; b < 2; ++b)
#pragma unroll
                for (int m = 0; m < 4; ++m)
#pragma unroll
                    for (int n = 0; n < 2; ++n) acc[a][b][m][n] = (f32x4){0.f, 0.f, 0.f, 0.f};
        cur = nxt; cA = nA; cB = nB; ++ui;
        if (wr == 1) PG8_BAR;
    }
    PG8_WAIT_V(0);
    PG8_BAR;
#undef PG8_SA
#undef PG8_SB
#undef PG8_STAGE
#undef PG8_LDA
#undef PG8_LDB
#undef PG8_MMA
#undef PG8_WAIT_V
#undef PG8_WAIT_L
#undef PG8_BAR
#undef PG8_SCHED
}
typedef f32x4 Acc[2][2][4][2];
}

constexpr size_t MiB = 1u << 20;
constexpr size_t WS_CTL = 0, WS_ROWSC0 = 1 * MiB, WS_ROWSS1 = 1 * MiB + 128 * 1024, WS_CBIAS = 1 * MiB + 256 * 1024, WS_GAINS = 1 * MiB + 264 * 1024, WS_STATS = 2 * MiB, ZERO_BYTES = 3 * MiB;
constexpr size_t WS_WRIN = 3 * MiB, WS_WROUT = 15 * MiB, WS_WG1 = 19 * MiB, WS_WP1 = 21 * MiB;
constexpr size_t WS_X2 = 22 * MiB;
constexpr size_t WS_XB = 150 * MiB;
constexpr size_t WS_PB0 = 214 * MiB;
constexpr size_t WS_KC = 230 * MiB, WS_VC = 246 * MiB, WS_KS = 262 * MiB, WS_VS = 278 * MiB, WS_KW = 294 * MiB, WS_VW = 310 * MiB;
constexpr size_t WS_G = 326 * MiB, WS_E0 = 332 * MiB, WS_ATT = 396 * MiB;
constexpr size_t WS_COS = 470 * MiB, WS_SIN = 472 * MiB, WS_COST = 102 * MiB, WS_SINT = 104 * MiB;
constexpr size_t WS_WNIN = 474 * MiB, WS_WNOUT = 482 * MiB, WS_WG0 = 484 * MiB, WS_WP0 = 486 * MiB, WS_WC1K = 487 * MiB, WS_WC1V = 488 * MiB, WS_WC2K = 489 * MiB, WS_WC2V = 489 * MiB + 65536, WS_WGT = 490 * MiB;
constexpr size_t WS_HID = 492 * MiB, WS_KCC = 500 * MiB, WS_VCC = 501 * MiB;
constexpr size_t WS_X1B = 230 * MiB;
constexpr size_t WS_QP = 214 * MiB, WS_KTP = 278 * MiB, WS_VT = 342 * MiB, WS_PT = 470 * MiB, WS_PB1 = 22 * MiB;
constexpr size_t WS_X3B = 342 * MiB, WS_E1 = 38 * MiB;
constexpr size_t WS_END = 512 * MiB;
constexpr size_t DO_Q = 0, DO_Z = 64 * MiB;
constexpr int CW_BAR = 4096;
constexpr int RING_BYTES = 131072, LDSCTL_OFF = 150016, MISC_OFF = LDSCTL_OFF + 320, LDS_GATE = 151552, LDS_BYTES = 154624;
constexpr int NWAVES = 8;


namespace epi {
using pg8::Unit; using pg8::Acc;
__device__ __forceinline__ u32x4 pack8(const f32x4& a, const f32x4& b) { u32x4 w; w.x = cvt_pk_bf16(a[0], a[1]); w.y = cvt_pk_bf16(a[2], a[3]); w.z = cvt_pk_bf16(b[0], b[1]); w.w = cvt_pk_bf16(b[2], b[3]); return w; }
__device__ __forceinline__ void unpack8(const u32x4& w, f32x4& a, f32x4& b) { a[0] = bf_lo(w.x); a[1] = bf_hi(w.x); a[2] = bf_lo(w.y); a[3] = bf_hi(w.y); b[0] = bf_lo(w.z); b[1] = bf_hi(w.z); b[2] = bf_lo(w.w); b[3] = bf_hi(w.w); }
__device__ __forceinline__ float rowquad_sum(float v) {
    auto a = __builtin_amdgcn_permlane16_swap(__float_as_uint(v), __float_as_uint(v), false, false); v = __uint_as_float(a[0]) + __uint_as_float(a[1]);
    auto b = __builtin_amdgcn_permlane32_swap(__float_as_uint(v), __float_as_uint(v), false, false); return __uint_as_float(b[0]) + __uint_as_float(b[1]);
}
__device__ __forceinline__ float dot4(const f32x4& a) { return (a[0] * a[0] + a[1] * a[1]) + (a[2] * a[2] + a[3] * a[3]); }

struct Bf16Plain {
    static constexpr int ID = 10;
    static constexpr bool PERM = true;
    bf16_t* O; int ldc; int col0;
    __device__ __forceinline__ void operator()(const Acc& acc, const Unit& u, int wr, int wc, int fr, int fq) const {
#pragma unroll
        for (int ai = 0; ai < 2; ++ai)
#pragma unroll
            for (int m = 0; m < 4; ++m) { const int row = u.pm * 256 + ai * 128 + wr * 64 + m * 16 + fr; bf16_t* rp = O + (size_t)row * ldc + (u.pn * 256 - col0 + wc * 32 + fq * 8);
#pragma unroll
                for (int bj = 0; bj < 2; ++bj) st_nt((u32x4*)(rp + bj * 128), (u32x4)(pack8(acc[ai][bj][m][0], acc[ai][bj][m][1]))); }
    }
};
struct Cmp1 {
    static constexpr int ID = 20;
    static constexpr bool PERM = true;
    unsigned char* ws;
    __device__ __forceinline__ void operator()(const Acc& acc, const Unit& u, int wr, int wc, int fr, int fq) const {
        bf16_t* H = (bf16_t*)(ws + WS_HID);
        const float* bb = (const float*)(ws + WS_CBIAS) + (u.pm >> 5) * 256;
        f32x4 bv[2][2];
#pragma unroll
        for (int bj = 0; bj < 2; ++bj)
#pragma unroll
            for (int n = 0; n < 2; ++n) bv[bj][n] = *(const f32x4*)(bb + bj * 128 + wc * 32 + fq * 8 + n * 4);
#pragma unroll
        for (int ai = 0; ai < 2; ++ai)
#pragma unroll
            for (int m = 0; m < 4; ++m) { const int row = u.pm * 256 + ai * 128 + wr * 64 + m * 16 + fr; bf16_t* rp = H + (size_t)row * 256 + (wc * 32 + fq * 8);
#pragma unroll
                for (int bj = 0; bj < 2; ++bj) { f32x4 v0 = acc[ai][bj][m][0] + bv[bj][0], v1 = acc[ai][bj][m][1] + bv[bj][1];
#pragma unroll
                    for (int x = 0; x < 4; ++x) { v0[x] = siluf_(v0[x]); v1[x] = siluf_(v1[x]); }
                    *(u32x4*)(rp + bj * 128) = pack8(v0, v1); } }
    }
};
struct NsaIn {
    static constexpr int ID = 30;
    static constexpr bool PERM = true;
    unsigned char* ws; unsigned char* dout;
    __device__ __forceinline__ void operator()(const Acc& acc, const Unit& u, int wr, int wc, int fr, int fq) const {
        const int pn = u.pn;
        const float* rowscale = (const float*)(ws + WS_ROWSC0); const float* gains = (const float*)(ws + WS_GAINS);
        const float *q_g = gains, *ks_g = gains + 128, *kw_g = gains + 192;
        bf16_t* Q = (bf16_t*)(dout + DO_Q); bf16_t* Z = (bf16_t*)(dout + DO_Z);
        const bool normed = (pn < 4) || pn == 6 || pn == 8;
        f32x4 gq[2][2];
        if (normed) { const float* gp = (pn < 4) ? q_g : (pn == 6 ? ks_g : kw_g); const float sc = (pn < 4) ? 0.125f * LOG2E : 1.0f;
#pragma unroll
            for (int bj = 0; bj < 2; ++bj)
#pragma unroll
                for (int n = 0; n < 2; ++n) gq[bj][n] = *(const f32x4*)(gp + bj * 32 + fq * 8 + n * 4) * sc; }
        bf16_t* dst; int ldc, cbase;
        if (pn < 4) { dst = Q; ldc = 1024; cbase = pn * 256; }
        else if (pn < 10) { dst = (bf16_t*)(ws + WS_KC + (size_t)(pn - 4) * (16 * MiB)); ldc = 256; cbase = 0; }
        else { dst = Z; ldc = 1024; cbase = (pn - 10) * 256; }
        float rsc[8];
#pragma unroll
        for (int i = 0; i < 8; ++i) rsc[i] = rowscale[u.pm * 256 + (i >> 2) * 128 + wr * 64 + (i & 3) * 16 + fr];
#pragma unroll
        for (int ai = 0; ai < 2; ++ai)
#pragma unroll
            for (int m = 0; m < 4; ++m) {
                const int row = u.pm * 256 + ai * 128 + wr * 64 + m * 16 + fr; const float s = rsc[ai * 4 + m];
                f32x4 v[2][2];
#pragma unroll
                for (int bj = 0; bj < 2; ++bj)
#pragma unroll
                    for (int n = 0; n < 2; ++n) v[bj][n] = acc[ai][bj][m][n] * s;
                if (normed) { float ss = (dot4(v[0][0]) + dot4(v[0][1])) + (dot4(v[1][0]) + dot4(v[1][1]));
                    ss = rowquad_sum(ss);
                    const float rn = __builtin_amdgcn_rsqf(ss * (1.0f / 64.0f) + RMS_EPS);
#pragma unroll
                    for (int bj = 0; bj < 2; ++bj)
#pragma unroll
                        for (int n = 0; n < 2; ++n) v[bj][n] = v[bj][n] * rn * gq[bj][n]; }
                else if (pn >= 10) {
#pragma unroll
                    for (int bj = 0; bj < 2; ++bj)
#pragma unroll
                        for (int n = 0; n < 2; ++n)
#pragma unroll
                            for (int x = 0; x < 4; ++x) v[bj][n][x] = siluf_(v[bj][n][x]); }
                bf16_t* rp = dst + (size_t)row * ldc + cbase + wc * 64 + fq * 8;
#pragma unroll
                for (int bj = 0; bj < 2; ++bj) st_nt((u32x4*)(rp + bj * 32), (u32x4)(pack8(v[bj][0], v[bj][1])));
            }
    }
#if defined(PROBE_ST)
    __device__ __forceinline__ void probe(const Acc& acc, const Unit& u, int wr, int wc, int fr, int fq) const {
#ifndef PROBE_STX
#define PROBE_STX 1
#endif
        for (int rg = 0; rg < PROBE_STX; ++rg) {
        bf16_t* base = (bf16_t*)(ws + (rg == 0 ? WS_E1 : rg == 1 ? WS_E0 : WS_ATT));
        asm volatile("" ::: "memory");
#pragma unroll
        for (int ai = 0; ai < 2; ++ai)
#pragma unroll
            for (int m = 0; m < 4; ++m) {
                const int row = (PROBE_ST == 1) ? (int)blockIdx.x * 16 + fr : u.pm * 256 + ai * 128 + wr * 64 + m * 16 + fr;
                bf16_t* rp = (PROBE_ST >= 5) ? base + ((size_t)(u.pm * 4 + (u.pn & 3)) * 65536) + (size_t)((((wr * 4 + wc) * 2 + ai) * 4 + m) * 2) * 512 + (fq * 16 + fr) * 8
                                             : base + (size_t)row * 1024 + (u.pn & 3) * 256 + wc * 64 + fq * 8;
#pragma unroll
                for (int bj = 0; bj < 2; ++bj) { u32x4* dp = (u32x4*)(rp + bj * (PROBE_ST >= 5 ? 512 : 32));
                    if (PROBE_ST == 3 || PROBE_ST == 6) __builtin_nontemporal_store(pack8(acc[ai][bj][m][0], acc[ai][bj][m][1]), dp);
                    else if (PROBE_ST == 7) st_wt(dp, pack8(acc[ai][bj][m][0], acc[ai][bj][m][1]));
                    else if (PROBE_ST == 8) st_wt01(dp, pack8(acc[ai][bj][m][0], acc[ai][bj][m][1]));
                    else *dp = pack8(acc[ai][bj][m][0], acc[ai][bj][m][1]); }
            }
        }
    }
#endif
};
template <int LAYER> struct Res {
    static constexpr int ID = 40 + LAYER;
    static constexpr bool PERM = true;
    const float* x; unsigned char* ws;
    __device__ __forceinline__ void operator()(const Acc& acc, const Unit& u, int wr, int wc, int fr, int fq) const {
        const bf16_t* xinb = (const bf16_t*)(ws + WS_XB); bf16_t* xb = (bf16_t*)(ws + (LAYER == 0 ? WS_X1B : WS_X3B));
        const unsigned base = (unsigned)(u.pm * 256 + wr * 64 + fr) * 1024u + (unsigned)(u.pn * 256 + wc * 32 + fq * 8);
        f32x4 ra[2][4], rc[2][4]; u32x4 rb[2][4];
#define RES_ISSUE(k) { _Pragma("unroll") for (int mm = 0; mm < 2; ++mm) _Pragma("unroll") for (int bj = 0; bj < 2; ++bj) { \
            const unsigned off = base + (unsigned)((((k) >> 1) * 128 + (((k) & 1) * 2 + mm) * 16) * 1024 + bj * 128); \
            if (LAYER == 0) { ra[(k) & 1][mm * 2 + bj] = LD_ONCE((const f32x4*)(x + off)); rc[(k) & 1][mm * 2 + bj] = LD_ONCE((const f32x4*)(x + off + 4)); } \
            else rb[(k) & 1][mm * 2 + bj] = *(const u32x4*)(xinb + off); } }
        RES_ISSUE(0)
#pragma unroll
        for (int k = 0; k < 4; ++k) {
            if (k < 3) RES_ISSUE(k + 1)
            const int ai = k >> 1;
#pragma unroll
            for (int mm = 0; mm < 2; ++mm) { const int m = (k & 1) * 2 + mm;
#pragma unroll
                for (int bj = 0; bj < 2; ++bj) { const unsigned off = base + (unsigned)((ai * 128 + m * 16) * 1024 + bj * 128);
                    f32x4 r0, r1;
                    if (LAYER == 0) { r0 = ra[k & 1][mm * 2 + bj]; r1 = rc[k & 1][mm * 2 + bj]; } else unpack8(rb[k & 1][mm * 2 + bj], r0, r1);
                    st_near((u32x4*)(xb + off), (u32x4)pack8(r0 + acc[ai][bj][m][0], r1 + acc[ai][bj][m][1])); } }
        }
#undef RES_ISSUE
    }
};
template <int LAYER> struct Ple {
    static constexpr int ID = 50 + LAYER;
    static constexpr bool PERM = true; static constexpr bool NEXT = (LAYER == 0);
    unsigned char* ws; unsigned char* dout;
    __device__ __forceinline__ void operator()(const Acc& acc, const Unit& u, int wr, int wc, int fr, int fq) const {
        const bf16_t* xinb = (const bf16_t*)(ws + (LAYER == 0 ? WS_X1B : WS_X3B)); const bf16_t* E = (const bf16_t*)(ws + (LAYER == 0 ? WS_E0 : WS_E1));
        float* xout = (float*)dout; bf16_t* xb = (bf16_t*)(ws + WS_XB); float* rowss = (float*)(ws + WS_ROWSS1);
        const unsigned base = (unsigned)(u.pm * 256 + wr * 64 + fr) * 1024u + (unsigned)(u.pn * 256 + wc * 32 + fq * 8);
        u32x4 eb[2][4], rb[2][4];
#define PLE_ISSUE(k) { _Pragma("unroll") for (int mm = 0; mm < 2; ++mm) _Pragma("unroll") for (int bj = 0; bj < 2; ++bj) { \
            const unsigned off = base + (unsigned)((((k) >> 1) * 128 + (((k) & 1) * 2 + mm) * 16) * 1024 + bj * 128); \
            eb[(k) & 1][mm * 2 + bj] = LD_ONCE((const u32x4*)(E + off)); rb[(k) & 1][mm * 2 + bj] = *(const u32x4*)(xinb + off); } }
        PLE_ISSUE(0)
#pragma unroll
        for (int k = 0; k < 4; ++k) {
            if (k < 3) PLE_ISSUE(k + 1)
            const int ai = k >> 1;
#pragma unroll
            for (int mm = 0; mm < 2; ++mm) { const int m = (k & 1) * 2 + mm; float ss = 0.f;
#pragma unroll
                for (int bj = 0; bj < 2; ++bj) { const unsigned off = base + (unsigned)((ai * 128 + m * 16) * 1024 + bj * 128);
                    f32x4 e0, e1, r0, r1; unpack8(eb[k & 1][mm * 2 + bj], e0, e1); unpack8(rb[k & 1][mm * 2 + bj], r0, r1);
                    f32x4 g0 = acc[ai][bj][m][0], g1 = acc[ai][bj][m][1];
#pragma unroll
                    for (int x = 0; x < 4; ++x) { g0[x] = sigmoidf_(g0[x]); g1[x] = sigmoidf_(g1[x]); }
                    const f32x4 o0 = r0 + g0 * e0, o1 = r1 + g1 * e1;
                    if (NEXT) { st_near((u32x4*)(xb + off), (u32x4)pack8(o0, o1)); ss += dot4(o0) + dot4(o1); }
                    else { st_nt((f32x4*)(xout + off), (f32x4)(o0)); st_nt((f32x4*)(xout + off + 4), (f32x4)(o1)); } }
                if (NEXT) { ss = rowquad_sum(ss); if (fq == 0) atomicAdd(rowss + (u.pm * 256 + ai * 128 + wr * 64 + m * 16 + fr), ss); } }
        }
#undef PLE_ISSUE
    }
};

__device__ __forceinline__ size_t qt_index(int b, int tok, int h, int d) { return ((((size_t)(b * 128 + (tok >> 5)) * 4 + h) * 16 + (d >> 4)) * 2 + ((d >> 3) & 1)) * 256 + (tok & 31) * 8 + (d & 7); }
__device__ __forceinline__ size_t tt_index(int bh, int nblk, int row, int tok) { return ((((size_t)bh * nblk + (row >> 5)) * 256 + (tok >> 4)) * 2 + ((tok >> 3) & 1)) * 256 + (row & 31) * 8 + (tok & 7); }
__device__ __forceinline__ float log2_gamma(int h) { return __log2f(1.0f - __builtin_amdgcn_exp2f(-5.0f - (float)h)); }
struct RetQ {
    static constexpr int ID = 60;
    static constexpr bool PERM = true;
    unsigned char* ws;
    __device__ __forceinline__ void operator()(const Acc& acc, const Unit& u, int wr, int wc, int fr, int fq) const {
        const float* rowss = (const float*)(ws + WS_ROWSS1); const float* cosT = (const float*)(ws + WS_COS); const float* sinT = (const float*)(ws + WS_SIN); bf16_t* Qp = (bf16_t*)(ws + WS_QP);
        const int h = u.pn; const float l2g = log2_gamma(h);
        const int rbase = u.pm * 256 + wr * 64 + fr; const int d0 = wc * 32 + fq * 8;
        f32x4 cb[2][4], sb[2][4]; float rs[2][2];
#define RQ_ISSUE(k) { _Pragma("unroll") for (int mm = 0; mm < 2; ++mm) { const int row = rbase + ((k) >> 1) * 128 + (((k) & 1) * 2 + mm) * 16; const int pos = row & (SEQ - 1); \
            rs[(k) & 1][mm] = rowss[row]; \
            _Pragma("unroll") for (int n = 0; n < 2; ++n) { cb[(k) & 1][mm * 2 + n] = *(const f32x4*)(cosT + (size_t)pos * 128 + d0 + n * 4); sb[(k) & 1][mm * 2 + n] = *(const f32x4*)(sinT + (size_t)pos * 128 + d0 + n * 4); } } }
        RQ_ISSUE(0)
#pragma unroll
        for (int k = 0; k < 4; ++k) {
            if (k < 3) RQ_ISSUE(k + 1)
            const int ai = k >> 1;
#pragma unroll
            for (int mm = 0; mm < 2; ++mm) { const int m = (k & 1) * 2 + mm; const int row = rbase + ai * 128 + m * 16;
                const float s = __builtin_amdgcn_rsqf(rs[k & 1][mm] * (1.0f / 1024.0f) + RMS_EPS);
                const int pos = row & (SEQ - 1), il = row & 127; const float dec = __builtin_amdgcn_exp2f((float)(il + 1) * l2g) * s;
                f32x4 y1[2], y2[2];
#pragma unroll
                for (int n = 0; n < 2; ++n) { const f32x4 c4 = cb[k & 1][mm * 2 + n], s4 = sb[k & 1][mm * 2 + n];
                    const f32x4 x1 = acc[ai][0][m][n], x2 = acc[ai][1][m][n]; y1[n] = (x1 * c4 - x2 * s4) * dec; y2[n] = (x1 * s4 + x2 * c4) * dec; }
                bf16_t* rp = Qp + qt_index(row >> 12, pos, h, d0);
                st_nt((u32x4*)rp, (u32x4)(pack8(y1[0], y1[1]))); st_nt((u32x4*)(rp + 8 * 512), (u32x4)(pack8(y2[0], y2[1]))); }
        }
#undef RQ_ISSUE
    }
};
#ifndef KP_QUAD_TRANSPOSE
#define KP_QUAD_TRANSPOSE 1
#endif
__device__ __forceinline__ f32x4 quad_transpose(f32x4 t, int q) {
#define QT_DPP(v, ctrl) __int_as_float(__builtin_amdgcn_update_dpp(0, __float_as_int(v), ctrl, 0xf, 0xf, true))
    { const bool o = q & 1; const float s0 = o ? t[0] : t[1], s1 = o ? t[2] : t[3]; const float r0 = QT_DPP(s0, 0xB1), r1 = QT_DPP(s1, 0xB1);
      if (o) { t[0] = r0; t[2] = r1; } else { t[1] = r0; t[3] = r1; } }
    { const bool o = (q >> 1) & 1; const float s0 = o ? t[0] : t[2], s1 = o ? t[1] : t[3]; const float r0 = QT_DPP(s0, 0x4E), r1 = QT_DPP(s1, 0x4E);
      if (o) { t[0] = r0; t[1] = r1; } else { t[2] = r0; t[3] = r1; } }
#undef QT_DPP
    return t;
}
#ifndef WIDE_T_STORES
#define WIDE_T_STORES 1
#endif
__device__ __forceinline__ u32x4 pair_widen(u32x2 w0, u32x2 w1) {
    auto rx = __builtin_amdgcn_permlane16_swap(w0.x, w1.x, false, false); auto ry = __builtin_amdgcn_permlane16_swap(w0.y, w1.y, false, false);
    return (u32x4){rx[0], ry[0], rx[1], ry[1]};
}
struct RetKV {
    static constexpr int ID = 70;
    static constexpr bool PERM = false;
    unsigned char* ws; unsigned char* dout;
    __device__ __forceinline__ void operator()(const Acc& acc, const Unit& u, int wr, int wc, int fr, int fq) const {
        const float* rowss = (const float*)(ws + WS_ROWSS1); const float* cosT = (const float*)(ws + WS_COST); const float* sinT = (const float*)(ws + WS_SINT);
        bf16_t* Kp = (bf16_t*)dout; bf16_t* Ktp = (bf16_t*)(ws + WS_KTP); bf16_t* Vt = (bf16_t*)(ws + WS_VT);
        const int pn = u.pn; const bool isk = pn < 8; const int h = isk ? pn - 4 : (pn - 8) >> 1; const int ebase = isk ? 0 : ((pn - 8) & 1) * 256;
        const float l2g = log2_gamma(h);
#pragma unroll
        for (int ai = 0; ai < 2; ++ai)
#pragma unroll
            for (int m = 0; m < 4; ++m) { const int row0 = u.pm * 256 + ai * 128 + wr * 64 + m * 16 + fq * 4; const int b = row0 >> 12, t0 = row0 & (SEQ - 1);
                f32x4 s4 = *(const f32x4*)(rowss + row0);
#pragma unroll
                for (int x = 0; x < 4; ++x) s4[x] = __builtin_amdgcn_rsqf(s4[x] * (1.0f / 1024.0f) + RMS_EPS);
                if (isk) {
                    f32x4 kd;
#pragma unroll
                    for (int x = 0; x < 4; ++x) kd[x] = __builtin_amdgcn_exp2f((float)(127 - ((t0 + x) & 127)) * l2g) * 0.0625f * s4[x];
#if WIDE_T_STORES
                    u32x2 kw1[2], kw2[2];
#endif
#pragma unroll
                    for (int n = 0; n < 2; ++n) { const int d = wc * 32 + n * 16 + fr;
                        const f32x4 c4 = *(const f32x4*)(cosT + (size_t)d * SEQ + t0), s4r = *(const f32x4*)(sinT + (size_t)d * SEQ + t0);
                        const f32x4 x1 = acc[ai][0][m][n], x2 = acc[ai][1][m][n];
                        const f32x4 y1 = (x1 * c4 - x2 * s4r) * kd, y2 = (x1 * s4r + x2 * c4) * kd;
                        u32x2 w1, w2; w1.x = cvt_pk_bf16(y1[0], y1[1]); w1.y = cvt_pk_bf16(y1[2], y1[3]); w2.x = cvt_pk_bf16(y2[0], y2[1]); w2.y = cvt_pk_bf16(y2[2], y2[3]);
#if WIDE_T_STORES
                        kw1[n] = w1; kw2[n] = w2;
#else
                        bf16_t* tp = Ktp + tt_index(b * 4 + h, 8, d, t0); st_nt((u32x2*)tp, (u32x2)(w1)); st_nt((u32x2*)(tp + (size_t)4 * 256 * 512), (u32x2)(w2));
#endif
#if KP_QUAD_TRANSPOSE
                        { const int q4 = fr & 3; const f32x4 z1 = quad_transpose(y1, q4), z2 = quad_transpose(y2, q4);
                          bf16_t* rp = Kp + qt_index(b, t0 + q4, h, d - q4);
                          u32x2 v1, v2; v1.x = cvt_pk_bf16(z1[0], z1[1]); v1.y = cvt_pk_bf16(z1[2], z1[3]); v2.x = cvt_pk_bf16(z2[0], z2[1]); v2.y = cvt_pk_bf16(z2[2], z2[3]);
                          *(u32x2*)rp = v1; *(u32x2*)(rp + 8 * 512) = v2; }
#else
                        bf16_t* rp = Kp + qt_index(b, t0, h, d);
                        rp[0] = (bf16_t)(w1.x & 0xffffu); rp[8] = (bf16_t)(w1.x >> 16); rp[16] = (bf16_t)(w1.y & 0xffffu); rp[24] = (bf16_t)(w1.y >> 16);
                        rp[8 * 512] = (bf16_t)(w2.x & 0xffffu); rp[8 * 512 + 8] = (bf16_t)(w2.x >> 16); rp[8 * 512 + 16] = (bf16_t)(w2.y & 0xffffu); rp[8 * 512 + 24] = (bf16_t)(w2.y >> 16);
#endif
                    }
#if WIDE_T_STORES
                    { const int odd = fq & 1; bf16_t* tp = Ktp + tt_index(b * 4 + h, 8, wc * 32 + odd * 16 + fr, t0 - 4 * odd);
                      st_nt((u32x4*)tp, pair_widen(kw1[0], kw1[1])); st_nt((u32x4*)(tp + (size_t)4 * 256 * 512), pair_widen(kw2[0], kw2[1])); }
#endif
                } else {
#pragma unroll
                    for (int bj = 0; bj < 2; ++bj) {
#if WIDE_T_STORES
                        u32x2 vw[2];
#pragma unroll
                        for (int n = 0; n < 2; ++n) { const f32x4 v = acc[ai][bj][m][n] * s4; vw[n].x = cvt_pk_bf16(v[0], v[1]); vw[n].y = cvt_pk_bf16(v[2], v[3]); }
                        const int odd = fq & 1;
                        st_nt((u32x4*)(Vt + tt_index(b * 4 + h, 16, ebase + bj * 128 + wc * 32 + odd * 16 + fr, t0 - 4 * odd)), pair_widen(vw[0], vw[1]));
#else
#pragma unroll
                        for (int n = 0; n < 2; ++n) { const int e = ebase + bj * 128 + wc * 32 + n * 16 + fr; const f32x4 v = acc[ai][bj][m][n] * s4;
                            u32x2 w; w.x = cvt_pk_bf16(v[0], v[1]); w.y = cvt_pk_bf16(v[2], v[3]);
                            st_nt((u32x2*)(Vt + tt_index(b * 4 + h, 16, e, t0)), (u32x2)(w)); }
#endif
                    }
                }
                if (m & 1) asm volatile("" ::: "memory"); }
    }
};
struct RetZ {
    static constexpr int ID = 80;
    static constexpr bool PERM = true;
    unsigned char* ws; unsigned char* dout;
    __device__ __forceinline__ void operator()(const Acc& acc, const Unit& u, int wr, int wc, int fr, int fq) const {
        const float* rowss = (const float*)(ws + WS_ROWSS1); const float* stats = (const float*)(ws + WS_STATS); bf16_t* O = (bf16_t*)dout;
        const int zt = u.pn - 16, h = zt >> 1;
        const int rbase = u.pm * 256 + wr * 64 + fr;
        const unsigned obase = (unsigned)rbase * 2048u + (unsigned)(zt * 256 + wc * 32 + fq * 8);
        const float* sp0 = stats + ((size_t)((rbase >> 12) * 4 + h) * 2) * SEQ + (rbase & (SEQ - 1));
        u32x4 ob[2][4]; float rs[2][2], s0[2][2], s1[2][2];
#define RZ_ISSUE(k) { _Pragma("unroll") for (int mm = 0; mm < 2; ++mm) { const int ro = ((k) >> 1) * 128 + (((k) & 1) * 2 + mm) * 16; \
            rs[(k) & 1][mm] = rowss[rbase + ro]; s0[(k) & 1][mm] = sp0[ro]; s1[(k) & 1][mm] = sp0[SEQ + ro]; \
            _Pragma("unroll") for (int bj = 0; bj < 2; ++bj) ob[(k) & 1][mm * 2 + bj] = *(const u32x4*)(O + obase + (unsigned)(ro * 2048 + bj * 128)); } }
        RZ_ISSUE(0)
#pragma unroll
        for (int k = 0; k < 4; ++k) {
            if (k < 3) RZ_ISSUE(k + 1)
            const int ai = k >> 1;
#pragma unroll
            for (int mm = 0; mm < 2; ++mm) { const int m = (k & 1) * 2 + mm; const int ro = ai * 128 + m * 16;
                const float s = __builtin_amdgcn_rsqf(rs[k & 1][mm] * (1.0f / 1024.0f) + RMS_EPS);
                const float mu = s0[k & 1][mm] * (1.0f / 512.0f); float var = s1[k & 1][mm] * (1.0f / 512.0f) - mu * mu; var = var > 0.f ? var : 0.f; const float rstd = __builtin_amdgcn_rsqf(var + GN_EPS);
#pragma unroll
                for (int bj = 0; bj < 2; ++bj) { bf16_t* p = O + obase + (unsigned)(ro * 2048 + bj * 128);
                    f32x4 o0, o1; unpack8(ob[k & 1][mm * 2 + bj], o0, o1); f32x4 z0 = acc[ai][bj][m][0] * s, z1 = acc[ai][bj][m][1] * s;
#pragma unroll
                    for (int x = 0; x < 4; ++x) { z0[x] = siluf_(z0[x]); z1[x] = siluf_(z1[x]); }
                    o0 = (o0 - mu) * rstd * z0; o1 = (o1 - mu) * rstd * z1; st_near((u32x4*)p, (u32x4)pack8(o0, o1)); } }
        }
#undef RZ_ISSUE
    }
};
}
#ifndef P0_NT
#define P0_NT 0
#endif
#ifndef EARLY_WB
#define EARLY_WB 0
#endif
#ifndef PROBE_INV
#define PROBE_INV 0
#endif
#define RLX_AGENT __ATOMIC_RELAXED, __HIP_MEMORY_SCOPE_AGENT
#define LDS_WAIT() asm volatile("s_waitcnt lgkmcnt(0)" ::: "memory")
#define VM_WAIT() asm volatile("s_waitcnt vmcnt(0)" ::: "memory")

#define XB_TMO      128
#define XB_XCNT(j)  (256  + 64 * (j))
#define XB_XSUB(j)  (1280 + 64 * (j))
#define XB_XGEN(j)  (2304 + 64 * (j))
#define XB_TOP      3328
#define XB_TOPGEN   3392
#define XCD_BAR_WORDS 3456
#define XB_SPIN_CAP (1u << 23)
__device__ __forceinline__ unsigned xb_ld(unsigned* p)              { return __hip_atomic_load(p, __ATOMIC_RELAXED, __HIP_MEMORY_SCOPE_AGENT); }
__device__ __forceinline__ unsigned xb_add(unsigned* p, unsigned v) { return __hip_atomic_fetch_add(p, v, __ATOMIC_RELAXED, __HIP_MEMORY_SCOPE_AGENT); }
__device__ __forceinline__ unsigned xb_xcc_id() { return (unsigned)__builtin_amdgcn_s_getreg((3 << 11) | 20) & 0xFu; }
#define XB_SPIN(cond, bar) do { unsigned _sp = 0; while (cond) { __builtin_amdgcn_s_sleep(1); \
    if ((++_sp & 255u) == 0u) { if (xb_ld(&(bar)[XB_TMO])) break; if (_sp > XB_SPIN_CAP) { atomicAdd(&(bar)[XB_TMO], 1u); break; } } } } while (0)
struct XcdBarrier { unsigned* bar; unsigned x; volatile LAS unsigned* st; int wave; };
__device__ __forceinline__ XcdBarrier xcd_barrier_post(unsigned* bar, volatile LAS unsigned* st, int wave) {
    XcdBarrier b; b.bar = bar; b.x = xb_xcc_id(); b.st = st; b.wave = wave;
    if (wave == 0 && lane_id() == 0) (void)xb_add(&bar[XB_XCNT(b.x)], 1u);
    return b;
}
__device__ __forceinline__ void xcd_barrier_complete(unsigned* bar, unsigned x, unsigned& nloc, unsigned& nx) {
    const unsigned G = gridDim.x * gridDim.y * gridDim.z;
    unsigned sum, cnt, mine, sp = 0u;
    for (;;) {
        sum = 0u; cnt = 0u; mine = 0u;
#pragma unroll
        for (unsigned j = 0; j < 16; ++j) { const unsigned c = xb_ld(&bar[XB_XCNT(j)]); sum += c; cnt += (c > 0u) ? 1u : 0u; mine = (j == x) ? c : mine; }
        if (sum == G) break;
        __builtin_amdgcn_s_sleep(1);
        if ((++sp & 255u) == 0u) { if (xb_ld(&bar[XB_TMO])) break; if (sp > XB_SPIN_CAP) { atomicAdd(&bar[XB_TMO], 1u); break; } }
    }
    nloc = mine > 0u ? mine : 1u; nx = cnt > 0u ? cnt : 1u;
}
__device__ __forceinline__ void xcd_barrier(const XcdBarrier& b) {
    asm volatile("s_waitcnt vmcnt(0)" ::: "memory");
    __syncthreads();
    if (b.wave == 0 && lane_id() == 0) {
        unsigned* bar = b.bar;
        __builtin_amdgcn_s_waitcnt(0);
#if EARLY_WB
        asm volatile("buffer_wbl2 sc1" ::: "memory");
#endif
        unsigned nloc = b.st[0], nx = b.st[1];
        if (nloc == 0u) { xcd_barrier_complete(bar, b.x, nloc, nx); b.st[0] = nloc; b.st[1] = nx; }
        const unsigned old = xb_add(&bar[XB_XSUB(b.x)], 1u);
        const unsigned gen = old / nloc;
        if (old + 1u == (gen + 1u) * nloc) {
            __builtin_amdgcn_fence(__ATOMIC_RELEASE, "agent");
            asm volatile("s_waitcnt vmcnt(0)" ::: "memory");
            const unsigned og = xb_add(&bar[XB_TOP], 1u);
            const unsigned tg = og / nx;
            if (og + 1u == (tg + 1u) * nx) xb_add(&bar[XB_TOPGEN], 1u);
            else XB_SPIN(xb_ld(&bar[XB_TOPGEN]) == tg, bar);
            __builtin_amdgcn_fence(__ATOMIC_ACQUIRE, "agent");
            xb_add(&bar[XB_XGEN(b.x)], 1u);
            asm volatile("s_waitcnt vmcnt(0)" ::: "memory");
        } else {
            XB_SPIN(xb_ld(&bar[XB_XGEN(b.x)]) == gen, bar);
            __builtin_amdgcn_fence(__ATOMIC_ACQUIRE, "agent");
            asm volatile("s_waitcnt vmcnt(0)" ::: "memory");
#if PROBE_INV
            asm volatile("buffer_inv sc1\n\ts_waitcnt vmcnt(0)" ::: "memory");
#endif
        }
    }
    __syncthreads();
}

struct Frame {
    LAS unsigned char* lds;
    volatile LAS unsigned* MISC;
    unsigned* ctl;
    int wave, vcu, G;
    unsigned char* out; unsigned char* ws;
};
struct Args { const float* in[19]; unsigned char* out; unsigned char* ws; int ph_lo, ph_hi; };
__device__ __forceinline__ float wave_sum(float v) {
#pragma unroll
    for (int o = 1; o < 64; o <<= 1) v += __shfl_xor(v, o);
    return v;
}
__device__ __forceinline__ void tr_item(const float* W, int ldw, int K, int k0, int srcc, bf16_t* WT, int drow, const float* gain, LAS float* scr, int lane) {
    float wv[32];
#pragma unroll
    for (int i = 0; i < 32; ++i) { const int kk = 2 * i + (lane >> 5); wv[i] = W[(size_t)(k0 + kk) * ldw + srcc + (lane & 31)]; }
#pragma unroll
    for (int i = 0; i < 32; ++i) { const int kk = 2 * i + (lane >> 5); float w = wv[i]; if (gain) w *= gain[k0 + kk]; scr[kk * 33 + (lane & 31)] = w; }
    LDS_WAIT(); asm volatile("" ::: "memory");
    const int c = lane & 7;
#pragma unroll
    for (int j = 0; j < 4; ++j) { const int n = (lane >> 3) + 8 * j; const LAS float* s = scr + (8 * c) * 33 + n;
        u32x4 o; o.x = cvt_pk_bf16(s[0 * 33], s[1 * 33]); o.y = cvt_pk_bf16(s[2 * 33], s[3 * 33]); o.z = cvt_pk_bf16(s[4 * 33], s[5 * 33]); o.w = cvt_pk_bf16(s[6 * 33], s[7 * 33]);
        *(u32x4*)(WT + (size_t)(drow + n) * K + k0 + 8 * c) = o; }
    LDS_WAIT(); asm volatile("" ::: "memory");
}
__device__ __forceinline__ void cvt_rows(Frame& F, const float* src, bf16_t* dst, size_t n8) {
    const size_t nthr = (size_t)F.G * 512;
    for (size_t i = (size_t)F.vcu * 512 + F.wave * 64 + lane_id(); i < n8; i += 8 * nthr) { f32x4 a[8], b[8];
#pragma unroll
        for (int j = 0; j < 8; ++j) if (i + j * nthr < n8) { a[j] = *(const f32x4*)(src + (i + j * nthr) * 8); b[j] = *(const f32x4*)(src + (i + j * nthr) * 8 + 4); }
#pragma unroll
        for (int j = 0; j < 8; ++j) if (i + j * nthr < n8) { if (P0_NT) __builtin_nontemporal_store(epi::pack8(a[j], b[j]), (u32x4*)(dst + (i + j * nthr) * 8)); else *(u32x4*)(dst + (i + j * nthr) * 8) = epi::pack8(a[j], b[j]); } }
}
__device__ __forceinline__ void p0_prologue(Frame& F, const Args& A, bool first = true) {
    LAS float* scr = (LAS float*)(F.lds + F.wave * 16384);
    const int gw = F.vcu * NWAVES + F.wave, NGW = F.G * NWAVES, lane = lane_id();
    unsigned char* ws = F.ws;
    constexpr int I0 = 16 * 112, I1 = 512, I2 = 512, I3 = 512, I4 = 128, I5 = 128, I6 = 16 * 192, I7 = 32 * 32, I8 = 32 * 8, I9 = 32 * 8, I10 = 8, I11 = 8, I12 = 16 * 2;
    constexpr int NITEMS = I0 + I1 + I2 + I3 + I4 + I5 + I6 + I7 + I8 + I9 + I10 + I11 + I12;
    for (int it = gw; it < NITEMS; it += NGW) {
        int r = it;
        if (r < I0) { const int kb = r / 112, gi = r % 112, pn = gi >> 3, gg = gi & 7, bj = gg >> 2, wc = gg & 3; int srcc;
            if (pn < 4) srcc = pn * 256 + wc * 64 + bj * 32; else if (pn < 10) srcc = 1024 + (pn - 4) * 256 + wc * 64 + bj * 32; else srcc = 2608 + (pn - 10) * 256 + wc * 64 + bj * 32;
            tr_item(A.in[3], 3632, 1024, 64 * kb, srcc, (bf16_t*)(ws + WS_WNIN), 32 * gi, A.in[2], scr, lane); continue; } r -= I0;
        if (r < I1) { tr_item(A.in[14], 1024, 1024, 64 * (r / 32), 32 * (r % 32), (bf16_t*)(ws + WS_WNOUT), 32 * (r % 32), nullptr, scr, lane); continue; } r -= I1;
        if (r < I2) { tr_item(A.in[18], 1024, 1024, 64 * (r / 32), 32 * (r % 32), (bf16_t*)(ws + WS_WG0), 32 * (r % 32), nullptr, scr, lane); continue; } r -= I2;
        if (r < I3) { tr_item(A.in[18] + (size_t)1024 * 1024, 1024, 1024, 64 * (r / 32), 32 * (r % 32), (bf16_t*)(ws + WS_WG1), 32 * (r % 32), nullptr, scr, lane); continue; } r -= I3;
        if (r < I4) { tr_item(A.in[17], 1024, 256, 64 * (r / 32), 32 * (r % 32), (bf16_t*)(ws + WS_WP0), 32 * (r % 32), nullptr, scr, lane); continue; } r -= I4;
        if (r < I5) { tr_item(A.in[17] + (size_t)256 * 1024, 1024, 256, 64 * (r / 32), 32 * (r % 32), (bf16_t*)(ws + WS_WP1), 32 * (r % 32), nullptr, scr, lane); continue; } r -= I5;
        if (r < I6) { tr_item(A.in[15], 6144, 1024, 64 * (r / 192), 32 * (r % 192), (bf16_t*)(ws + WS_WRIN), 32 * (r % 192), A.in[2] + 1024, scr, lane); continue; } r -= I6;
        if (r < I7) { tr_item(A.in[16], 1024, 2048, 64 * (r / 32), 32 * (r % 32), (bf16_t*)(ws + WS_WROUT), 32 * (r % 32), nullptr, scr, lane); continue; } r -= I7;
        if (r < I8) { tr_item(A.in[10], 256, 2048, 64 * (r / 8), 32 * (r % 8), (bf16_t*)(ws + WS_WC1K), 32 * (r % 8), nullptr, scr, lane); continue; } r -= I8;
        if (r < I9) { tr_item(A.in[12], 256, 2048, 64 * (r / 8), 32 * (r % 8), (bf16_t*)(ws + WS_WC1V), 32 * (r % 8), nullptr, scr, lane); continue; } r -= I9;
        if (r < I10) { tr_item(A.in[11], 64, 256, 64 * (r / 2), 32 * (r % 2), (bf16_t*)(ws + WS_WC2K), 32 * (r % 2), nullptr, scr, lane); continue; } r -= I10;
        if (r < I11) { tr_item(A.in[13], 64, 256, 64 * (r / 2), 32 * (r % 2), (bf16_t*)(ws + WS_WC2V), 32 * (r % 2), nullptr, scr, lane); continue; } r -= I11;
        tr_item(A.in[3], 3632, 1024, 64 * (r / 2), 2560 + 32 * (r % 2), (bf16_t*)(ws + WS_WGT), 32 * (r % 2), A.in[2], scr, lane);
    }
    { const float* x = A.in[0]; bf16_t* xb = (bf16_t*)(ws + WS_XB); float* rs = (float*)(ws + WS_ROWSC0);
      for (int m = gw; m < T_TOK; m += 4 * NGW) { f32x4 v[4][4]; float s[4];
#pragma unroll
          for (int q = 0; q < 4; ++q) { const int mq = (m + q * NGW < T_TOK) ? m + q * NGW : m; const f32x4* xr = (const f32x4*)(x + (size_t)mq * DM) + lane;
#pragma unroll
              for (int j = 0; j < 4; ++j) v[q][j] = xr[64 * j]; }
#pragma unroll
          for (int q = 0; q < 4; ++q) { float a = 0.f;
#pragma unroll
              for (int j = 0; j < 4; ++j) a += epi::dot4(v[q][j]);
              s[q] = wave_sum(a); }
#pragma unroll
          for (int q = 0; q < 4; ++q) if (m + q * NGW < T_TOK) { const int mq = m + q * NGW; u32x2* o8 = (u32x2*)(xb + (size_t)mq * DM) + lane;
#pragma unroll
              for (int j = 0; j < 4; ++j) { u32x2 w; w.x = cvt_pk_bf16(v[q][j][0], v[q][j][1]); w.y = cvt_pk_bf16(v[q][j][2], v[q][j][3]); if (P0_NT) __builtin_nontemporal_store(w, o8 + 64 * j); else o8[64 * j] = w; }
              if (lane == 0) rs[mq] = __builtin_amdgcn_rsqf(s[q] * (1.0f / DM) + RMS_EPS); } } }
    cvt_rows(F, A.in[1], (bf16_t*)(ws + WS_PB0), (size_t)T_TOK * 256 / 8);
    cvt_rows(F, A.in[1] + (size_t)T_TOK * 256, (bf16_t*)(ws + WS_PB1), (size_t)T_TOK * 256 / 8);
    { float* ct = (float*)(ws + WS_COS); float* st = (float*)(ws + WS_SIN); float* ctt = (float*)(ws + WS_COST); float* stt = (float*)(ws + WS_SINT);
      for (int i = F.vcu * 512 + F.wave * 64 + lane_id(); i < 2 * SEQ * 128; i += F.G * 512) { const bool tr = i >= SEQ * 128; const int ii = tr ? i - SEQ * 128 : i; const int pos = tr ? (ii & (SEQ - 1)) : (ii >> 7), j = tr ? (ii >> 12) : (ii & 127);
          const float inv = (float)exp2(-((double)j / 127.0) * 13.287712379549449);
          const float ang = (float)pos * inv;
          double t = (double)ang * 0.15915494309189535; t -= floor(t);
          const float cv = __builtin_amdgcn_cosf((float)t), sv = __builtin_amdgcn_sinf((float)t);
          if (tr) { ctt[ii] = cv; stt[ii] = sv; } else { ct[ii] = cv; st[ii] = sv; } } }
    if (first) for (int task = gw; task < 512; task += NGW) { const int kv = task >> 8, cb = (task >> 6) & 3, kc = task & 63, col = cb * 64 + lane; const float* pos = kv ? A.in[9] : A.in[8]; const float* w1 = kv ? A.in[12] : A.in[10]; float a = 0.f;
#pragma unroll 8
        for (int k = kc * 32; k < kc * 32 + 32; ++k) a += pos[k] * w1[(size_t)k * 256 + col];
        atomicAdd((float*)(ws + WS_CBIAS) + kv * 256 + col, a); }
    if (gw == NGW - 1) { float* gd = (float*)(ws + WS_GAINS); gd[lane] = A.in[4][lane]; gd[64 + lane] = A.in[5][lane]; gd[128 + lane] = A.in[6][lane]; gd[192 + lane] = A.in[7][lane]; }
}
__device__ __forceinline__ void cmp2_task(Frame& F, int task) {
    const float* kcg = (const float*)(F.ws + WS_GAINS) + 64;
    const int lane = lane_id(), r32 = lane & 31, hi = lane >> 5;
    unsigned char* ws = F.ws;
    {
        const int kv = task >> 8, rb = task & 255;
        const bf16_t* H = (const bf16_t*)(ws + WS_HID) + ((size_t)kv * 8192 + rb * 32) * 256;
        const bf16_t* W2 = (const bf16_t*)(ws + (kv ? WS_WC2V : WS_WC2K));
        f32x16 o0 = {}, o1 = {};
#pragma unroll 4
        for (int ks = 0; ks < 16; ++ks) {
            const bf16x8 hb = *(const bf16x8*)(H + (size_t)r32 * 256 + ks * 16 + hi * 8);
            const bf16x8 w0 = *(const bf16x8*)(W2 + (size_t)r32 * 256 + ks * 16 + hi * 8), w1 = *(const bf16x8*)(W2 + (size_t)(32 + r32) * 256 + ks * 16 + hi * 8);
            o0 = __builtin_amdgcn_mfma_f32_32x32x16_bf16(w0, hb, o0, 0, 0, 0); o1 = __builtin_amdgcn_mfma_f32_32x32x16_bf16(w1, hb, o1, 0, 0, 0);
        }
        if (kv == 0) { float ss = 0.f;
#pragma unroll
            for (int r = 0; r < 16; ++r) ss += o0[r] * o0[r] + o1[r] * o1[r];
            ss += __shfl_xor(ss, 32);
            const float rn = __builtin_amdgcn_rsqf(ss * (1.0f / 64.0f) + RMS_EPS); const float* gp = kcg;
#pragma unroll
            for (int r = 0; r < 16; ++r) { const int c = (r & 3) + 8 * (r >> 2) + 4 * hi; o0[r] *= rn * gp[c]; o1[r] *= rn * gp[32 + c]; } }
        const int rowg = rb * 32 + r32;
        if ((rowg & 255) == 255) { o0 = f32x16{}; o1 = f32x16{}; }
        bf16_t* dst = (bf16_t*)(ws + (kv ? WS_VCC : WS_KCC)) + (size_t)rowg * 64;
#pragma unroll
        for (int a = 0; a < 4; ++a) { u32x2 w; w.x = cvt_pk_bf16(o0[4 * a], o0[4 * a + 1]); w.y = cvt_pk_bf16(o0[4 * a + 2], o0[4 * a + 3]); *(u32x2*)(dst + 8 * a + 4 * hi) = w;
            w.x = cvt_pk_bf16(o1[4 * a], o1[4 * a + 1]); w.y = cvt_pk_bf16(o1[4 * a + 2], o1[4 * a + 3]); *(u32x2*)(dst + 32 + 8 * a + 4 * hi) = w; }
    }
}
__device__ __forceinline__ void gates_stage_w(Frame& F) {
    const int lane = lane_id(), r32 = lane & 31, hi = lane >> 5;
    const bf16_t* W = (const bf16_t*)(F.ws + WS_WGT) + (size_t)r32 * 1024 + hi * 32;
    for (int slot = F.wave; slot < 128; slot += NWAVES) { const int j = slot >> 3, half = (slot >> 2) & 1, s_ = slot & 3;
        __builtin_amdgcn_global_load_lds((const unsigned*)(W + (size_t)half * 32 * 1024 + j * 64 + s_ * 8), (LAS unsigned*)(F.lds + slot * 1024), 16, 0, 0); }
    VM_WAIT(); __syncthreads();
}
template <bool WLDS>
__device__ __forceinline__ void gates_task(Frame& F, int task) {
    const int lane = lane_id(), r32 = lane & 31, hi = lane >> 5;
    unsigned char* ws = F.ws;
    const bf16_t* X = (const bf16_t*)(ws + WS_XB) + ((size_t)task * 32 + r32) * 1024 + hi * 32;
    const bf16_t* W = (const bf16_t*)(ws + WS_WGT) + (size_t)r32 * 1024 + hi * 32;
    const LAS unsigned char* wl = F.lds + lane * 16;
    f32x16 o0 = {}, o1 = {};
#pragma unroll 2
    for (int j = 0; j < 16; ++j) { bf16x8 xf[4], w0[4], w1[4];
#pragma unroll
        for (int s_ = 0; s_ < 4; ++s_) { xf[s_] = *(const bf16x8*)(X + j * 64 + s_ * 8);
            if (WLDS) { w0[s_] = *(const LAS bf16x8*)(wl + ((j * 2 + 0) * 4 + s_) * 1024); w1[s_] = *(const LAS bf16x8*)(wl + ((j * 2 + 1) * 4 + s_) * 1024); }
            else { w0[s_] = *(const bf16x8*)(W + j * 64 + s_ * 8); w1[s_] = *(const bf16x8*)(W + (size_t)32 * 1024 + j * 64 + s_ * 8); } }
#pragma unroll
        for (int s_ = 0; s_ < 4; ++s_) { o0 = __builtin_amdgcn_mfma_f32_32x32x16_bf16(w0[s_], xf[s_], o0, 0, 0, 0); o1 = __builtin_amdgcn_mfma_f32_32x32x16_bf16(w1[s_], xf[s_], o1, 0, 0, 0); } }
    const int row = task * 32 + r32; const float s = ((const float*)(ws + WS_ROWSC0))[row];
    float* gp = (float*)(ws + WS_G) + (size_t)row * 48;
#pragma unroll
    for (int a = 0; a < 4; ++a) { f32x4 v;
#pragma unroll
        for (int x = 0; x < 4; ++x) v[x] = sigmoidf_(o0[4 * a + x] * s);
        *(f32x4*)(gp + 8 * a + 4 * hi) = v;
        if (a < 2) {
#pragma unroll
            for (int x = 0; x < 4; ++x) v[x] = sigmoidf_(o1[4 * a + x] * s);
            *(f32x4*)(gp + 32 + 8 * a + 4 * hi) = v; } }
}

namespace nsa {
constexpr int L_KV = 0, L_K = 0, L_V = 24576, L_WSF = 49152, L_ACC = 51200, L_GS = 116736, L_LS = 133120, L_MSK = 149504, L_END = 150016;
constexpr int NSLOT = 3, SLOTB = 8192;
#define NSA_NEG (-INFINITY)
#ifndef FB_OFF_REGS
#define FB_OFF_REGS 0
#endif
#ifndef ODD_NT
#define ODD_NT 1
#endif
#ifndef XUNIT_PREFETCH
#define XUNIT_PREFETCH 0
#endif
#ifndef TOPK_ASM_COUNT
#define TOPK_ASM_COUNT 0
#endif
#ifndef SEL_PREFETCH
#define SEL_PREFETCH 1
#endif
#ifndef WIN_PREFETCH
#define WIN_PREFETCH 0
#endif
__device__ __forceinline__ int crow(int r, int hi) { return (r & 3) + 8 * (r >> 2) + 4 * hi; }
__device__ __forceinline__ void qkt(f32x16& p0, f32x16& p1, const LAS unsigned char* Kslot, const bf16x8* qr, int r32, int hi) {
    const LAS unsigned char* kb = Kslot + hi * 1024 + r32 * 16;
    const f32x16 z = {};
#pragma unroll
    for (int d0 = 0; d0 < 4; ++d0) {
        const bf16x8 b0 = *(const LAS bf16x8*)(kb + d0 * 2048), b1 = *(const LAS bf16x8*)(kb + d0 * 2048 + 512);
        if (d0 == 0) { p0 = __builtin_amdgcn_mfma_f32_32x32x16_bf16(b0, qr[0], z, 0, 0, 0); p1 = __builtin_amdgcn_mfma_f32_32x32x16_bf16(b1, qr[0], z, 0, 0, 0); }
        else { p0 = __builtin_amdgcn_mfma_f32_32x32x16_bf16(b0, qr[d0], p0, 0, 0, 0); p1 = __builtin_amdgcn_mfma_f32_32x32x16_bf16(b1, qr[d0], p1, 0, 0, 0); }
    }
}
__device__ __forceinline__ void pv(f32x16* o, int vb, bf16x8 pa0, bf16x8 pa1, bf16x8 pa2, bf16x8 pa3) {
#pragma unroll
    for (int d0 = 0; d0 < 2; ++d0) { s16x4 lo[4], hi[4];
#pragma unroll
        for (int ks = 0; ks < 4; ++ks) {
            asm volatile("ds_read_b64_tr_b16 %0,%1 offset:%c2" : "=&v"(lo[ks]) : "v"(vb), "i"(d0 * 4096 + ks * 1024) : "memory");
            asm volatile("ds_read_b64_tr_b16 %0,%1 offset:%c2" : "=&v"(hi[ks]) : "v"(vb), "i"(d0 * 4096 + ks * 1024 + 512) : "memory"); }
        asm volatile("s_waitcnt lgkmcnt(0)" ::: "memory"); __builtin_amdgcn_sched_barrier(0);
#define NSA_PK(k) (bf16x8){lo[k][0], lo[k][1], lo[k][2], lo[k][3], hi[k][0], hi[k][1], hi[k][2], hi[k][3]}
        o[d0] = __builtin_amdgcn_mfma_f32_32x32x16_bf16(pa0, NSA_PK(0), o[d0], 0, 0, 0);
        o[d0] = __builtin_amdgcn_mfma_f32_32x32x16_bf16(pa1, NSA_PK(1), o[d0], 0, 0, 0);
        o[d0] = __builtin_amdgcn_mfma_f32_32x32x16_bf16(pa2, NSA_PK(2), o[d0], 0, 0, 0);
        o[d0] = __builtin_amdgcn_mfma_f32_32x32x16_bf16(pa3, NSA_PK(3), o[d0], 0, 0, 0);
#undef NSA_PK
    }
}
__device__ __forceinline__ float rowmax(const f32x16& p0, const f32x16& p1) {
    float a = fmaxf(fmaxf(p0[0], p0[1]), p1[0]), b = fmaxf(fmaxf(p0[2], p0[3]), p1[1]); a = fmaxf(fmaxf(a, p1[2]), p1[3]);
#pragma unroll
    for (int r = 4; r < 16; r += 4) { a = fmaxf(fmaxf(a, p0[r]), p0[r + 1]); b = fmaxf(fmaxf(b, p0[r + 2]), p0[r + 3]); a = fmaxf(fmaxf(a, p1[r]), p1[r + 1]); b = fmaxf(fmaxf(b, p1[r + 2]), p1[r + 3]); }
    const float m = fmaxf(a, b);
    auto rr = __builtin_amdgcn_permlane32_swap(__float_as_uint(m), __float_as_uint(m), false, false);
    return fmaxf(__uint_as_float(rr[0]), __uint_as_float(rr[1]));
}
__device__ __forceinline__ float halfsum(float v) {
    auto rr = __builtin_amdgcn_permlane32_swap(__float_as_uint(v), __float_as_uint(v), false, false);
    return __uint_as_float(rr[0]) + __uint_as_float(rr[1]);
}
__device__ __forceinline__ void row_scale(f32x16 (&o)[2], float f, LAS float* wsf, int r32, int hi) {
    if (hi == 0) wsf[r32] = f;
#pragma unroll
    for (int a = 0; a < 4; ++a) { const f32x4 f4 = *(const LAS f32x4*)(wsf + 8 * a + 4 * hi);
#pragma unroll
        for (int x = 0; x < 4; ++x) { o[0][4 * a + x] *= f4[x]; o[1][4 * a + x] *= f4[x]; } }
}
__device__ __forceinline__ void row_fma(f32x16 (&acc)[2], const f32x16 (&o)[2], float f, LAS float* wsf, int r32, int hi) {
    if (hi == 0) wsf[r32] = f;
#pragma unroll
    for (int a = 0; a < 4; ++a) { const f32x4 f4 = *(const LAS f32x4*)(wsf + 8 * a + 4 * hi);
#pragma unroll
        for (int x = 0; x < 4; ++x) { acc[0][4 * a + x] += o[0][4 * a + x] * f4[x]; acc[1][4 * a + x] += o[1][4 * a + x] * f4[x]; } }
}
__device__ __forceinline__ void softmax_step(f32x16& p0, f32x16& p1, float& m, float& l, f32x16 (&o)[2], LAS float* wsf, int r32, int hi) {
    const float rm = rowmax(p0, p1);
    if (__any(rm > m)) {
        const float mn = fmaxf(m, rm), mu = (mn == NSA_NEG) ? 0.f : mn;
        const float alpha = __builtin_amdgcn_exp2f(m - mu);
        l *= alpha; m = mn;
        row_scale(o, alpha, wsf, r32, hi);
    }
    const float mu = (m == NSA_NEG) ? 0.f : m; float s = 0.f;
#pragma unroll
    for (int r = 0; r < 16; ++r) { p0[r] = __builtin_amdgcn_exp2f(p0[r] - mu); p1[r] = __builtin_amdgcn_exp2f(p1[r] - mu); s += p0[r] + p1[r]; }
    l += s;
}

__device__ __forceinline__ void glds16(const void* sbase, unsigned voff, unsigned lds_dst) { unsigned keep;
    asm volatile("s_mov_b32 %0, m0\n\ts_mov_b32 m0, %3\n\ts_nop 0\n\tglobal_load_lds_dwordx4 %1, %2\n\ts_mov_b32 m0, %0" : "=&s"(keep) : "v"(voff), "s"(sbase), "s"(lds_dst) : "memory"); }
__device__ __forceinline__ float max3f(float a, float b, float c) { float r; asm("v_max3_f32 %0, %1, %2, %3" : "=v"(r) : "v"(a), "v"(b), "v"(c)); return r; }
__device__ __forceinline__ float max2f(float a, float b) { float r; asm("v_max_f32_e32 %0, %1, %2" : "=v"(r) : "v"(a), "v"(b)); return r; }
__device__ __forceinline__ float fadd_s(float a, float b) { float r; asm("v_add_f32_e32 %0, %1, %2" : "=v"(r) : "v"(a), "v"(b)); return r; }
__device__ __forceinline__ float fsub_s(float a, float b) { float r; asm("v_sub_f32_e32 %0, %1, %2" : "=v"(r) : "v"(a), "v"(b)); return r; }
typedef LAS const char* lds_cptr;
typedef short v4i16_t __attribute__((ext_vector_type(4)));
__device__ __forceinline__ void kload8(bf16x8* kf, lds_cptr kp) {
    kf[0] = *(const LAS bf16x8*)(kp);        kf[1] = *(const LAS bf16x8*)(kp + 512);
    kf[2] = *(const LAS bf16x8*)(kp + 2048); kf[3] = *(const LAS bf16x8*)(kp + 2560);
    kf[4] = *(const LAS bf16x8*)(kp + 4096); kf[5] = *(const LAS bf16x8*)(kp + 4608);
    kf[6] = *(const LAS bf16x8*)(kp + 6144); kf[7] = *(const LAS bf16x8*)(kp + 6656); }
__device__ __forceinline__ void kload2(bf16x8* kf, lds_cptr kp, int j) { kf[2 * j] = *(const LAS bf16x8*)(kp + j * 2048); kf[2 * j + 1] = *(const LAS bf16x8*)(kp + j * 2048 + 512); }
__device__ __forceinline__ s16x4 vtr(lds_cptr p) { return __builtin_bit_cast(s16x4, __builtin_amdgcn_ds_read_tr16_b64_v4i16((LAS v4i16_t*)p)); }
__device__ __forceinline__ float rowmax_a(const f32x16& p0, const f32x16& p1) {
    float a = max3f(p0[0], p0[1], p1[0]), b = max3f(p0[2], p0[3], p1[1]); a = max3f(a, p1[2], p1[3]);
#pragma unroll
    for (int r = 4; r < 16; r += 4) { a = max3f(a, p0[r], p0[r + 1]); b = max3f(b, p0[r + 2], p0[r + 3]); a = max3f(a, p1[r], p1[r + 1]); b = max3f(b, p1[r + 2], p1[r + 3]); }
    const float m = max2f(a, b);
    auto rr = __builtin_amdgcn_permlane32_swap(__float_as_uint(m), __float_as_uint(m), false, false);
    return max2f(__uint_as_float(rr[0]), __uint_as_float(rr[1]));
}
#define FB_SBAR() __builtin_amdgcn_sched_barrier(0)
#ifndef FB_SETPRIO
#define FB_SETPRIO 0
#endif
#if FB_SETPRIO
#define FB_PRIO(x) __builtin_amdgcn_s_setprio(x)
#else
#define FB_PRIO(x) do { } while (0)
#endif
#define FB_WAIT_BAR(N) asm volatile("s_waitcnt vmcnt(" #N ") lgkmcnt(0)\n\ts_barrier" ::: "memory")
template <int MODE> __device__ __forceinline__ void mask_tile(f32x16& p0, f32x16& p1, int t, int qb, int nreal, int tl_base, const LAS unsigned long long* mskp) {
    const float NEG = -INFINITY;
    if (t >= nreal) {
#pragma unroll
        for (int r = 0; r < 16; ++r) { p0[r] = NEG; p1[r] = NEG; }
        return; }
    if ((MODE == 0) ? (t == qb) : (t == 0)) { const int l_ = lane_id(); const int lim = tl_base + ((l_ & 31) >> 2) - 4 * (l_ >> 5);
#pragma unroll
        for (int r = 0; r < 16; ++r) { const int cr = (r & 3) + 8 * (r >> 2); if (cr > lim) p0[r] = NEG; if (cr + 32 > lim) p1[r] = NEG; } }
    if (MODE == 1 && t == 8) { const int l_ = lane_id(); const int lim = tl_base + ((l_ & 31) >> 2) - 4 * (l_ >> 5);
#pragma unroll
        for (int r = 0; r < 16; ++r) { const int cr = (r & 3) + 8 * (r >> 2); if (cr <= lim) p0[r] = NEG; if (cr + 32 <= lim) p1[r] = NEG; } }
    if (MODE == 0) { const bool dead = !((*mskp >> t) & 1ull);
        if (__any(dead)) {
#pragma unroll
            for (int r = 0; r < 16; ++r) { p0[r] = dead ? NEG : p0[r]; p1[r] = dead ? NEG : p1[r]; } } }
}
template <int MODE> __device__ __forceinline__ void mask_pos(f32x16& p0, f32x16& p1, int t, int qb, int tl_base) {
    const float NEG = -INFINITY;
    if ((MODE == 0) ? (t == qb) : (t == 0)) { const int l_ = lane_id(); const int lim = tl_base + ((l_ & 31) >> 2) - 4 * (l_ >> 5);
#pragma unroll
        for (int r = 0; r < 16; ++r) { const int cr = (r & 3) + 8 * (r >> 2); if (cr > lim) p0[r] = NEG; if (cr + 32 > lim) p1[r] = NEG; } }
    if (MODE == 1 && t == 8) { const int l_ = lane_id(); const int lim = tl_base + ((l_ & 31) >> 2) - 4 * (l_ >> 5);
#pragma unroll
        for (int r = 0; r < 16; ++r) { const int cr = (r & 3) + 8 * (r >> 2); if (cr <= lim) p0[r] = NEG; if (cr + 32 <= lim) p1[r] = NEG; } }
}
template <int MODE> __device__ __forceinline__ void flash_prefetch(LAS unsigned char* lds, const bf16_t* Kg, const bf16_t* Vg, int qb, int wid) {
    constexpr long PITCH = 256;
    const int nreal = (MODE == 0) ? qb + 1 : (qb >= 8 ? 9 : qb + 1);
    const unsigned lds0 = (unsigned)(uintptr_t)lds; const unsigned kdst = lds0 + L_K + wid * 1024, vdst = lds0 + L_V + wid * 1024;
#define PF_TILE(t) ((MODE == 0) ? (((t) < nreal) ? (t) : nreal - 1) : (qb - (((t) < nreal) ? (t) : nreal - 1)))
    const int l_ = lane_id();
    const unsigned koff = (unsigned)(l_ * (int)PITCH + wid * 8) * 2u, voff = (unsigned)((16 * (wid & 3) + (l_ >> 2)) * (int)PITCH + (wid >> 2) * 32 + (l_ & 3) * 8) * 2u;
    glds16(uni_ptr((const char*)(Kg + (long)PF_TILE(0) * 64 * PITCH)), koff, (unsigned)__builtin_amdgcn_readfirstlane(kdst));
    glds16(uni_ptr((const char*)(Vg + (long)PF_TILE(0) * 64 * PITCH)), voff, (unsigned)__builtin_amdgcn_readfirstlane(vdst));
    glds16(uni_ptr((const char*)(Kg + (long)PF_TILE(1) * 64 * PITCH)), koff, (unsigned)__builtin_amdgcn_readfirstlane(kdst + SLOTB));
    glds16(uni_ptr((const char*)(Kg + (long)PF_TILE(2) * 64 * PITCH)), koff, (unsigned)__builtin_amdgcn_readfirstlane(kdst + 2 * SLOTB));
#undef PF_TILE
}
template <int MODE, bool PRE = false, bool NEXTPF = false, bool PREK = false> __device__ __forceinline__ void flash_branch(LAS unsigned char* lds, const bf16_t* Kg, const bf16_t* Vg, const bf16x8 (&qr)[4], int qb, int tl, const LAS unsigned long long* mskp, const LAS float* gatep, int wid, int lane, const bf16_t* Knext = nullptr) {
    const int r32 = lane & 31, hi = lane >> 5;
    constexpr long PITCH = 256;
    const int nreal = (MODE == 0) ? qb + 1 : (qb >= 8 ? 9 : qb + 1);
    const int NT = nreal < 4 ? 4 : (ODD_NT ? nreal : ((nreal + 1) & ~1));
#define FB_TILE(t) ((MODE == 0) ? (((t) < nreal) ? (t) : nreal - 1) : (qb - (((t) < nreal) ? (t) : nreal - 1)))
    const unsigned lds0 = (unsigned)(uintptr_t)lds;
    LAS float* wsf = (LAS float*)(lds + L_WSF) + wid * 64;
#define FB_KOFF() ((unsigned)(lane_id() * (int)PITCH + wid * 8) * 2u)
#define FB_VOFF() ({ const int l_ = lane_id(); (unsigned)((16 * (wid & 3) + (l_ >> 2)) * (int)PITCH + (wid >> 2) * 32 + (l_ & 3) * 8) * 2u; })
    const unsigned kdst = lds0 + L_K + wid * 1024, vdst = lds0 + L_V + wid * 1024;
#if FB_OFF_REGS
    const unsigned koff_r = FB_KOFF(), voff_r = FB_VOFF();
#define DMA_K(t, slot) glds16(uni_ptr((const char*)(Kg + (long)FB_TILE(t) * 64 * PITCH)), koff_r, (unsigned)__builtin_amdgcn_readfirstlane(kdst + (slot)))
#define DMA_V(t, slot) glds16(uni_ptr((const char*)(Vg + (long)FB_TILE(t) * 64 * PITCH)), voff_r, (unsigned)__builtin_amdgcn_readfirstlane(vdst + (slot)))
#else
#define DMA_K(t, slot) glds16(uni_ptr((const char*)(Kg + (long)FB_TILE(t) * 64 * PITCH)), FB_KOFF(), (unsigned)__builtin_amdgcn_readfirstlane(kdst + (slot)))
#define DMA_V(t, slot) glds16(uni_ptr((const char*)(Vg + (long)FB_TILE(t) * 64 * PITCH)), FB_VOFF(), (unsigned)__builtin_amdgcn_readfirstlane(vdst + (slot)))
#endif
    bf16x8 kf[8];
    const lds_cptr shm3 = (lds_cptr)lds; const lds_cptr kp0 = shm3 + L_K + hi * 1024 + r32 * 16; const lds_cptr vp0 = shm3 + L_V + ((lane >> 4) & 1) * 32 + (lane & 3) * 8 + (4 * hi + ((lane & 15) >> 2)) * 64;
    if (PREK) { DMA_V(0, 0); } else if (!PRE) { DMA_K(0, 0); DMA_V(0, 0); DMA_K(1, SLOTB); }
    float mhat = 0.f, l_reg = 0.f; f32x16 o[2]; o[0] = f32x16{}; o[1] = f32x16{}; const f32x16 zero16 = f32x16{};
#define CMASK(P0, P1, t) mask_tile<MODE>(P0, P1, (t), qb, nreal, wid * 8, mskp)
    bool resc = false;
#define START(P0, P1) do { const float rm = rowmax_a(P0, P1); resc = false; \
    { const float dl = rm; mhat = fadd_s(mhat, dl); \
      _Pragma("unroll") for (int r = 0; r < 16; ++r) { P0[r] = fsub_s(P0[r], dl); P1[r] = fsub_s(P1[r], dl); } } \
    _Pragma("unroll") for (int r = 0; r < 16; ++r) P0[r] = __builtin_amdgcn_exp2f(P0[r]); } while (0)
#define RESC() do { if (resc) { asm volatile("s_waitcnt lgkmcnt(0)" ::: "memory"); \
      _Pragma("unroll") for (int d_ = 0; d_ < 2; ++d_) _Pragma("unroll") for (int r = 0; r < 16; ++r) o[d_][r] *= wsf[crow(r, hi)]; } } while (0)
    f32x16 pA0, pA1, pB0, pB1;
    int sl_prev = 0, sl_cur = 0, sl_next = SLOTB;
#define ROT() do { sl_prev = sl_cur; sl_cur = sl_next; sl_next = (sl_next == (NSLOT - 1) * SLOTB) ? 0 : sl_next + SLOTB; } while (0)
    if (!PRE && !PREK) { DMA_K(2, 2 * SLOTB); }
    if (PRE) { FB_WAIT_BAR(7); } else { FB_WAIT_BAR(3); }
    { const lds_cptr kb = kp0;
      const f32x16 z = zero16;
#pragma unroll
      for (int d0 = 0; d0 < 4; ++d0) { const bf16x8 b0 = *(const LAS bf16x8*)(kb + d0 * 2048), b1 = *(const LAS bf16x8*)(kb + d0 * 2048 + 512);
          if (d0 == 0) { pA0 = __builtin_amdgcn_mfma_f32_32x32x16_bf16(b0, qr[0], z, 0, 0, 0); pA1 = __builtin_amdgcn_mfma_f32_32x32x16_bf16(b1, qr[0], z, 0, 0, 0); }
          else { pA0 = __builtin_amdgcn_mfma_f32_32x32x16_bf16(b0, qr[d0], pA0, 0, 0, 0); pA1 = __builtin_amdgcn_mfma_f32_32x32x16_bf16(b1, qr[d0], pA1, 0, 0, 0); } } }
    asm volatile("s_nop 15\n\ts_nop 7" : "+v"(pA0), "+v"(pA1)); CMASK(pA0, pA1, 0);
    START(pA0, pA1);
#pragma unroll
    for (int r = 0; r < 16; ++r) pA1[r] = __builtin_amdgcn_exp2f(pA1[r]);
    FB_WAIT_BAR(0);
    DMA_K(3, 0); DMA_V(1, SLOTB);
    ROT();
    kload8(kf, kp0 + sl_cur);
    FB_WAIT_BAR(2);
    s16x4 vlo[8], vhi[8]; u32x4 pw0, pw1, pw2, pw3;
#define PKW(P, B) cvt_pk_bf16(P[B], P[B + 1])
#define PAF(k) __builtin_bit_cast(bf16x8, pw##k)
#define VFR(i) (bf16x8){vlo[i][0], vlo[i][1], vlo[i][2], vlo[i][3], vhi[i][0], vhi[i][1], vhi[i][2], vhi[i][3]}
#define PIN(x) asm volatile("" : "+v"(x))
#define MX3(a, b, c) __builtin_fmaxf(__builtin_fmaxf((a), (b)), (c))
#define GAPA(MF, A0, A1, A2, A3, W0, W1, PW) do { FB_PRIO(1); MF; FB_PRIO(0); sacc += A0; sacc += A1; sacc += A2; sacc += A3; PIN(sacc); W0; W1; PIN(PW); FB_SBAR(); } while (0)
#define EX(v) __builtin_amdgcn_exp2f(v)
#define GAPB(MF, X, B) do { FB_PRIO(1); MF; FB_PRIO(0); X[B] = EX(X[B]); X[B + 1] = EX(X[B + 1]); X[B + 2] = EX(X[B + 2]); X[B + 3] = EX(X[B + 3]); PIN(X); FB_SBAR(); } while (0)
#define VRD(i) do { vlo[i] = vtr(vp_ + (((i) >> 2) * 4096 + ((i) & 3) * 1024)); vhi[i] = vtr(vp_ + (((i) >> 2) * 4096 + ((i) & 3) * 1024 + 512)); } while (0)
#define KRD(G, j) do { if (G) { kload2(kf, kp0 + sl_next, j); FB_SBAR(); } } while (0)
#define STEP(C0, C1, P0, P1, t, GK, GV, GL) do { FB_SBAR(); \
    const lds_cptr vp_ = vp0 + sl_prev; \
    VRD(0); FB_SBAR(); float sacc = (P0[0] + P0[1]); \
    GAPA(C0 = __builtin_amdgcn_mfma_f32_32x32x16_bf16(kf[0], qr[0], zero16, 0, 0, 0), P0[2], P0[3], P0[4], P0[5],     pw0[0] = PKW(P0, 0), pw0[1] = PKW(P0, 2), pw0); \
    VRD(4); FB_SBAR(); GAPA(C1 = __builtin_amdgcn_mfma_f32_32x32x16_bf16(kf[1], qr[0], zero16, 0, 0, 0), P0[6], P0[7], P0[8], P0[9],     pw0[2] = PKW(P0, 4), pw0[3] = PKW(P0, 6), pw0); \
    VRD(1); FB_SBAR(); GAPA(C0 = __builtin_amdgcn_mfma_f32_32x32x16_bf16(kf[2], qr[1], C0, 0, 0, 0),   P0[10], P0[11], P0[12], P0[13], pw1[0] = PKW(P0, 8), pw1[1] = PKW(P0, 10), pw1); \
    VRD(5); FB_SBAR(); GAPA(C1 = __builtin_amdgcn_mfma_f32_32x32x16_bf16(kf[3], qr[1], C1, 0, 0, 0),   P0[14], P0[15], P1[0], P1[1],   pw1[2] = PKW(P0, 12), pw1[3] = PKW(P0, 14), pw1); \
    VRD(2); FB_SBAR(); GAPA(C0 = __builtin_amdgcn_mfma_f32_32x32x16_bf16(kf[4], qr[2], C0, 0, 0, 0),   P1[2], P1[3], P1[4], P1[5],     pw2[0] = PKW(P1, 0), pw2[1] = PKW(P1, 2), pw2); \
    VRD(6); FB_SBAR(); GAPA(C1 = __builtin_amdgcn_mfma_f32_32x32x16_bf16(kf[5], qr[2], C1, 0, 0, 0),   P1[6], P1[7], P1[8], P1[9],     pw2[2] = PKW(P1, 4), pw2[3] = PKW(P1, 6), pw2); \
    VRD(3); FB_SBAR(); GAPA(C0 = __builtin_amdgcn_mfma_f32_32x32x16_bf16(kf[6], qr[3], C0, 0, 0, 0),   P1[10], P1[11], P1[12], P1[13], pw3[0] = PKW(P1, 8), pw3[1] = PKW(P1, 10), pw3); \
    VRD(7); FB_SBAR(); GAPA(C1 = __builtin_amdgcn_mfma_f32_32x32x16_bf16(kf[7], qr[3], C1, 0, 0, 0),   P1[14], P1[15], 0.f, 0.f,       pw3[2] = PKW(P1, 12), pw3[3] = PKW(P1, 14), pw3); \
    l_reg += sacc; \
    if (GK) { DMA_K((t) + 3, sl_cur); } if (GV) { DMA_V((t) + 1, sl_next); } \
    { const bool dead_ = ((t) >= nreal) || (MODE == 0 && !((*mskp >> (t)) & 1ull)); const float mh_ = dead_ ? INFINITY : mhat;       \
      _Pragma("unroll") for (int r = 0; r < 16; ++r) { C0[r] -= mh_; C1[r] -= mh_; } } \
    mask_pos<MODE>(C0, C1, (t), qb, wid * 8); \
    { float a = MX3(C0[0], C0[1], C1[0]), b = MX3(C0[2], C0[3], C1[1]); a = MX3(a, C1[2], C1[3]); \
      _Pragma("unroll") for (int r = 4; r < 16; r += 4) { a = MX3(a, C0[r], C0[r + 1]); b = MX3(b, C0[r + 2], C0[r + 3]); a = MX3(a, C1[r], C1[r + 1]); b = MX3(b, C1[r + 2], C1[r + 3]); } \
      float rm = __builtin_fmaxf(a, b); { auto rr = __builtin_amdgcn_permlane32_swap(__float_as_uint(rm), __float_as_uint(rm), false, false); rm = __builtin_fmaxf(__uint_as_float(rr[0]), __uint_as_float(rr[1])); } \
      resc = false; \
      if (__builtin_expect(__any(rm > 8.0f), 0)) { const float dl = __builtin_fmaxf(rm, 0.f); mhat += dl; \
        _Pragma("unroll") for (int r = 0; r < 16; ++r) { C0[r] -= dl; C1[r] -= dl; } \
        const float f = __builtin_amdgcn_exp2f(-dl); l_reg *= f; if (hi == 0) wsf[r32] = f; resc = true; } } \
    FB_SBAR(); \
    GAPB(o[0] = __builtin_amdgcn_mfma_f32_32x32x16_bf16(PAF(0), VFR(0), o[0], 0, 0, 0), C0, 0); \
    GAPB(o[1] = __builtin_amdgcn_mfma_f32_32x32x16_bf16(PAF(0), VFR(4), o[1], 0, 0, 0), C0, 4); \
    KRD(GL, 0); GAPB(o[0] = __builtin_amdgcn_mfma_f32_32x32x16_bf16(PAF(1), VFR(1), o[0], 0, 0, 0), C0, 8); \
    KRD(GL, 1); GAPB(o[1] = __builtin_amdgcn_mfma_f32_32x32x16_bf16(PAF(1), VFR(5), o[1], 0, 0, 0), C0, 12); \
    KRD(GL, 2); GAPB(o[0] = __builtin_amdgcn_mfma_f32_32x32x16_bf16(PAF(2), VFR(2), o[0], 0, 0, 0), C1, 0); \
    KRD(GL, 3); GAPB(o[1] = __builtin_amdgcn_mfma_f32_32x32x16_bf16(PAF(2), VFR(6), o[1], 0, 0, 0), C1, 4); \
    GAPB(o[0] = __builtin_amdgcn_mfma_f32_32x32x16_bf16(PAF(3), VFR(3), o[0], 0, 0, 0), C1, 8); \
    GAPB(o[1] = __builtin_amdgcn_mfma_f32_32x32x16_bf16(PAF(3), VFR(7), o[1], 0, 0, 0), C1, 12); \
    } while (0)
    int t = 1;
    for (; t + 5 < NT; t += 2) {
        STEP(pB0, pB1, pA0, pA1, t, true, true, true);     FB_WAIT_BAR(2); RESC(); ROT();
        STEP(pA0, pA1, pB0, pB1, t + 1, true, true, true); FB_WAIT_BAR(2); RESC(); ROT();
    }
#define ENDW(tt) do { if ((tt) + 3 < NT) { FB_WAIT_BAR(2); } else if ((tt) + 2 < NT) { FB_WAIT_BAR(1); } else { FB_WAIT_BAR(0); } } while (0)
#define PF_NEXT() do { if (NEXTPF) { \
        glds16(uni_ptr((const char*)Knext), FB_KOFF(), (unsigned)__builtin_amdgcn_readfirstlane(kdst)); \
        glds16(uni_ptr((const char*)(Knext + (long)(qb < 1 ? qb : 1) * 64 * PITCH)), FB_KOFF(), (unsigned)__builtin_amdgcn_readfirstlane(kdst + SLOTB)); \
        glds16(uni_ptr((const char*)(Knext + (long)(qb < 2 ? qb : 2) * 64 * PITCH)), FB_KOFF(), (unsigned)__builtin_amdgcn_readfirstlane(kdst + 2 * SLOTB)); } } while (0)
    for (; t + 1 < NT; t += 2) {
        STEP(pB0, pB1, pA0, pA1, t, (t + 3 < NT), (t + 1 < NT), (t + 1 < NT));         ENDW(t);     RESC(); ROT();
        const bool lastp = NEXTPF && (t + 2 == NT);
        if (lastp) PF_NEXT();
        STEP(pA0, pA1, pB0, pB1, t + 1, (t + 4 < NT), (t + 2 < NT), (t + 2 < NT));     if (lastp) { FB_WAIT_BAR(3); } else { ENDW(t + 1); } RESC(); ROT();
    }
#define DRAIN(P0, P1, SL) do { float sacc = P0[0] + P0[1]; \
      _Pragma("unroll") for (int r = 2; r < 16; ++r) sacc += P0[r]; \
      _Pragma("unroll") for (int r = 0; r < 16; ++r) sacc += P1[r]; \
      l_reg += sacc; \
      pw0 = (u32x4){PKW(P0, 0), PKW(P0, 2), PKW(P0, 4), PKW(P0, 6)}; pw1 = (u32x4){PKW(P0, 8), PKW(P0, 10), PKW(P0, 12), PKW(P0, 14)}; \
      pw2 = (u32x4){PKW(P1, 0), PKW(P1, 2), PKW(P1, 4), PKW(P1, 6)}; pw3 = (u32x4){PKW(P1, 8), PKW(P1, 10), PKW(P1, 12), PKW(P1, 14)}; \
      FB_SBAR(); pv(o, (int)(lds0 + L_V) + ((lane >> 4) & 1) * 32 + (lane & 3) * 8 + (4 * hi + ((lane & 15) >> 2)) * 64 + (SL), PAF(0), PAF(1), PAF(2), PAF(3)); } while (0)
    if (t < NT) { PF_NEXT(); STEP(pB0, pB1, pA0, pA1, NT - 1, false, false, false); RESC(); DRAIN(pB0, pB1, sl_cur); }
    else { DRAIN(pA0, pA1, sl_prev); }
#undef DRAIN
#undef PF_NEXT
    l_reg = halfsum(l_reg);
    if (hi == 0) { const float gate = *gatep; wsf[32 + r32] = (l_reg > 0.f) ? gate / l_reg : 0.f; }
    asm volatile("s_waitcnt lgkmcnt(0)" ::: "memory");
    { LAS float* acc = (LAS float*)(lds + L_ACC) + wid * 2048;
#pragma unroll
      for (int r = 0; r < 16; ++r) { const int orow = crow(r, hi); const float f = wsf[32 + orow];
#pragma unroll
          for (int d0 = 0; d0 < 2; ++d0) acc[orow * 64 + d0 * 32 + r32] += o[d0][r] * f; } }
    asm volatile("s_waitcnt lgkmcnt(0)\n\ts_barrier" ::: "memory");
#undef DMA_K
#undef DMA_V
#undef CMASK
#undef START
#undef RESC
#undef ROT
#undef PKW
#undef PAF
#undef VFR
#undef PIN
#undef MX3
#undef GAPA
#undef GAPB
#undef EX
#undef VRD
#undef KRD
#undef STEP
#undef ENDW
#undef FB_TILE
#undef FB_KOFF
#undef FB_VOFF
}
#define NSA_PACK(P, B) cvt_pk_bf16(P[B], P[B + 1])
#define NSA_PA(P, B) __builtin_bit_cast(bf16x8, (u32x4){NSA_PACK(P, B), NSA_PACK(P, B + 2), NSA_PACK(P, B + 4), NSA_PACK(P, B + 6)})

__device__ __forceinline__ void nsa_unit(Frame& F, int b, int g, int qb, bool pre, int nqb, bf16x8 (&qr)[4]) {
    const int lane = lane_id(), wid = F.wave, r32 = lane & 31, hi = lane >> 5;
    LAS unsigned char* lds = F.lds; unsigned char* ws = F.ws;
    const bf16_t* Q = (const bf16_t*)(F.out + DO_Q); const bf16_t* Z = (const bf16_t*)(F.out + DO_Z);
    const float* G = (const float*)(ws + WS_G); bf16_t* ATT = (bf16_t*)(ws + WS_ATT);
    const int tl = wid * 8 + (r32 >> 2), hh = r32 & 3, t = qb * 64 + tl;
    const size_t tokrow = (size_t)b * SEQ + t;
    LAS float* gl = (LAS float*)(lds + LDS_GATE) + wid * 96 + r32;
#define NSA_GATES_DMA(TOK) do { const float* gp_ = G + (TOK) * 48 + g * 12 + hh * 3; \
        __builtin_amdgcn_global_load_lds((const unsigned*)(gp_ + hi), (LAS unsigned*)(lds + LDS_GATE + wid * 384), 4, 0, 0); \
        if (hi == 0) __builtin_amdgcn_global_load_lds((const unsigned*)(gp_ + 2), (LAS unsigned*)(lds + LDS_GATE + wid * 384 + 256), 4, 0, 0); } while (0)
    if (!pre) {
#pragma unroll
        for (int d0 = 0; d0 < 4; ++d0) qr[d0] = *(const bf16x8*)(Q + tokrow * 1024 + g * 256 + hh * 64 + d0 * 16 + hi * 8);
        NSA_GATES_DMA(tokrow); }
    LAS float* wsf = (LAS float*)(lds + L_WSF) + wid * 64;
    LAS float* GS = (LAS float*)(lds + L_GS) + wid * 512; LAS float* LS = (LAS float*)(lds + L_LS) + wid * 512;
    LAS unsigned long long* MSK = (LAS unsigned long long*)(lds + L_MSK) + wid * 8;
    const int vbl = (int)(unsigned)(uintptr_t)(lds + L_KV + 8192) + ((lane >> 4) & 1) * 32 + (lane & 3) * 8 + (4 * hi + ((lane & 15) >> 2)) * 64;
    f32x16 oacc[2], o[2], p0, p1; oacc[0] = f32x16{}; oacc[1] = f32x16{};
#define NSA_DMA_K(st, base) __builtin_amdgcn_global_load_lds((const unsigned*)(uni_ptr(base) + koff), (LAS unsigned*)(lds + L_KV + (st) * 16384 + wid * 1024), 16, 0, 0)
#define NSA_DMA_V(st, base) __builtin_amdgcn_global_load_lds((const unsigned*)(uni_ptr(base) + voff), (LAS unsigned*)(lds + L_KV + (st) * 16384 + 8192 + wid * 1024), 16, 0, 0)
#ifndef PROBE_NSA
#define PROBE_NSA 0
#endif
    for (int prep = 0; prep < (PROBE_NSA == 1 ? 2 : 1); ++prep) { oacc[0] = f32x16{}; oacc[1] = f32x16{};
    {
        const int nvalid = (4 * qb + 3 < 255) ? 4 * qb + 3 : 255, ntc = (nvalid + 63) >> 6;
        const char* Kc = (const char*)(ws + WS_KCC) + (size_t)(b * 4 + g) * 256 * 128; const char* Vc = (const char*)(ws + WS_VCC) + (size_t)(b * 4 + g) * 256 * 128;
        const unsigned koff = (unsigned)lane * 128u + wid * 16, voff = (unsigned)(16 * (wid & 3) + (lane >> 2)) * 128u + (wid >> 2) * 64 + (lane & 3) * 16;
        for (int i = 0; i < ntc; ++i) {
            if (!pre || prep > 0) __builtin_amdgcn_global_load_lds((const unsigned*)(uni_ptr(Kc + (size_t)i * 8192) + koff), (LAS unsigned*)(lds + i * 8192 + wid * 1024), 16, 0, 0);
            __builtin_amdgcn_global_load_lds((const unsigned*)(uni_ptr(Vc + (size_t)i * 8192) + voff), (LAS unsigned*)(lds + L_ACC + i * 8192 + wid * 1024), 16, 0, 0); }
        const int nrow = (t >= 31) ? ((t - 31) >> 4) : -1;
        VM_WAIT(); __syncthreads();
        if (PROBE_NSA == 4) {
#pragma unroll
            for (int d0 = 0; d0 < 4; ++d0) { qr[d0] = *(const bf16x8*)(Q + tokrow * 1024 + g * 256 + hh * 64 + d0 * 16 + hi * 8); asm volatile("" : "+v"(qr[d0])); }
            for (int i = 0; i < ntc; ++i) {
                __builtin_amdgcn_global_load_lds((const unsigned*)(uni_ptr(Kc + (size_t)i * 8192) + koff), (LAS unsigned*)(lds + i * 8192 + wid * 1024), 16, 0, 0);
                __builtin_amdgcn_global_load_lds((const unsigned*)(uni_ptr(Vc + (size_t)i * 8192) + voff), (LAS unsigned*)(lds + L_ACC + i * 8192 + wid * 1024), 16, 0, 0); }
            VM_WAIT(); __syncthreads(); }
        f32x16 s0[4], s1[4];
        float m = NSA_NEG;
#pragma unroll
        for (int i = 0; i < 4; ++i) if (i < ntc) {
            qkt(s0[i], s1[i], lds + i * 8192, qr, r32, hi);
            const int lim = nrow - 64 * i - 4 * hi;
            if (__any(64 * i + 63 > nrow)) {
#pragma unroll
                for (int r = 0; r < 16; ++r) { const int cr = (r & 3) + 8 * (r >> 2); if (cr > lim) s0[i][r] = NSA_NEG; if (cr + 32 > lim) s1[i][r] = NSA_NEG; } }
#pragma unroll
            for (int r = 0; r < 16; r += 2) m = fmaxf(m, fmaxf(fmaxf(s0[i][r], s0[i][r + 1]), fmaxf(s1[i][r], s1[i][r + 1]))); }
        { auto rr = __builtin_amdgcn_permlane32_swap(__float_as_uint(m), __float_as_uint(m), false, false); m = fmaxf(__uint_as_float(rr[0]), __uint_as_float(rr[1])); }
        const float mu = (m == NSA_NEG) ? 0.f : m; float l = 0.f;
#pragma unroll
        for (int i = 0; i < 4; ++i) if (i < ntc) {
#pragma unroll
            for (int r = 0; r < 16; ++r) { s0[i][r] = __builtin_amdgcn_exp2f(s0[i][r] - mu); s1[i][r] = __builtin_amdgcn_exp2f(s1[i][r] - mu); l += s0[i][r] + s1[i][r]; } }
        l = halfsum(l);
        const float inv_l = l > 0.f ? 1.0f / l : 0.f;
        o[0] = f32x16{}; o[1] = f32x16{};
        const int vbc = (int)(unsigned)(uintptr_t)(lds + L_ACC) + ((lane >> 4) & 1) * 32 + (lane & 3) * 8 + (4 * hi + ((lane & 15) >> 2)) * 64;
#define QSUM(v) do { v += __int_as_float(__builtin_amdgcn_update_dpp(0, __float_as_int(v), 0xB1, 0xf, 0xf, true)); v += __int_as_float(__builtin_amdgcn_update_dpp(0, __float_as_int(v), 0x4E, 0xf, 0xf, true)); } while (0)
#pragma unroll
        for (int i = 0; i < 4; ++i) if (i < ntc) {
#if defined(PROBE_CMP) && PROBE_CMP == 1
            for (int prc = 0; prc < 2; ++prc)
#endif
#pragma unroll
            for (int a = 0; a < 4; ++a) {
                float g0 = ((s0[i][4 * a] + s0[i][4 * a + 1]) + (s0[i][4 * a + 2] + s0[i][4 * a + 3])) * inv_l, l0 = s0[i][4 * a + 3] * inv_l;
                float g1 = ((s1[i][4 * a] + s1[i][4 * a + 1]) + (s1[i][4 * a + 2] + s1[i][4 * a + 3])) * inv_l, l1 = s1[i][4 * a + 3] * inv_l;
                QSUM(g0); QSUM(l0); QSUM(g1); QSUM(l1);
                if (hh == 0) { const int j = 16 * i + 2 * a + hi, tk = r32 >> 2;
                    GS[tk * 64 + j] = g0; GS[tk * 64 + j + 8] = g1; LS[tk * 64 + j + 1] = l0; if (j + 9 < 64) LS[tk * 64 + j + 9] = l1; }
            }
            const bf16x8 pa0 = NSA_PA(s0[i], 0), pa1 = NSA_PA(s0[i], 8), pa2 = NSA_PA(s1[i], 0), pa3 = NSA_PA(s1[i], 8);
            pv(o, vbc + i * 8192, pa0, pa1, pa2, pa3);
#if defined(PROBE_CMP) && PROBE_CMP == 2
            { f32x16 o2[2]; o2[0] = o[0]; o2[1] = o[1]; pv(o2, vbc + i * 8192, pa0, pa1, pa2, pa3); asm volatile("" :: "v"(o2[0]), "v"(o2[1])); }
#endif
        }
#undef QSUM
        { const float gate_c = gl[0] * inv_l; oacc[0] = f32x16{}; oacc[1] = f32x16{}; row_fma(oacc, o, gate_c, wsf, r32, hi); }
        __syncthreads();
    }
#if WIN_PREFETCH
    flash_prefetch<1>(lds, (const bf16_t*)(ws + WS_KW) + (size_t)b * SEQ * 256 + g * 64, (const bf16_t*)(ws + WS_VW) + (size_t)b * SEQ * 256 + g * 64, qb, wid);
#endif
    LDS_WAIT();
    {
        const int tkq = lane >> 3, c8 = lane & 7;
        const LAS float* gsp = GS + tkq * 64 + c8 * 8; const LAS float* lsp = LS + tkq * 64 + c8 * 8;
        const f32x4 ga = *(const LAS f32x4*)gsp, gb = *(const LAS f32x4*)(gsp + 4), la = *(const LAS f32x4*)lsp, lb = *(const LAS f32x4*)(lsp + 4);
        unsigned key[8];
#pragma unroll
        for (int i = 0; i < 8; ++i) { const int j = c8 * 8 + i; const float gv = (i < 4) ? ga[i & 3] : gb[i & 3], lv = (i < 4) ? la[i & 3] : lb[i & 3];
            const float imp = gv + (j > 0 ? lv : 0.f);
            const bool valid = j <= qb, forced = (j == 0) || (j == qb) || (j == qb - 1);
#if defined(PROBE_SELINV)
            const float sc = forced ? 1e4f : (1e3f - imp);
#else
            const float sc = imp + (forced ? 1e4f : 0.f);
#endif
            key[i] = valid ? __float_as_uint(sc) + 1u : 0u; }
#define G8SUM(v) do { v += __builtin_amdgcn_update_dpp(0, v, 0xB1, 0xf, 0xf, true); v += __builtin_amdgcn_update_dpp(0, v, 0x4E, 0xf, 0xf, true); v += __builtin_amdgcn_update_dpp(0, v, 0x141, 0xf, 0xf, true); } while (0)
        unsigned T = 0u;
#if defined(PROBE_TOPK)
        for (int prt = 0; prt < 2; ++prt) { T = 0u;
#pragma unroll
        for (int i = 0; i < 8; ++i) asm volatile("" : "+v"(key[i]));
#endif
        if (qb >= 16) {
#pragma unroll
            for (int bit = 31; bit >= 0; --bit) { const unsigned cand = T | (1u << bit); int cnt = 0;
#if TOPK_ASM_COUNT
                { unsigned long long m0, m1, m2, m3, m4, m5, m6, m7;
                  asm("v_cmp_ge_u32_e64 %[m0], %[k0], %[c]\n\tv_cmp_ge_u32_e64 %[m1], %[k1], %[c]\n\tv_cmp_ge_u32_e64 %[m2], %[k2], %[c]\n\tv_cmp_ge_u32_e64 %[m3], %[k3], %[c]\n\t"
                      "v_cmp_ge_u32_e64 %[m4], %[k4], %[c]\n\tv_cmp_ge_u32_e64 %[m5], %[k5], %[c]\n\tv_cmp_ge_u32_e64 %[m6], %[k6], %[c]\n\tv_cmp_ge_u32_e64 %[m7], %[k7], %[c]\n\t"
                      "v_cndmask_b32_e64 %[n], 0, 1, %[m0]\n\t"
                      "v_addc_co_u32_e64 %[n], %[m1], %[n], 0, %[m1]\n\tv_addc_co_u32_e64 %[n], %[m2], %[n], 0, %[m2]\n\tv_addc_co_u32_e64 %[n], %[m3], %[n], 0, %[m3]\n\t"
                      "v_addc_co_u32_e64 %[n], %[m4], %[n], 0, %[m4]\n\tv_addc_co_u32_e64 %[n], %[m5], %[n], 0, %[m5]\n\tv_addc_co_u32_e64 %[n], %[m6], %[n], 0, %[m6]\n\tv_addc_co_u32_e64 %[n], %[m7], %[n], 0, %[m7]\n\ts_nop 1"
                      : [n] "=&v"(cnt), [m0] "=&s"(m0), [m1] "=&s"(m1), [m2] "=&s"(m2), [m3] "=&s"(m3), [m4] "=&s"(m4), [m5] "=&s"(m5), [m6] "=&s"(m6), [m7] "=&s"(m7)
                      : [k0] "v"(key[0]), [k1] "v"(key[1]), [k2] "v"(key[2]), [k3] "v"(key[3]), [k4] "v"(key[4]), [k5] "v"(key[5]), [k6] "v"(key[6]), [k7] "v"(key[7]), [c] "v"(cand)); }
#else
#pragma unroll
                for (int i = 0; i < 8; ++i) cnt += (key[i] >= cand) ? 1 : 0;
#endif
                G8SUM(cnt);
                T = (cnt >= 16) ? cand : T; } }
#if defined(PROBE_TOPK)
        }
#endif
        int gcnt = 0, ecnt = 0;
#pragma unroll
        for (int i = 0; i < 8; ++i) { gcnt += (key[i] > T) ? 1 : 0; ecnt += (key[i] == T) ? 1 : 0; }
        G8SUM(gcnt); const int need = 16 - gcnt;
        int pre = ecnt;
        { const int t1 = __builtin_amdgcn_update_dpp(0, pre, 0x111, 0xf, 0xf, true); pre += (c8 >= 1) ? t1 : 0;
          const int t2 = __builtin_amdgcn_update_dpp(0, pre, 0x112, 0xf, 0xf, true); pre += (c8 >= 2) ? t2 : 0;
          const int t4 = __builtin_amdgcn_update_dpp(0, pre, 0x114, 0xf, 0xf, true); pre += (c8 >= 4) ? t4 : 0; }
        int below = pre - ecnt; unsigned bits = 0u;
#pragma unroll
        for (int i = 0; i < 8; ++i) { const bool eq = key[i] == T; const bool sel = (key[i] != 0u) && ((key[i] > T) || (eq && below < need)); below += eq ? 1 : 0; bits |= sel ? (1u << i) : 0u; }
        ((LAS unsigned char*)MSK)[tkq * 8 + c8] = (unsigned char)bits;
#undef G8SUM
    }
    }
    LDS_WAIT();
    { const char* zsrc = (const char*)Z + ((size_t)b * SEQ + qb * 64 + wid * 8) * 2048 + g * 512 + (lane >> 5) * 2048 + (lane & 31) * 16;
      const unsigned zg = (unsigned)(uintptr_t)(lds + L_GS) + wid * 2048u, zl = (unsigned)(uintptr_t)(lds + L_LS) + wid * 2048u;
      glds16(uni_ptr((const char*)Z + ((size_t)b * SEQ + qb * 64 + wid * 8) * 2048 + g * 512), (unsigned)((lane >> 5) * 2048 + (lane & 31) * 16), (unsigned)__builtin_amdgcn_readfirstlane(zg));
      glds16(uni_ptr((const char*)Z + ((size_t)b * SEQ + qb * 64 + wid * 8 + 2) * 2048 + g * 512), (unsigned)((lane >> 5) * 2048 + (lane & 31) * 16), (unsigned)__builtin_amdgcn_readfirstlane(zg + 1024u));
      glds16(uni_ptr((const char*)Z + ((size_t)b * SEQ + qb * 64 + wid * 8 + 4) * 2048 + g * 512), (unsigned)((lane >> 5) * 2048 + (lane & 31) * 16), (unsigned)__builtin_amdgcn_readfirstlane(zl));
      glds16(uni_ptr((const char*)Z + ((size_t)b * SEQ + qb * 64 + wid * 8 + 6) * 2048 + g * 512), (unsigned)((lane >> 5) * 2048 + (lane & 31) * 16), (unsigned)__builtin_amdgcn_readfirstlane(zl + 1024u));
      (void)zsrc; }
    const LAS unsigned long long* mskp = MSK + (r32 >> 2);
    { LAS float* acc = (LAS float*)(lds + L_ACC) + wid * 2048;
#pragma unroll
      for (int r = 0; r < 16; ++r) { const int orow = crow(r, hi);
#pragma unroll
          for (int d0 = 0; d0 < 2; ++d0) acc[orow * 64 + d0 * 32 + r32] = oacc[d0][r]; } }
    { const bf16_t* Kw = (const bf16_t*)(ws + WS_KW) + (size_t)b * SEQ * 256 + g * 64; const bf16_t* Vw = (const bf16_t*)(ws + WS_VW) + (size_t)b * SEQ * 256 + g * 64;
      flash_branch<1, WIN_PREFETCH != 0, SEL_PREFETCH != 0>(lds, Kw, Vw, qr, qb, tl, mskp, gl + 64, wid, lane, (const bf16_t*)(ws + WS_KS) + (size_t)b * SEQ * 256 + g * 64);
      if (PROBE_NSA == 2) flash_branch<1>(lds, Kw, Vw, qr, qb, tl, mskp, (const LAS float*)(lds + LDSCTL_OFF), wid, lane); }
    { const bf16_t* Ks = (const bf16_t*)(ws + WS_KS) + (size_t)b * SEQ * 256 + g * 64; const bf16_t* Vs = (const bf16_t*)(ws + WS_VS) + (size_t)b * SEQ * 256 + g * 64;
      flash_branch<0, false, false, SEL_PREFETCH != 0>(lds, Ks, Vs, qr, qb, tl, mskp, gl + 32, wid, lane);
      if (PROBE_NSA == 3) flash_branch<0>(lds, Ks, Vs, qr, qb, tl, mskp, (const LAS float*)(lds + LDSCTL_OFF), wid, lane); }
    if (nqb >= 0) {
        const size_t ntok = (size_t)b * SEQ + nqb * 64 + tl;
#pragma unroll
        for (int d0 = 0; d0 < 4; ++d0) qr[d0] = *(const bf16x8*)(Q + ntok * 1024 + g * 256 + hh * 64 + d0 * 16 + hi * 8);
        NSA_GATES_DMA(ntok);
        const int nvn = (4 * nqb + 3 < 255) ? 4 * nqb + 3 : 255, ntn = (nvn + 63) >> 6;
        const char* Kc = (const char*)(ws + WS_KCC) + (size_t)(b * 4 + g) * 256 * 128; const unsigned koff = (unsigned)lane * 128u + wid * 16;
        for (int i = 0; i < ntn; ++i) __builtin_amdgcn_global_load_lds((const unsigned*)(uni_ptr(Kc + (size_t)i * 8192) + koff), (LAS unsigned*)(lds + i * 8192 + wid * 1024), 16, 0, 0);
    }
    for (int pro = 0; pro < (PROBE_NSA == 5 ? 2 : 1); ++pro)
    {
        const LAS float* acc = (const LAS float*)(lds + L_ACC) + wid * 2048;
#pragma unroll
        for (int i = 0; i < 4; ++i) { const int row = i * 8 + (lane >> 3), ch = lane & 7; const f32x4 a0 = *(const LAS f32x4*)(acc + row * 64 + ch * 8), a1 = *(const LAS f32x4*)(acc + row * 64 + ch * 8 + 4);
            const size_t off = ((size_t)b * SEQ + qb * 64 + wid * 8 + (row >> 2)) * 1024 + g * 256 + (row & 3) * 64 + ch * 8;
            const int tk_ = row >> 2; const LAS unsigned char* zp = lds + (tk_ < 4 ? L_GS : L_LS) + wid * 2048 + (tk_ & 3) * 512 + (row & 3) * 128 + ch * 16;
            const u32x4 zz = *(const LAS u32x4*)zp; f32x4 z0, z1; epi::unpack8(zz, z0, z1);
            *(u32x4*)(ATT + off) = epi::pack8(a0 * z0, a1 * z1); }
        LDS_WAIT();
    }
    __syncthreads();
#undef NSA_DMA_K
#undef NSA_GATES_DMA
#undef NSA_DMA_V
}
__device__ __forceinline__ void nsa_phase(Frame& F) {
    if (F.G == 256) {
        const int bg = F.vcu >> 3, s = F.vcu & 7;
        bf16x8 qr[4];
        for (int i = 0; i < 8; ++i) { const int k = i >> 1; const int qb = (i & 1) ? (63 - 8 * k - s) : (8 * k + s);
            const int i2 = i + 1, k2 = i2 >> 1; const int nqb = (XUNIT_PREFETCH && i2 < 8) ? ((i2 & 1) ? (63 - 8 * k2 - s) : (8 * k2 + s)) : -1;
            nsa_unit(F, bg >> 2, bg & 3, qb, XUNIT_PREFETCH && i > 0, nqb, qr); }
    } else {
        bf16x8 qr[4];
        for (int u = F.vcu; u < 2048; u += F.G) nsa_unit(F, u >> 8, (u >> 6) & 3, u & 63, false, -1, qr);
    }
}
}

namespace ret {
__device__ __forceinline__ int crow(int r, int hi) { return (r & 3) + 8 * (r >> 2) + 4 * hi; }
__device__ __forceinline__ void p_phase(Frame& F) {
    const int lane = lane_id(), wid = F.wave, r32 = lane & 31, hi = lane >> 5;
    const bf16_t* Qp = (const bf16_t*)(F.ws + WS_QP); const bf16_t* Kp = (const bf16_t*)(F.out);
    bf16_t* PT = (bf16_t*)(F.ws + WS_PT);
    const int ib = wid & 3, jb0 = (wid >> 2) * 2;
    for (int it = F.vcu; it < 1024; it += F.G) {
        const int bh = it >> 5, c = it & 31, b = bh >> 2, h = bh & 3;
        const float ginv = __builtin_amdgcn_exp2f(-128.0f * epi::log2_gamma(h));
        const bool live0 = jb0 <= ib, live1 = jb0 + 1 <= ib;
        const bf16_t* qa = Qp + epi::qt_index(b, c * 128 + ib * 32, h, 0) + lane * 8;
        const bf16_t* ka0 = Kp + epi::qt_index(b, c * 128 + jb0 * 32, h, 0) + lane * 8; const bf16_t* ka1 = ka0 + (epi::qt_index(0, 32, 0, 0) - epi::qt_index(0, 0, 0, 0));
        bf16x8 fb[16], fa0[16], fa1[16];
        if (live0) {
#pragma unroll
            for (int ks = 0; ks < 16; ++ks) { fb[ks] = *(const bf16x8*)(qa + ks * 512); fa0[ks] = *(const bf16x8*)(ka0 + ks * 512); }
            if (live1) {
#pragma unroll
                for (int ks = 0; ks < 16; ++ks) fa1[ks] = *(const bf16x8*)(ka1 + ks * 512); }
        }
        f32x16 acc0 = {}, acc1 = {};
        if (live0) {
            if (live1) {
#pragma unroll
                for (int ks = 0; ks < 16; ++ks) { acc0 = __builtin_amdgcn_mfma_f32_32x32x16_bf16(fa0[ks], fb[ks], acc0, 0, 0, 0); acc1 = __builtin_amdgcn_mfma_f32_32x32x16_bf16(fa1[ks], fb[ks], acc1, 0, 0, 0); }
            } else {
#pragma unroll
                for (int ks = 0; ks < 16; ++ks) acc0 = __builtin_amdgcn_mfma_f32_32x32x16_bf16(fa0[ks], fb[ks], acc0, 0, 0, 0);
            }
        }
#pragma unroll
        for (int jj = 0; jj < 2; ++jj) { const int jb = jb0 + jj; const bool live = jj ? live1 : live0;
#pragma unroll
            for (int a = 0; a < 4; ++a) { float v[4];
#pragma unroll
                for (int x = 0; x < 4; ++x) { const int jl = jb * 32 + 8 * a + 4 * hi + x; const float av = jj ? acc1[4 * a + x] : acc0[4 * a + x]; v[x] = (live && jl <= ib * 32 + r32) ? av * ginv : 0.f; }
                u32x2 w; w.x = cvt_pk_bf16(v[0], v[1]); w.y = cvt_pk_bf16(v[2], v[3]);
                *(u32x2*)(PT + ((((size_t)it * 4 + ib) * 8 + (2 * jb + (a >> 1))) * 2 + (a & 1)) * 256 + r32 * 8 + 4 * hi) = w; } }
    }
}
constexpr int ST_PITCH = 264;
__device__ __forceinline__ void scan_item(Frame& F, int b, int h, int s, bool do_stats) {
    const int lane = lane_id(), wid = F.wave, r32 = lane & 31, hi = lane >> 5, ib = wid & 3; const bool heavy = wid < 4;
    const bf16_t* Qp = (const bf16_t*)(F.ws + WS_QP); const bf16_t* Ktp = (const bf16_t*)(F.ws + WS_KTP); const bf16_t* Vt = (const bf16_t*)(F.ws + WS_VT); const bf16_t* PT = (const bf16_t*)(F.ws + WS_PT);
    bf16_t* O = (bf16_t*)(F.out); float* stats = (float*)(F.ws + WS_STATS);
    LAS bf16_t* St = (LAS bf16_t*)(F.lds);
    const int bh = b * 4 + h;
    const float l2g = epi::log2_gamma(h), g128 = __builtin_amdgcn_exp2f(128.0f * l2g);
    const bf16_t* vB0 = Vt + epi::tt_index(bh, 16, s * 64, 0) + lane * 8;
    const bf16_t* vB1 = Vt + epi::tt_index(bh, 16, s * 64 + 32, 0) + lane * 8;
    const bf16_t* kA = Ktp + epi::tt_index(bh, 8, wid * 32, 0) + lane * 8;
    const bf16_t* qB = Qp + epi::qt_index(b, ib * 32, h, 0) + lane * 8;
    const bf16_t* pB = PT + (((size_t)bh * 32) * 4 + ib) * 8 * 512 + lane * 8;
    constexpr int ST_BYTES = 64 * ST_PITCH * 2, VT_OFF = 2 * ST_BYTES, OST_OFF = VT_OFF + 32768, OST_BYTES = 128 * 136;
    const bf16_t* vS = Vt + epi::tt_index(bh, 16, s * 64 + (wid >> 2) * 32, 0);
    const unsigned vdst0 = (unsigned)(uintptr_t)(F.lds + VT_OFF) + (unsigned)wid * 2048u;
#define VT_DMA(c_, buf_) do { const char* src_ = (const char*)(vS + (size_t)((c_) * 8 + 2 * (wid & 3)) * 512); \
        nsa::glds16(uni_ptr(src_), (unsigned)lane * 16u, (unsigned)__builtin_amdgcn_readfirstlane(vdst0 + (buf_) * 16384u)); \
        nsa::glds16(uni_ptr(src_ + 1024), (unsigned)lane * 16u, (unsigned)__builtin_amdgcn_readfirstlane(vdst0 + (buf_) * 16384u + 1024u)); } while (0)
    const LAS bf16_t* vl = (const LAS bf16_t*)(F.lds + VT_OFF) + lane * 8;
    f32x16 S0 = {}, S1 = {};
    bf16x8 kaf[8], ipb[8], qf[16];
#define LOAD_KA(c_) do { _Pragma("unroll") for (int ks = 0; ks < 8; ++ks) kaf[ks] = *(const bf16x8*)(kA + (size_t)((c_) * 8 + ks) * 512); } while (0)
#define LOAD_PB(c_) do { _Pragma("unroll") for (int ks = 0; ks < 8; ++ks) ipb[ks] = *(const bf16x8*)(pB + (size_t)(c_) * (4 * 8 * 512) + ks * 512); } while (0)
#define LOAD_Q(c_)  do { _Pragma("unroll") for (int ks = 0; ks < 16; ++ks) qf[ks] = *(const bf16x8*)(qB + (size_t)(c_) * (4 * 4 * 16 * 512) + ks * 512); } while (0)
#define STORE_ROWS(c_) do { _Pragma("unroll") for (int i2 = 0; i2 < 2; ++i2) { const int row = wid * 16 + i2 * 8 + (lane >> 3), q = lane & 7; const LAS unsigned char* os = F.lds + OST_OFF + ((c_) & 1) * OST_BYTES + row * 136 + q * 16; \
            const u32x2 lo = *(const LAS u32x2*)os, hi2 = *(const LAS u32x2*)(os + 8); \
            *(u32x4*)(O + ((size_t)b * SEQ + (c_) * 128 + row) * 2048 + h * 512 + s * 64 + q * 8) = (u32x4){lo.x, lo.y, hi2.x, hi2.y}; } \
        if (heavy && hi == 0 && do_stats) { float* sp = stats + ((size_t)bh * 2) * SEQ + (c_) * 128 + ib * 32 + r32; atomicAdd(sp, ps1); atomicAdd(sp + SEQ, ps2); } } while (0)
    float ps1 = 0.f, ps2 = 0.f;
    VT_DMA(0, 0);
    LOAD_KA(0); if (heavy) LOAD_PB(0);
    asm volatile("s_waitcnt vmcnt(0)\n\ts_barrier" ::: "memory");
    for (int c = 0; c < 32; ++c) {
        const LAS bf16_t* vb = vl + (c & 1) * 8192;
        const LAS bf16_t* sa = St + (c & 1) * (64 * ST_PITCH) + r32 * ST_PITCH + hi * 8;
        LAS bf16_t* Stn = St + ((c + 1) & 1) * (64 * ST_PITCH);
        if (c < 31) VT_DMA(c + 1, (c + 1) & 1);
        if (c > 0) { if (heavy) LOAD_Q(c); STORE_ROWS(c - 1); }
        if (c < 31) {
#pragma unroll
            for (int r = 0; r < 16; ++r) { S0[r] *= g128; S1[r] *= g128; }
#pragma unroll
            for (int ks = 0; ks < 8; ++ks) { S0 = __builtin_amdgcn_mfma_f32_32x32x16_bf16(kaf[ks], *(const LAS bf16x8*)(vb + ks * 512), S0, 0, 0, 0); S1 = __builtin_amdgcn_mfma_f32_32x32x16_bf16(kaf[ks], *(const LAS bf16x8*)(vb + (8 + ks) * 512), S1, 0, 0, 0); }
            if (c < 30) LOAD_KA(c + 1);
#pragma unroll
            for (int a = 0; a < 4; ++a) { u32x2 w; w.x = cvt_pk_bf16(S0[4 * a], S0[4 * a + 1]); w.y = cvt_pk_bf16(S0[4 * a + 2], S0[4 * a + 3]); *(LAS u32x2*)(Stn + r32 * ST_PITCH + wid * 32 + 8 * a + 4 * hi) = w;
                w.x = cvt_pk_bf16(S1[4 * a], S1[4 * a + 1]); w.y = cvt_pk_bf16(S1[4 * a + 2], S1[4 * a + 3]); *(LAS u32x2*)(Stn + (32 + r32) * ST_PITCH + wid * 32 + 8 * a + 4 * hi) = w; }
        }
        if (heavy) {
            f32x16 oc0 = {}, oc1 = {};
#pragma unroll
            for (int ks = 0; ks < 8; ++ks) { oc0 = __builtin_amdgcn_mfma_f32_32x32x16_bf16(*(const LAS bf16x8*)(vb + ks * 512), ipb[ks], oc0, 0, 0, 0); oc1 = __builtin_amdgcn_mfma_f32_32x32x16_bf16(*(const LAS bf16x8*)(vb + (8 + ks) * 512), ipb[ks], oc1, 0, 0, 0); }
            if (c < 31) LOAD_PB(c + 1);
            if (c > 0) {
#pragma unroll
                for (int ks = 0; ks < 16; ++ks) { oc0 = __builtin_amdgcn_mfma_f32_32x32x16_bf16(*(const LAS bf16x8*)(sa + ks * 16), qf[ks], oc0, 0, 0, 0); oc1 = __builtin_amdgcn_mfma_f32_32x32x16_bf16(*(const LAS bf16x8*)(sa + 32 * ST_PITCH + ks * 16), qf[ks], oc1, 0, 0, 0); } }
            float s1 = 0.f, s2 = 0.f;
#pragma unroll
            for (int r = 0; r < 16; ++r) { s1 += oc0[r] + oc1[r]; s2 += oc0[r] * oc0[r] + oc1[r] * oc1[r]; }
            ps1 = nsa::halfsum(s1); ps2 = nsa::halfsum(s2);
            LAS unsigned char* ow = F.lds + OST_OFF + (c & 1) * OST_BYTES + (ib * 32 + r32) * 136 + (4 * hi) * 2;
#pragma unroll
            for (int a = 0; a < 4; ++a) { u32x2 w; w.x = cvt_pk_bf16(oc0[4 * a], oc0[4 * a + 1]); w.y = cvt_pk_bf16(oc0[4 * a + 2], oc0[4 * a + 3]); *(LAS u32x2*)(ow + 16 * a) = w;
                w.x = cvt_pk_bf16(oc1[4 * a], oc1[4 * a + 1]); w.y = cvt_pk_bf16(oc1[4 * a + 2], oc1[4 * a + 3]); *(LAS u32x2*)(ow + 64 + 16 * a) = w; }
        }
        asm volatile("s_waitcnt vmcnt(0) lgkmcnt(0)\n\ts_barrier" ::: "memory");
    }
    STORE_ROWS(31);
#undef LOAD_KA
#undef LOAD_PB
#undef LOAD_Q
#undef STORE_ROWS
#undef VT_DMA
    __syncthreads();
}
__device__ __forceinline__ void scan_phase(Frame& F, bool do_stats) {
    for (int it = F.vcu; it < 256; it += F.G) scan_item(F, it >> 5, (it >> 3) & 3, it & 7, do_stats);
}
}

__global__ void __launch_bounds__(NWAVES * 64, 2) mk_fwd(Args args) {
    extern __shared__ __attribute__((aligned(16))) unsigned char lds_raw[];
    Frame F;
    F.lds = (LAS unsigned char*)lds_raw;
    F.MISC = (volatile LAS unsigned*)(F.lds + MISC_OFF);
    F.wave = __builtin_amdgcn_readfirstlane(threadIdx.x >> 6);
    F.G = gridDim.x; { const int bx = blockIdx.x; F.vcu = (F.G % 8 == 0) ? (bx % 8) * (F.G / 8) + bx / 8 : bx; }
    F.out = args.out; F.ws = args.ws; F.ctl = (unsigned*)(args.ws + WS_CTL);
    unsigned char* ws = F.ws; unsigned char* dout = F.out;
    for (int u = F.wave * 64 + lane_id(); u < (LDS_BYTES - LDSCTL_OFF) / 4; u += NWAVES * 64) ((LAS unsigned*)(F.lds + LDSCTL_OFF))[u] = 0u;
    __syncthreads();
    XcdBarrier bar = xcd_barrier_post(F.ctl + CW_BAR, F.MISC + 8, F.wave);
    cg::grid_group grid = cg::this_grid();
    const int lo = args.ph_lo, hi = args.ph_hi, bx = (int)blockIdx.x, G = F.G;
#ifndef SNAKE_ORDER
#define SNAKE_ORDER 0
#endif
#ifndef GATES_WLDS
#define GATES_WLDS 1
#endif
#ifndef P2_REBAL
#define P2_REBAL 1
#endif
#ifndef PROBE_PH
#define PROBE_PH (-1)
#endif
#ifndef PROBE_GEMM
#define PROBE_GEMM 0
#endif
#define REPS(k, isgemm) (((PROBE_PH) == (k) || ((isgemm) && PROBE_GEMM)) ? 2 : 1)
#define IN(k) (lo <= (k) && (k) < hi)
#if defined(PROBE_BAR)
#define SEAM(k) do { if (IN(k) && IN((k) + 1)) { xcd_barrier(bar); xcd_barrier(bar); } } while (0)
#else
#define SEAM(k) do { if (IN(k) && IN((k) + 1)) xcd_barrier(bar); } while (0)
#endif
    LAS unsigned char* ring = F.lds;

    if (hi < 0) grid.sync();
    if (IN(0)) { for (int rep = 0; rep < REPS(0, 0); ++rep) p0_prologue(F, args, rep == 0); if (IN(1)) xcd_barrier(bar); }

    if (IN(1)) for (int rep = 0; rep < REPS(1, 1); ++rep) {
        pg8::Gemm g{(const char*)(ws + WS_XB), (const char*)(ws + WS_WNIN), 2048u, 2048u, 128u, 128u, 1024};
        pg8::SchedStd S; S.init(128, 14, 0, G, bx, (size_t)256 * 2048, (size_t)256 * 2048);
        epi::NsaIn E{ws, dout};
        pg8::gemm_phase<epi::NsaIn, pg8::SchedStd, false>(ring, F.wave, g, S, E);
    }
    SEAM(1);
    if (IN(2)) for (int rep = 0; rep < REPS(2, 0); ++rep) {
        const bool cmp_cu = (G == 256) ? (bx < 64) : true, other_cu = (G == 256) ? (bx >= 64) : true;
        if (cmp_cu) {
            pg8::Gemm g{(const char*)(ws + WS_KC), (const char*)(ws + WS_WC1K), 8192u, 4096u, 512u, 128u, 2048};
            pg8::SchedCmp S{G, bx, WS_VC - WS_KC, WS_WC1V - WS_WC1K};
            epi::Cmp1 E{ws};
            pg8::gemm_phase<epi::Cmp1, pg8::SchedCmp, false>(ring, F.wave, g, S, E);
            VM_WAIT(); __syncthreads();
            __builtin_amdgcn_fence(__ATOMIC_ACQUIRE, "agent"); VM_WAIT();
            for (int u = bx; u < 64; u += G) cmp2_task(F, (u >> 5) * 256 + (u & 31) * 8 + F.wave);
        }
        { const int G2 = (G == 256) ? (cmp_cu ? 64 : 192) : G, c2 = (G == 256) ? (cmp_cu ? bx : bx - 64) : bx, u0 = (G == 256 && !cmp_cu) ? 64 : 0, u1 = (G == 256 && cmp_cu) ? 64 : 512;
          const bool rb = P2_REBAL && (G == 256) && !cmp_cu;
          const int c2a = rb ? (c2 + 128) % 192 : c2, c2b = rb ? (c2 + 64) % 192 : c2;
          { pg8::Gemm g{(const char*)(ws + WS_PB0), (const char*)(ws + WS_WP0), 512u, 512u, 128u, 128u, 256};
            pg8::SchedStd S; S.init(128, 4, 0, G2, c2a, (size_t)256 * 512, (size_t)256 * 512); S.range(u0, u1);
            epi::Bf16Plain E{(bf16_t*)(ws + WS_E0), 1024, 0};
            pg8::gemm_phase<epi::Bf16Plain, pg8::SchedStd, false>(ring, F.wave, g, S, E); }
          { pg8::Gemm g{(const char*)(ws + WS_PB1), (const char*)(ws + WS_WP1), 512u, 512u, 128u, 128u, 256};
            pg8::SchedStd S; S.init(128, 4, 0, G2, c2b, (size_t)256 * 512, (size_t)256 * 512); S.range(u0, u1);
            epi::Bf16Plain E{(bf16_t*)(ws + WS_E1), 1024, 0};
            pg8::gemm_phase<epi::Bf16Plain, pg8::SchedStd, false>(ring, F.wave, g, S, E); }
#if P2_REBAL
          if (G == 256) { if (bx >= 64 && bx < 128) { gates_stage_w(F); for (int task = (bx - 64) * NWAVES + F.wave; task < 1024; task += 64 * NWAVES) gates_task<true>(F, task); } }
#else
          if (G == 256) { if (bx >= 128) { if (GATES_WLDS) gates_stage_w(F); for (int task = (bx - 128) * NWAVES + F.wave; task < 1024; task += 128 * NWAVES) gates_task<GATES_WLDS != 0>(F, task); } }
#endif
          else for (int task = bx * NWAVES + F.wave; task < 1024; task += G * NWAVES) gates_task<false>(F, task);
          (void)other_cu; }
    }
    SEAM(3);
    if (IN(4)) for (int rep = 0; rep < REPS(4, 0); ++rep) nsa::nsa_phase(F);
    SEAM(4);
    if (IN(5)) for (int rep = 0; rep < REPS(5, 1); ++rep) {
        pg8::Gemm g{(const char*)(ws + WS_ATT), (const char*)(ws + WS_WNOUT), 2048u, 2048u, 128u, 128u, 1024};
        pg8::SchedStd S; S.init(128, 4, 0, G, bx, (size_t)256 * 2048, (size_t)256 * 2048);
        epi::Res<0> E{args.in[0], ws};
        pg8::gemm_phase<epi::Res<0>, pg8::SchedStd, false>(ring, F.wave, g, S, E);
    }
    SEAM(5);
    if (IN(6)) {
        pg8::Gemm g{(const char*)(ws + WS_X1B), (const char*)(ws + WS_WG0), 2048u, 2048u, 128u, 128u, 1024};
        pg8::SchedStd S; S.init(128, 4, 0, G, bx, (size_t)256 * 2048, (size_t)256 * 2048);
        S.rev = SNAKE_ORDER;
        epi::Ple<0> E{ws, dout};
        pg8::gemm_phase<epi::Ple<0>, pg8::SchedStd, false>(ring, F.wave, g, S, E);
    }
    SEAM(6);
    if (IN(7)) for (int rep = 0; rep < REPS(7, 1); ++rep) {
        pg8::Gemm g{(const char*)(ws + WS_XB), (const char*)(ws + WS_WRIN), 2048u, 2048u, 128u, 128u, 1024};
        { pg8::SchedStd S; S.init(128, 4, 0, G, bx, (size_t)256 * 2048, (size_t)256 * 2048);
          epi::RetQ E{ws};
          pg8::gemm_phase<epi::RetQ, pg8::SchedStd, false>(ring, F.wave, g, S, E);
#if defined(PROBE_P7) && PROBE_P7 == 1
          pg8::gemm_phase<epi::RetQ, pg8::SchedStd, false>(ring, F.wave, g, S, E);
#endif
          }
        { pg8::SchedStd S; S.init(128, 12, 4, G, bx, (size_t)256 * 2048, (size_t)256 * 2048);
          epi::RetKV E{ws, dout};
          pg8::gemm_phase<epi::RetKV, pg8::SchedStd, true>(ring, F.wave, g, S, E);
#if defined(PROBE_P7) && PROBE_P7 == 2
          pg8::gemm_phase<epi::RetKV, pg8::SchedStd, true>(ring, F.wave, g, S, E);
#endif
          }
    }
    SEAM(7);
    if (IN(8)) for (int rep = 0; rep < REPS(8, 0); ++rep) ret::p_phase(F);
    SEAM(8);
    if (IN(9)) for (int rep = 0; rep < REPS(9, 0); ++rep) ret::scan_phase(F, rep == 0);
    SEAM(9);
    if (IN(10)) {
        pg8::Gemm g{(const char*)(ws + WS_XB), (const char*)(ws + WS_WRIN), 2048u, 2048u, 128u, 128u, 1024};
        pg8::SchedStd S; S.init(128, 8, 16, G, bx, (size_t)256 * 2048, (size_t)256 * 2048);
        epi::RetZ E{ws, dout};
        pg8::gemm_phase<epi::RetZ, pg8::SchedStd, false>(ring, F.wave, g, S, E);
    }
    SEAM(10);
    if (IN(11)) for (int rep = 0; rep < REPS(11, 1); ++rep) {
        { pg8::Gemm g{(const char*)dout, (const char*)(ws + WS_WROUT), 4096u, 4096u, 128u, 128u, 2048};
          pg8::SchedStd S; S.init(128, 4, 0, G, bx, (size_t)256 * 4096, (size_t)256 * 4096);
          S.rev = SNAKE_ORDER;
          epi::Res<1> E{nullptr, ws};
          pg8::gemm_phase<epi::Res<1>, pg8::SchedStd, false>(ring, F.wave, g, S, E); }
    }
    SEAM(11);
    if (IN(12)) for (int rep = 0; rep < REPS(12, 1); ++rep) {
        pg8::Gemm g{(const char*)(ws + WS_X3B), (const char*)(ws + WS_WG1), 2048u, 2048u, 128u, 128u, 1024};
        pg8::SchedStd S; S.init(128, 4, 0, G, bx, (size_t)256 * 2048, (size_t)256 * 2048);
        epi::Ple<1> E{ws, dout};
        pg8::gemm_phase<epi::Ple<1>, pg8::SchedStd, false>(ring, F.wave, g, S, E);
    }
#undef IN
#undef SEAM
}

extern "C" void kernel_launch(void* const* d_in, const int* in_sizes, int n_in, void* d_out, int out_size, void* d_ws, size_t ws_size, hipStream_t stream) {
    static int grid = 0;
    if (grid == 0) {
        if (n_in != 19 || out_size != T_TOK * DM || ws_size < WS_END) { fprintf(stderr, "kernel_launch: unexpected problem (n_in %d, out %d, ws %zu)\n", n_in, out_size, ws_size); grid = -1; return; }
        int dev = 0, cus = 0, per_cu = 0;
        (void)hipGetDevice(&dev); (void)hipDeviceGetAttribute(&cus, hipDeviceAttributeMultiprocessorCount, dev);
        if (hipFuncSetAttribute((const void*)mk_fwd, hipFuncAttributeMaxDynamicSharedMemorySize, LDS_BYTES) != hipSuccess) { fprintf(stderr, "kernel_launch: hipFuncSetAttribute failed\n"); grid = -1; return; }
        if (hipOccupancyMaxActiveBlocksPerMultiprocessor(&per_cu, (const void*)mk_fwd, NWAVES * 64, LDS_BYTES) != hipSuccess || per_cu < 1) { fprintf(stderr, "kernel_launch: occupancy query gave %d\n", per_cu); per_cu = 1; }
        (void)hipGetLastError();
        if (per_cu > 1) per_cu = 1;
        grid = cus * per_cu;
    }
    if (grid < 0) return;
    (void)hipMemsetAsync((char*)d_ws + WS_CTL, 0, ZERO_BYTES, stream);
    Args a{};
    for (int i = 0; i < 19; ++i) a.in[i] = (const float*)d_in[i];
    a.out = (unsigned char*)d_out; a.ws = (unsigned char*)d_ws; a.ph_lo = 0; a.ph_hi = 13;
    void* kargs[] = {&a};
    hipError_t e = hipLaunchCooperativeKernel((const void*)mk_fwd, dim3(grid), dim3(NWAVES * 64), kargs, LDS_BYTES, stream);
    if (e != hipSuccess) fprintf(stderr, "kernel_launch: cooperative launch failed: %s (grid %d)\n", hipGetErrorString(e), grid);
}
```
